# Optimizing an MI355X kernel written in HIP

```python
import math
import jax, jax.numpy as jnp
from jax import lax
import numpy as np

D_MODEL = 1024
BATCH = 4
SEQ = 4096
DEPTH = 2

GDN_HEADS = 8
GDN_HEAD_DIM = 128
GDN_WIDTH = GDN_HEADS * GDN_HEAD_DIM
CONV_K = 4
GDN_CHUNK = 64
DSA_HEADS = 8
DSA_HEAD_DIM = 128
DSA_WIDTH = DSA_HEADS * DSA_HEAD_DIM
IDX_HEADS = 8
IDX_HEAD_DIM = 64
TOPK_MAX = 256
DSA_QBLK = 64
ROPE_THETA = 10000.0
FF_DIM = -(-8 * D_MODEL // (3 * 256)) * 256
NORM_EPS = 1e-6

IN_SIZES = (
    3 * GDN_WIDTH,
    GDN_WIDTH,
    GDN_HEADS,
    GDN_HEADS,
    3 * DSA_WIDTH,
    IDX_HEADS * IDX_HEAD_DIM,
    IDX_HEAD_DIM,
    IDX_HEADS,
    D_MODEL,
    D_MODEL,
)
IN_COLS = 3 * GDN_WIDTH + GDN_WIDTH + 2 * GDN_HEADS + 3 * DSA_WIDTH + IDX_HEADS * IDX_HEAD_DIM + IDX_HEAD_DIM + IDX_HEADS + 2 * D_MODEL

kernel_name = "hybrid_gdn_dsa_gated_block"


def rms_norm(x, gain):
    xf = x.astype(jnp.float32)
    y = xf * lax.rsqrt(jnp.mean(xf * xf, axis=-1, keepdims=True) + NORM_EPS)
    return (y * gain.astype(jnp.float32)).astype(x.dtype)


def l2norm(x):
    return x * lax.rsqrt(jnp.sum(x * x, axis=-1, keepdims=True) + NORM_EPS)


def split_cols(t, sizes):
    out, start = [], 0
    for s in sizes:
        out.append(t[..., start:start + s])
        start += s
    return out


def rope_tables(seq_len, dim):
    inv_freq = 1.0 / (ROPE_THETA ** (jnp.arange(0, dim, 2, dtype=jnp.float32) / dim))
    ang = jnp.arange(seq_len, dtype=jnp.float32)[:, None] * inv_freq[None, :]
    return jnp.cos(ang), jnp.sin(ang)


def apply_rope(x, cos, sin):
    half = x.shape[-1] // 2
    extra = x.ndim - 3
    c = cos.reshape(cos.shape[0], *([1] * extra), half)
    s = sin.reshape(sin.shape[0], *([1] * extra), half)
    x1 = x[..., :half].astype(jnp.float32)
    x2 = x[..., half:].astype(jnp.float32)
    return jnp.concatenate([x1 * c - x2 * s, x2 * c + x1 * s], axis=-1).astype(x.dtype)


def causal_short_conv(x, w):
    L = x.shape[1]
    xp = jnp.pad(x, ((0, 0), (CONV_K - 1, 0), (0, 0)))
    y = w[0] * xp[:, 0:L]
    for j in range(1, CONV_K):
        y = y + w[j] * xp[:, j:j + L]
    return jax.nn.silu(y)


def chunk_gated_delta_rule(q, k, v, g, beta):
    B, L, H, dk = q.shape
    dv = v.shape[-1]
    C = GDN_CHUNK
    N = L // C
    f32 = jnp.float32

    def chunks(t):
        return jnp.moveaxis(t.astype(f32).reshape(B, N, C, H, *t.shape[3:]), 3, 1)

    q = chunks(q) * (dk ** -0.5)
    k = chunks(k)
    v = chunks(v)
    gam = jnp.cumsum(chunks(g), axis=-1)
    beta = chunks(beta)

    tril_incl = jnp.tril(jnp.ones((C, C), dtype=bool))
    tril_strict = jnp.tril(jnp.ones((C, C), dtype=bool), -1)
    decay = jnp.exp(jnp.where(tril_incl, gam[..., :, None] - gam[..., None, :], -jnp.inf))

    kk = jnp.einsum('bhnid,bhnjd->bhnij', k, k)
    a_mat = jnp.where(tril_strict, beta[..., None] * kk * decay, 0.0)
    lhs = jnp.eye(C, dtype=f32) + a_mat
    rhs = jnp.concatenate([v * beta[..., None], k * (beta * jnp.exp(gam))[..., None]], axis=-1)
    sol = lax.linalg.triangular_solve(lhs, rhs, left_side=True, lower=True, unit_diagonal=True)
    u, w = sol[..., :dv], sol[..., dv:]

    qk = jnp.where(tril_incl, jnp.einsum('bhnid,bhnjd->bhnij', q, k) * decay, 0.0)
    q_dec = q * jnp.exp(gam)[..., None]
    k_dec = k * jnp.exp(gam[..., -1:] - gam)[..., None]
    g_last = jnp.exp(gam[..., -1])

    def step(S, xs):
        u_c, w_c, qk_c, qd_c, kd_c, gl_c = xs
        v_new = u_c - jnp.einsum('bhcd,bhde->bhce', w_c, S)
        o_c = jnp.einsum('bhcd,bhde->bhce', qd_c, S) + jnp.einsum('bhij,bhje->bhie', qk_c, v_new)
        S = S * gl_c[..., None, None] + jnp.einsum('bhcd,bhce->bhde', kd_c, v_new)
        return S, o_c

    xs = tuple(jnp.moveaxis(t, 2, 0) for t in (u, w, qk, q_dec, k_dec, g_last))
    S0 = jnp.zeros((B, H, dk, dv), dtype=f32)
    _, o = lax.scan(step, S0, xs)
    o = jnp.moveaxis(o, 0, 2).reshape(B, H, L, dv)
    return jnp.transpose(o, (0, 2, 1, 3))


def dsa_attention(q, k, v, q_idx, k_idx, w_idx):
    B, L, H, dh = q.shape
    topk = min(TOPK_MAX, L // 4)
    nblk = L // DSA_QBLK
    key_pos = jnp.arange(L, dtype=jnp.int32)
    k_idx_f = k_idx.astype(jnp.float32) * (IDX_HEAD_DIM ** -0.5)
    gather = jax.vmap(lambda kk, ii: kk[ii])

    def blocks(t):
        return jnp.moveaxis(t.reshape(B, nblk, DSA_QBLK, *t.shape[2:]), 1, 0)

    def one_block(args):
        qb, qib, wb, start = args
        qpos = start + jnp.arange(DSA_QBLK, dtype=jnp.int32)
        logits = jnp.einsum('bqhd,bsd->bqhs', qib.astype(jnp.float32), k_idx_f)
        score = jnp.einsum('bqh,bqhs->bqs', wb.astype(jnp.float32) * (IDX_HEADS ** -0.5), jax.nn.relu(logits))
        causal = key_pos[None, :] <= qpos[:, None]
        score = jnp.where(causal[None], score, -jnp.inf)
        _, idx = lax.top_k(score, topk)
        ks = gather(k, idx).astype(jnp.float32)
        vs = gather(v, idx).astype(jnp.float32)
        s = jnp.einsum('bqhd,bqkhd->bqhk', qb.astype(jnp.float32), ks) * (dh ** -0.5)
        valid = idx <= qpos[None, :, None]
        s = jnp.where(valid[:, :, None, :], s, -jnp.inf)
        p = jax.nn.softmax(s, axis=-1)
        return jnp.einsum('bqhk,bqkhd->bqhd', p, vs).astype(q.dtype)

    starts = jnp.arange(nblk, dtype=jnp.int32) * DSA_QBLK
    o = lax.map(one_block, (blocks(q), blocks(q_idx), blocks(w_idx), starts))
    return jnp.moveaxis(o, 0, 1).reshape(B, L, H * dh)


def hybrid_mixer(h, w_in, conv_w, a_log, dt_bias, gdn_norm, w_out_gdn, w_out_dsa, w_o, cos_a, sin_a, cos_i, sin_i):
    B, L, _ = h.shape
    proj = h @ w_in
    (qkv_a, z_a, a_a, b_a, qkv_b, q_i, k_i, w_i, g_a, g_b) = split_cols(proj, IN_SIZES)

    qkv_a = causal_short_conv(qkv_a, conv_w)
    q_a, k_a, v_a = split_cols(qkv_a, (GDN_WIDTH, GDN_WIDTH, GDN_WIDTH))
    q_a = l2norm(q_a.reshape(B, L, GDN_HEADS, GDN_HEAD_DIM).astype(jnp.float32))
    k_a = l2norm(k_a.reshape(B, L, GDN_HEADS, GDN_HEAD_DIM).astype(jnp.float32))
    v_a = v_a.reshape(B, L, GDN_HEADS, GDN_HEAD_DIM)
    g = -jnp.exp(a_log.astype(jnp.float32)) * jax.nn.softplus(a_a.astype(jnp.float32) + dt_bias.astype(jnp.float32))
    beta = jax.nn.sigmoid(b_a.astype(jnp.float32))
    o_a = chunk_gated_delta_rule(q_a, k_a, v_a, g, beta)
    o_a = rms_norm(o_a, gdn_norm) * jax.nn.silu(z_a.reshape(B, L, GDN_HEADS, GDN_HEAD_DIM).astype(jnp.float32))
    y_a = o_a.reshape(B, L, GDN_WIDTH).astype(h.dtype) @ w_out_gdn

    q_b, k_b, v_b = split_cols(qkv_b, (DSA_WIDTH, DSA_WIDTH, DSA_WIDTH))
    q_b = apply_rope(q_b.reshape(B, L, DSA_HEADS, DSA_HEAD_DIM), cos_a, sin_a)
    k_b = apply_rope(k_b.reshape(B, L, DSA_HEADS, DSA_HEAD_DIM), cos_a, sin_a)
    v_b = v_b.reshape(B, L, DSA_HEADS, DSA_HEAD_DIM)
    q_i = apply_rope(q_i.reshape(B, L, IDX_HEADS, IDX_HEAD_DIM), cos_i, sin_i)
    k_i = apply_rope(k_i, cos_i, sin_i)
    y_b = dsa_attention(q_b, k_b, v_b, q_i, k_i, w_i) @ w_out_dsa

    merged = jax.nn.sigmoid(g_a) * y_a + jax.nn.sigmoid(g_b) * y_b
    return merged @ w_o


def swiglu(h, w_gate_up, w_down):
    gu = h @ w_gate_up
    return (jax.nn.silu(gu[..., :FF_DIM]) * gu[..., FF_DIM:]) @ w_down


def setup_inputs(seed: int = 0) -> dict:
    key = jax.random.key(seed)
    ks = jax.random.split(key, 15)
    f32 = jnp.float32

    def normal(k, shape, scale):
        return jax.random.normal(k, shape, f32) * scale

    def gain(k, shape):
        return 1.0 + 0.02 * jax.random.normal(k, shape, f32)

    x = normal(ks[0], (BATCH, SEQ, D_MODEL), 1.0)
    norm_mix = gain(ks[1], (DEPTH, D_MODEL))
    w_in = normal(ks[2], (DEPTH, D_MODEL, IN_COLS), D_MODEL ** -0.5)
    conv_w = normal(ks[3], (DEPTH, CONV_K, 3 * GDN_WIDTH), CONV_K ** -0.5)
    a_log = jnp.log(jax.random.uniform(ks[4], (DEPTH, GDN_HEADS), f32, minval=1.0, maxval=16.0))
    dt = jnp.exp(jax.random.uniform(ks[5], (DEPTH, GDN_HEADS), f32, minval=math.log(1e-3), maxval=math.log(1e-1)))
    dt_bias = dt + jnp.log(-jnp.expm1(-dt))
    gdn_norm = gain(ks[6], (DEPTH, GDN_HEAD_DIM))
    w_out_gdn = normal(ks[7], (DEPTH, GDN_WIDTH, D_MODEL), GDN_WIDTH ** -0.5)
    w_out_dsa = normal(ks[8], (DEPTH, DSA_WIDTH, D_MODEL), DSA_WIDTH ** -0.5)
    w_o = normal(ks[9], (DEPTH, D_MODEL, D_MODEL), D_MODEL ** -0.5)
    norm_ffn = gain(ks[10], (DEPTH, D_MODEL))
    w_gate_up = normal(ks[11], (DEPTH, D_MODEL, 2 * FF_DIM), D_MODEL ** -0.5)
    w_down = normal(ks[12], (DEPTH, FF_DIM, D_MODEL), FF_DIM ** -0.5)
    norm_final = gain(ks[13], (D_MODEL,))
    return {"x": x, "norm_mix": norm_mix, "w_in": w_in, "conv_w": conv_w, "a_log": a_log,
            "dt_bias": dt_bias, "gdn_norm": gdn_norm, "w_out_gdn": w_out_gdn, "w_out_dsa": w_out_dsa,
            "w_o": w_o, "norm_ffn": norm_ffn, "w_gate_up": w_gate_up, "w_down": w_down,
            "norm_final": norm_final}


def reference(x, norm_mix, w_in, conv_w, a_log, dt_bias, gdn_norm, w_out_gdn, w_out_dsa, w_o,
              norm_ffn, w_gate_up, w_down, norm_final):
    L = x.shape[1]
    cos_a, sin_a = rope_tables(L, DSA_HEAD_DIM)
    cos_i, sin_i = rope_tables(L, IDX_HEAD_DIM)
    h = x
    for l in range(DEPTH):
        h = h + hybrid_mixer(rms_norm(h, norm_mix[l]), w_in[l], conv_w[l], a_log[l], dt_bias[l],
                             gdn_norm[l], w_out_gdn[l], w_out_dsa[l], w_o[l], cos_a, sin_a, cos_i, sin_i)
        h = h + swiglu(rms_norm(h, norm_ffn[l]), w_gate_up[l], w_down[l])
    return rms_norm(h, norm_final)
```

```cpp
#include <hip/hip_runtime.h>
#include <hip/hip_cooperative_groups.h>
#include <cstdio>
#include <cstdint>
namespace cg = cooperative_groups;

typedef unsigned short bf16_t;
typedef float f32x4 __attribute__((ext_vector_type(4)));

constexpr int BATCH = 4, SEQ = 4096, DM = 1024, M = BATCH * SEQ, DEPTH = 2;
constexpr int GH = 8, GD = 128, CONVK = 4, CH = 64;
constexpr int AH = 8, AD = 128, IH = 8, ID = 64, TOPK = 256;
constexpr int FF = 2816, INC = 9816;
constexpr int NSPLIT = 2, MS = M / NSPLIT, BPS = BATCH / NSPLIT;
constexpr float EPS = 1e-6f;
constexpr int C_QKVA = 0, C_Z = 3072, C_A = 4096, C_B = 4104, C_QB = 4112, C_KB = 5136, C_VB = 6160, C_QI = 7184, C_KI = 7696, C_WI = 7760, C_GA = 7768, C_GB = 8792;

constexpr size_t MiB = 1u << 20;
constexpr size_t WS_CTL = 0;
constexpr size_t WS_WT = 1 * MiB;
constexpr size_t WS_TAB = 43 * MiB;
constexpr size_t WS_XN = 46 * MiB;
constexpr size_t WS_OA = 78 * MiB;
constexpr size_t WS_AT = 110 * MiB;
constexpr size_t WS_R = 142 * MiB;
constexpr size_t R_QKVA = 0, R_ZS = 48 * MiB, R_QB = 64 * MiB, R_KB = 80 * MiB, R_VB = 96 * MiB, R_QI = 112 * MiB, R_KI = 120 * MiB;
constexpr size_t R_WI = 121 * MiB, R_GG = R_WI + 256 * 1024, R_BETA = R_GG + 256 * 1024, R_HALO = 122 * MiB;
constexpr size_t R_P2 = 124 * MiB + 256 * 1024;
constexpr size_t R_TMP = R_P2;
constexpr size_t R_SG = 0, R_M1 = 64 * MiB, R_MG = R_M1;
constexpr size_t R_ACT = 0;
constexpr size_t WS_END = WS_R + R_P2 + 32 * MiB;
static_assert(WS_END <= 321650688ull, "workspace map exceeds the guaranteed d_ws size");
constexpr int LDS_BYTES = 147456;

struct Args { const float* in[14]; float* out; unsigned char* ws; };

__device__ __forceinline__ float bf2f(unsigned v) { return __uint_as_float(v << 16); }
__device__ __forceinline__ bf16_t f2bf(float f) { unsigned u = __float_as_uint(f); u += 0x7fffu + ((u >> 16) & 1u); return (bf16_t)(u >> 16); }
__device__ __forceinline__ float sigmoidf_(float x) { return 1.f / (1.f + __expf(-x)); }
__device__ __forceinline__ float siluf_(float x) { return x / (1.f + __expf(-x)); }
__device__ __forceinline__ float softplusf_(float x) { return fmaxf(x, 0.f) + log1pf(__expf(-fabsf(x))); }
__device__ __forceinline__ float wave_sum(float v) {
#pragma unroll
    for (int o = 1; o < 64; o <<= 1) v += __shfl_xor(v, o);
    return v;
}
__device__ __forceinline__ float wave_max(float v) {
#pragma unroll
    for (int o = 1; o < 64; o <<= 1) v = fmaxf(v, __shfl_xor(v, o));
    return v;
}

struct Ctx {
    const float* x; const float* norm_mix; const float* w_in; const float* conv_w; const float* a_log; const float* dt_bias; const float* gdn_norm;
    const float* w_out_gdn; const float* w_out_dsa; const float* w_o; const float* norm_ffn; const float* w_gate_up; const float* w_down; const float* norm_final;
    float* out; unsigned char* ws; unsigned char* R;
    float *cosA, *sinA, *cosI, *sinI;
    bf16_t *XN, *OA, *AT;
};

__device__ const double ROPE_INVF[64] = {1.0, 0.8659643233600653, 0.7498942093324559, 0.6493816315762113, 0.5623413251903491, 0.4869675251658631, 0.4216965034285822, 0.3651741272548377, 0.31622776601683794, 0.27384196342643613, 0.23713737056616552, 0.2053525026457146, 0.1778279410038923, 0.1539926526059492, 0.1333521432163324, 0.11547819846894582, 0.1, 0.08659643233600653, 0.07498942093324558, 0.06493816315762113, 0.05623413251903491, 0.04869675251658631, 0.042169650342858224, 0.03651741272548377, 0.03162277660168379, 0.027384196342643614, 0.023713737056616554, 0.02053525026457146, 0.01778279410038923, 0.01539926526059492, 0.01333521432163324, 0.011547819846894581, 0.01, 0.008659643233600654, 0.007498942093324558, 0.006493816315762113, 0.005623413251903491, 0.004869675251658631, 0.004216965034285823, 0.003651741272548377, 0.0031622776601683794, 0.0027384196342643613, 0.0023713737056616554, 0.002053525026457146, 0.0017782794100389228, 0.001539926526059492, 0.001333521432163324, 0.0011547819846894581, 0.001, 0.0008659643233600654, 0.0007498942093324559, 0.0006493816315762113, 0.0005623413251903491, 0.0004869675251658631, 0.00042169650342858224, 0.0003651741272548377, 0.00031622776601683794, 0.0002738419634264361, 0.00023713737056616554, 0.0002053525026457146, 0.00017782794100389227, 0.0001539926526059492, 0.0001333521432163324, 0.00011547819846894582};
__device__ __forceinline__ void rope_cs(int t, double invf, float& cs, float& sn) {
    const double ang = (double)t * invf; const double k = rint(ang * 0.15915494309189535); const float r = (float)(ang - k * 6.283185307179586);
    cs = cosf(r); sn = sinf(r);
}
__device__ void phase_tables(const Ctx& c) {
    const int gt = blockIdx.x * blockDim.x + threadIdx.x, nt = gridDim.x * blockDim.x;
    for (int i = gt; i < SEQ * 64; i += nt) { const int t = i >> 6, d = i & 63; float cs, sn; rope_cs(t, ROPE_INVF[d], cs, sn); c.cosA[i] = cs; c.sinA[i] = sn; }
    for (int i = gt; i < SEQ * 32; i += nt) { const int t = i >> 5, d = i & 31; float cs, sn; rope_cs(t, ROPE_INVF[2 * d], cs, sn); c.cosI[i] = cs; c.sinI[i] = sn; }
}

__device__ void phase_rmsnorm(const float* src, const float* gain, bf16_t* dst_bf, float* dst_f) {
    const int lane = threadIdx.x & 63, gw = (blockIdx.x * blockDim.x + threadIdx.x) >> 6, nw = (gridDim.x * blockDim.x) >> 6;
    for (int r = gw; r < M; r += nw) {
        const f32x4* xr = (const f32x4*)(src + (size_t)r * DM) + lane;
        f32x4 v[4]; float s = 0.f;
#pragma unroll
        for (int j = 0; j < 4; ++j) { v[j] = xr[64 * j]; s += v[j].x * v[j].x + v[j].y * v[j].y + v[j].z * v[j].z + v[j].w * v[j].w; }
        const float rs = rsqrtf(wave_sum(s) * (1.f / DM) + EPS);
#pragma unroll
        for (int j = 0; j < 4; ++j) {
            const f32x4 g = ((const f32x4*)gain)[lane + 64 * j]; const f32x4 o = v[j] * rs * g;
            if (dst_bf) { uint2 w; w.x = f2bf(o.x) | ((unsigned)f2bf(o.y) << 16); w.y = f2bf(o.z) | ((unsigned)f2bf(o.w) << 16); ((uint2*)(dst_bf + (size_t)r * DM))[lane + 64 * j] = w; }
            else ((f32x4*)(dst_f + (size_t)r * DM))[lane + 64 * j] = o;
        }
    }
}

struct NG { const bf16_t* A; int lda; const float* W; int ldw; int col0; int ncols; int row0; int nrows; int K; float* T; int ldt; int tcol0; };
__device__ void naive_gemm(const NG& g, unsigned char* smem) {
    float* As = (float*)smem; float* Bs = As + 16 * 132;
    const int tid = threadIdx.x, ty = tid >> 4, tx = tid & 15;
    const int ntr = g.nrows / 128, ntc = (g.ncols + 63) / 64;
    for (int u = blockIdx.x; u < ntr * ntc; u += gridDim.x) {
        const int tr = u % ntr, tc = u / ntr, r0 = tr * 128, c0 = tc * 64;
        float acc[4][4];
#pragma unroll
        for (int i = 0; i < 4; ++i)
#pragma unroll
            for (int j = 0; j < 4; ++j) acc[i][j] = 0.f;
        for (int k0 = 0; k0 < g.K; k0 += 16) {
            { const int row = tid >> 2, kq = (tid & 3) * 4;
              const uint2 raw = *(const uint2*)(g.A + (size_t)(g.row0 + r0 + row) * g.lda + k0 + kq);
              As[(kq + 0) * 132 + row] = bf2f(raw.x & 0xffffu); As[(kq + 1) * 132 + row] = bf2f(raw.x >> 16);
              As[(kq + 2) * 132 + row] = bf2f(raw.y & 0xffffu); As[(kq + 3) * 132 + row] = bf2f(raw.y >> 16); }
            { const int k = tid >> 5, cc = (tid & 31) * 2;
              const float* wp = g.W + (size_t)(k0 + k) * g.ldw + g.col0 + c0 + cc;
              Bs[k * 68 + cc] = (c0 + cc < g.ncols) ? wp[0] : 0.f; Bs[k * 68 + cc + 1] = (c0 + cc + 1 < g.ncols) ? wp[1] : 0.f; }
            __syncthreads();
#pragma unroll
            for (int kk = 0; kk < 16; ++kk) {
                const f32x4 a = *(const f32x4*)&As[kk * 132 + ty * 4]; const f32x4 b = *(const f32x4*)&Bs[kk * 68 + tx * 4];
#pragma unroll
                for (int i = 0; i < 4; ++i)
#pragma unroll
                    for (int j = 0; j < 4; ++j) acc[i][j] += a[i] * b[j];
            }
            __syncthreads();
        }
#pragma unroll
        for (int i = 0; i < 4; ++i)
#pragma unroll
            for (int j = 0; j < 4; ++j) { const int cc = c0 + tx * 4 + j; if (cc < g.ncols) g.T[(size_t)(r0 + ty * 4 + i) * g.ldt + g.tcol0 + cc] = acc[i][j]; }
    }
}

enum { E_QKVA, E_Z, E_AB, E_ROPE, E_V, E_QI, E_KIWI, E_SG, E_YA, E_YB, E_WO, E_SWIGLU, E_DOWN };
struct EP { int kind; int nrows; int rowg0; int p0; int layer; bf16_t* dst; const float* base; };
__device__ void epi_phase(const Ctx& c, const EP& e) {
    const float* T = (const float*)(c.R + R_TMP);
    const int gt = blockIdx.x * blockDim.x + threadIdx.x, nt = gridDim.x * blockDim.x;
    int W;
    switch (e.kind) { case E_QKVA: case E_Z: case E_V: case E_SG: case E_YA: case E_YB: case E_WO: case E_DOWN: W = 1024; break;
        case E_AB: W = 16; break; case E_ROPE: W = 512; break; case E_QI: W = 256; break; case E_KIWI: W = 40; break; default: W = 256; break; }
    const long total = (long)e.nrows * W;
    for (long idx = gt; idx < total; idx += nt) {
        const int r = (int)(idx / W), j = (int)(idx % W);
        const int rowg = e.rowg0 + r, rs = rowg % MS, pos = rowg % SEQ;
        const float* Tr = T + (size_t)r * 1024;
        switch (e.kind) {
        case E_QKVA: { const int col = e.p0 * 1024 + j; const bf16_t v = f2bf(Tr[j]); ((bf16_t*)(c.R + R_QKVA))[(size_t)rs * 3072 + col] = v;
                       if ((rs & 63) >= 61) ((bf16_t*)(c.R + R_HALO))[((size_t)(rs >> 6) * 3 + ((rs & 63) - 61)) * 3072 + col] = v; } break;
        case E_Z: ((bf16_t*)(c.R + R_ZS))[(size_t)rs * 1024 + j] = f2bf(siluf_(Tr[j])); break;
        case E_AB: { const int h = j & 7;
                     if (j < 8) ((float*)(c.R + R_GG))[rs * 8 + h] = -__expf(c.a_log[e.layer * 8 + h]) * softplusf_(Tr[j] + c.dt_bias[e.layer * 8 + h]);
                     else ((float*)(c.R + R_BETA))[rs * 8 + h] = sigmoidf_(Tr[j]); } break;
        case E_ROPE: { const int h = j >> 6, d = j & 63; const float x1 = Tr[h * 128 + d], x2 = Tr[h * 128 + 64 + d], cs = c.cosA[pos * 64 + d], sn = c.sinA[pos * 64 + d];
                       bf16_t* dst = e.dst + (size_t)rs * 1024 + h * 128 + d; dst[0] = f2bf(x1 * cs - x2 * sn); dst[64] = f2bf(x2 * cs + x1 * sn); } break;
        case E_V: e.dst[(size_t)rs * 1024 + j] = f2bf(Tr[j]); break;
        case E_QI: { const int h = j >> 5, d = j & 31; const float x1 = Tr[h * 64 + d], x2 = Tr[h * 64 + 32 + d], cs = c.cosI[pos * 32 + d], sn = c.sinI[pos * 32 + d];
                     bf16_t* dst = (bf16_t*)(c.R + R_QI) + (size_t)rs * 512 + h * 64 + d; dst[0] = f2bf(x1 * cs - x2 * sn); dst[32] = f2bf(x2 * cs + x1 * sn); } break;
        case E_KIWI: { if (j < 32) { const int d = j; const float x1 = Tr[d], x2 = Tr[32 + d], cs = c.cosI[pos * 32 + d], sn = c.sinI[pos * 32 + d];
                           bf16_t* dst = (bf16_t*)(c.R + R_KI) + (size_t)rs * 64 + d; dst[0] = f2bf((x1 * cs - x2 * sn) * 0.125f); dst[32] = f2bf((x2 * cs + x1 * sn) * 0.125f); }
                       else ((float*)(c.R + R_WI))[rs * 8 + (j - 32)] = Tr[64 + (j - 32)] * 0.35355339059327373f; } break;
        case E_SG: ((bf16_t*)(c.R + R_SG))[(size_t)rowg * 2048 + e.p0 * 1024 + j] = f2bf(sigmoidf_(Tr[j])); break;
        case E_YA: ((bf16_t*)(c.R + R_M1))[(size_t)rowg * 1024 + j] = f2bf(bf2f(((const bf16_t*)(c.R + R_SG))[(size_t)rowg * 2048 + j]) * Tr[j]); break;
        case E_YB: ((bf16_t*)(c.R + R_MG))[(size_t)rowg * 1024 + j] = f2bf(bf2f(((const bf16_t*)(c.R + R_M1))[(size_t)rowg * 1024 + j]) + bf2f(((const bf16_t*)(c.R + R_SG))[(size_t)rowg * 2048 + 1024 + j]) * Tr[j]); break;
        case E_WO: c.out[(size_t)rowg * 1024 + j] = e.base[(size_t)rowg * 1024 + j] + Tr[j]; break;
        case E_SWIGLU: ((bf16_t*)(c.R + R_ACT))[(size_t)rowg * FF + e.p0 * 256 + j] = f2bf(siluf_(Tr[j]) * Tr[256 + j]); break;
        case E_DOWN: c.out[(size_t)rowg * 1024 + j] += Tr[j]; break;
        }
    }
}

__device__ void naive_conv(const Ctx& c, int layer) {
    bf16_t* Q = (bf16_t*)(c.R + R_QKVA); const bf16_t* H = (const bf16_t*)(c.R + R_HALO); const float* cw = c.conv_w + (size_t)layer * 4 * 3072;
    const int gt = blockIdx.x * blockDim.x + threadIdx.x, nt = gridDim.x * blockDim.x;
    for (int idx = gt; idx < (MS / 64) * 3072; idx += nt) {
        const int ch = idx % 3072, ck = idx / 3072;
        const float w0 = cw[ch], w1 = cw[3072 + ch], w2 = cw[2 * 3072 + ch], w3 = cw[3 * 3072 + ch];
        float x3 = 0.f, x2 = 0.f, x1 = 0.f;
        if ((ck * 64) % SEQ != 0) { const bf16_t* hp = H + (size_t)(ck - 1) * 3 * 3072 + ch; x3 = bf2f(hp[0]); x2 = bf2f(hp[3072]); x1 = bf2f(hp[2 * 3072]); }
        bf16_t* p = Q + (size_t)ck * 64 * 3072 + ch;
        for (int r = 0; r < 64; ++r) { const float xv = bf2f(p[(size_t)r * 3072]); const float y = w0 * x3 + w1 * x2 + w2 * x1 + w3 * xv; p[(size_t)r * 3072] = f2bf(siluf_(y)); x3 = x2; x2 = x1; x1 = xv; }
    }
}
__device__ void naive_l2norm(const Ctx& c) {
    bf16_t* Q = (bf16_t*)(c.R + R_QKVA);
    const int lane = threadIdx.x & 63, gw = (blockIdx.x * blockDim.x + threadIdx.x) >> 6, nw = (gridDim.x * blockDim.x) >> 6;
    for (int t = gw; t < MS * 16; t += nw) {
        const int r = t >> 4, hh = t & 15;
        unsigned* p = (unsigned*)(Q + (size_t)r * 3072 + hh * 128) + lane; const unsigned raw = *p;
        const float a = bf2f(raw & 0xffffu), b = bf2f(raw >> 16); const float rs = rsqrtf(wave_sum(a * a + b * b) + EPS);
        *p = f2bf(a * rs) | ((unsigned)f2bf(b * rs) << 16);
    }
}
__device__ void naive_scan(const Ctx& c, unsigned char* smem) {
    const bf16_t* Q = (const bf16_t*)(c.R + R_QKVA); const float* GG = (const float*)(c.R + R_GG); const float* BT = (const float*)(c.R + R_BETA); float* O = (float*)(c.R + R_TMP);
    const int lane = threadIdx.x & 63, wv = threadIdx.x >> 6, gw = blockIdx.x * 8 + wv, nw = gridDim.x * 8;
    float* kL = (float*)smem + wv * 4096; float* qL = kL + 2048;
    const int dq = lane >> 4, el = lane & 15;
    for (int task = gw; task < BPS * 8 * 8; task += nw) {
        const int eb = task & 7, h = (task >> 3) & 7, bl = task >> 6, e = eb * 16 + el;
        float S[32];
#pragma unroll
        for (int i = 0; i < 32; ++i) S[i] = 0.f;
        for (int t0 = 0; t0 < SEQ; t0 += 16) {
            for (int tk = 0; tk < 16; ++tk) { const size_t row = (size_t)bl * SEQ + t0 + tk;
                const unsigned qr = *((const unsigned*)(Q + row * 3072 + h * 128) + lane), kr = *((const unsigned*)(Q + row * 3072 + 1024 + h * 128) + lane);
                qL[tk * 128 + lane * 2] = bf2f(qr & 0xffffu); qL[tk * 128 + lane * 2 + 1] = bf2f(qr >> 16); kL[tk * 128 + lane * 2] = bf2f(kr & 0xffffu); kL[tk * 128 + lane * 2 + 1] = bf2f(kr >> 16); }
            __builtin_amdgcn_s_waitcnt(0); __builtin_amdgcn_wave_barrier();
            for (int tk = 0; tk < 16; ++tk) { const size_t row = (size_t)bl * SEQ + t0 + tk;
                const float eg = __expf(GG[row * 8 + h]), bt = BT[row * 8 + h], v = bf2f(Q[row * 3072 + 2048 + h * 128 + e]);
                const float* kp = kL + tk * 128 + dq * 32; const float* qp = qL + tk * 128 + dq * 32;
                float ks = 0.f;
#pragma unroll
                for (int i = 0; i < 32; ++i) ks += kp[i] * S[i];
                ks += __shfl_xor(ks, 16); ks += __shfl_xor(ks, 32);
                const float cc = bt * (v - eg * ks); float o = 0.f;
#pragma unroll
                for (int i = 0; i < 32; ++i) { S[i] = eg * S[i] + kp[i] * cc; o += qp[i] * S[i]; }
                o += __shfl_xor(o, 16); o += __shfl_xor(o, 32);
                if (dq == 0) O[row * 1024 + h * 128 + e] = o * 0.08838834764831845f;
            }
            __builtin_amdgcn_s_waitcnt(0); __builtin_amdgcn_wave_barrier();
        }
    }
}
__device__ void naive_gate(const Ctx& c, int layer, int split) {
    const float* O = (const float*)(c.R + R_TMP); const bf16_t* Z = (const bf16_t*)(c.R + R_ZS); const float* gn = c.gdn_norm + layer * 128;
    const int lane = threadIdx.x & 63, gw = (blockIdx.x * blockDim.x + threadIdx.x) >> 6, nw = (gridDim.x * blockDim.x) >> 6;
    for (int t = gw; t < MS * 8; t += nw) {
        const int r = t >> 3, h = t & 7; const size_t off = (size_t)r * 1024 + h * 128 + lane * 2;
        const float a = O[off], b = O[off + 1]; const float rs = rsqrtf(wave_sum(a * a + b * b) * (1.f / 128.f) + EPS);
        const unsigned z = *(const unsigned*)(Z + off);
        *(unsigned*)(c.OA + (size_t)split * MS * 1024 + off) = f2bf(a * rs * gn[lane * 2] * bf2f(z & 0xffffu)) | ((unsigned)f2bf(b * rs * gn[lane * 2 + 1] * bf2f(z >> 16)) << 16);
    }
}

__device__ void naive_dsa(const Ctx& c, int split, unsigned char* smem) {
    const bf16_t* QB = (const bf16_t*)(c.R + R_QB); const bf16_t* KB = (const bf16_t*)(c.R + R_KB); const bf16_t* VB = (const bf16_t*)(c.R + R_VB);
    const bf16_t* QI = (const bf16_t*)(c.R + R_QI); const bf16_t* KI = (const bf16_t*)(c.R + R_KI); const float* WI = (const float*)(c.R + R_WI);
    float* qi = (float*)smem; float* qf = qi + 512; float* sc = qf + 1024; float* scores = sc + 2048; unsigned* sel = (unsigned*)(scores + 4096); float* wi = (float*)(sel + 256); unsigned* cnt = (unsigned*)(wi + 8);
    const int tid = threadIdx.x, lane = tid & 63, wv = tid >> 6;
    for (int row = blockIdx.x; row < MS; row += gridDim.x) {
        const int t = row % SEQ, rb = row - t, n = t + 1;
        __syncthreads();
        qi[tid] = bf2f(QI[(size_t)row * 512 + tid]); qf[tid] = bf2f(QB[(size_t)row * 1024 + tid]); qf[tid + 512] = bf2f(QB[(size_t)row * 1024 + 512 + tid]);
        if (tid < 8) wi[tid] = WI[row * 8 + tid];
        if (tid == 0) { cnt[0] = 0; cnt[1] = 0; cnt[2] = 0; cnt[3] = 0; }
        __syncthreads();
        for (int s = tid; s < n; s += 512) {
            const uint4* kp = (const uint4*)(KI + (size_t)(rb + s) * 64);
            float acc = 0.f;
#pragma unroll 1
            for (int h = 0; h < 8; ++h) { float d = 0.f;
#pragma unroll 2
                for (int i = 0; i < 8; ++i) { const uint4 w = kp[i]; const float* qp = qi + h * 64 + i * 8;
                    d += qp[0] * bf2f(w.x & 0xffffu) + qp[1] * bf2f(w.x >> 16) + qp[2] * bf2f(w.y & 0xffffu) + qp[3] * bf2f(w.y >> 16)
                       + qp[4] * bf2f(w.z & 0xffffu) + qp[5] * bf2f(w.z >> 16) + qp[6] * bf2f(w.w & 0xffffu) + qp[7] * bf2f(w.w >> 16); }
                acc += wi[h] * fmaxf(d, 0.f); }
            scores[s] = acc + 0.f;
        }
        __syncthreads();
        int nsel;
        if (n <= TOPK) { for (int s = tid; s < n; s += 512) sel[s] = s; nsel = n; }
        else {
            unsigned T = 0;
            for (int bit = 31; bit >= 0; --bit) {
                const unsigned cand = T | (1u << bit); unsigned my = 0;
                for (int s = tid; s < n; s += 512) { unsigned u = __float_as_uint(scores[s]); u = (u & 0x80000000u) ? ~u : (u | 0x80000000u); my += (u >= cand) ? 1u : 0u; }
                my = (unsigned)wave_sum((float)my);
                if (lane == 0) atomicAdd(&cnt[1], my);
                __syncthreads();
                const unsigned tot = cnt[1];
                __syncthreads();
                if (tid == 0) cnt[1] = 0;
                if (tot >= (unsigned)TOPK) T = cand;
                __syncthreads();
            }
            unsigned mgt = 0, meq = 0;
            for (int s = tid; s < n; s += 512) { unsigned u = __float_as_uint(scores[s]); u = (u & 0x80000000u) ? ~u : (u | 0x80000000u); mgt += (u > T); meq += (u == T); }
            mgt = (unsigned)wave_sum((float)mgt); meq = (unsigned)wave_sum((float)meq);
            if (lane == 0) { atomicAdd(&cnt[2], mgt); atomicAdd(&cnt[3], meq); }
            __syncthreads();
            const unsigned cgt = cnt[2], ceq = cnt[3], need = TOPK - cgt;
            if (ceq == need) { for (int s = tid; s < n; s += 512) { unsigned u = __float_as_uint(scores[s]); u = (u & 0x80000000u) ? ~u : (u | 0x80000000u); if (u >= T) { const unsigned p = atomicAdd(&cnt[0], 1u); sel[p] = s; } } }
            else { for (int s = tid; s < n; s += 512) { unsigned u = __float_as_uint(scores[s]); u = (u & 0x80000000u) ? ~u : (u | 0x80000000u); if (u > T) { const unsigned p = atomicAdd(&cnt[0], 1u); sel[p] = s; } }
                   __syncthreads();
                   if (tid == 0) { unsigned p = cnt[0], left = need; for (int s = 0; s < n && left; ++s) { unsigned u = __float_as_uint(scores[s]); u = (u & 0x80000000u) ? ~u : (u | 0x80000000u); if (u == T) { sel[p++] = s; --left; } } } }
            nsel = TOPK;
        }
        __syncthreads();
        for (int p = tid; p < 8 * TOPK; p += 512) { const int h = p >> 8, j = p & 255;
            if (j < nsel) { const uint4* kp = (const uint4*)(KB + (size_t)(rb + sel[j]) * 1024 + h * 128); const float* qp = qf + h * 128; float d = 0.f;
#pragma unroll 4
                for (int i = 0; i < 16; ++i) { const uint4 w = kp[i]; d += qp[i * 8] * bf2f(w.x & 0xffffu) + qp[i * 8 + 1] * bf2f(w.x >> 16) + qp[i * 8 + 2] * bf2f(w.y & 0xffffu) + qp[i * 8 + 3] * bf2f(w.y >> 16)
                        + qp[i * 8 + 4] * bf2f(w.z & 0xffffu) + qp[i * 8 + 5] * bf2f(w.z >> 16) + qp[i * 8 + 6] * bf2f(w.w & 0xffffu) + qp[i * 8 + 7] * bf2f(w.w >> 16); }
                sc[h * 256 + j] = d * 0.08838834764831845f; } }
        __syncthreads();
        { float* sp = sc + wv * 256; float mx = -3.0e38f; for (int j = lane; j < nsel; j += 64) mx = fmaxf(mx, sp[j]); mx = wave_max(mx);
          float sm = 0.f; for (int j = lane; j < nsel; j += 64) { const float pz = __expf(sp[j] - mx); sp[j] = pz; sm += pz; } sm = wave_sum(sm); const float inv = 1.f / sm;
          for (int j = lane; j < nsel; j += 64) sp[j] *= inv; }
        __syncthreads();
        { const int o = tid * 2, h = o >> 7; const float* sp = sc + h * 256; float a0 = 0.f, a1 = 0.f;
          for (int j = 0; j < nsel; ++j) { const unsigned w = *(const unsigned*)(VB + (size_t)(rb + sel[j]) * 1024 + o); const float pz = sp[j]; a0 += pz * bf2f(w & 0xffffu); a1 += pz * bf2f(w >> 16); }
          *(unsigned*)(c.AT + ((size_t)split * MS + row) * 1024 + o) = f2bf(a0) | ((unsigned)f2bf(a1) << 16); }
    }
}

__global__ void __launch_bounds__(512, 2) fwd_kernel(Args a) {
    extern __shared__ __attribute__((aligned(16))) unsigned char smem[];
    cg::grid_group grid = cg::this_grid();
    Ctx c;
    c.x = a.in[0]; c.norm_mix = a.in[1]; c.w_in = a.in[2]; c.conv_w = a.in[3]; c.a_log = a.in[4]; c.dt_bias = a.in[5]; c.gdn_norm = a.in[6];
    c.w_out_gdn = a.in[7]; c.w_out_dsa = a.in[8]; c.w_o = a.in[9]; c.norm_ffn = a.in[10]; c.w_gate_up = a.in[11]; c.w_down = a.in[12]; c.norm_final = a.in[13];
    c.out = a.out; c.ws = a.ws; c.R = a.ws + WS_R;
    c.cosA = (float*)(a.ws + WS_TAB); c.sinA = c.cosA + SEQ * 64; c.cosI = c.sinA + SEQ * 64; c.sinI = c.cosI + SEQ * 32;
    c.XN = (bf16_t*)(a.ws + WS_XN); c.OA = (bf16_t*)(a.ws + WS_OA); c.AT = (bf16_t*)(a.ws + WS_AT);
    float* TMP = (float*)(c.R + R_TMP);
#define SYNC() grid.sync()
    phase_tables(c);
    phase_rmsnorm(c.x, c.norm_mix, c.XN, nullptr);
    SYNC();
#pragma unroll 1
    for (int layer = 0; layer < DEPTH; ++layer) {
        const float* w_in = c.w_in + (size_t)layer * DM * INC;
#pragma unroll 1
        for (int pc = 0; pc < 66; ++pc) {
            int type, k = 0, split = 0;
            if (pc < 30) { split = pc / 15; const int j = pc % 15; if (j < 10) { type = 0; k = split * 10 + j; } else type = j - 9; }
            else if (pc < 40) { type = 0; k = pc - 10; }
            else if (pc == 40) type = 6;
            else if (pc < 65) { type = 0; k = pc - 11; }
            else type = 7;
            if (type == 0) {
                NG g; EP e; int ng = 1; NG g2;
                g.A = c.XN; g.lda = DM; g.W = w_in; g.ldw = INC; g.col0 = 0; g.ncols = 1024; g.row0 = 0; g.nrows = MS; g.K = DM; g.T = TMP; g.ldt = 1024; g.tcol0 = 0;
                e.kind = E_V; e.nrows = MS; e.rowg0 = 0; e.p0 = 0; e.layer = layer; e.dst = nullptr; e.base = nullptr;
                if (k < 20) { const int sp = k / 10, j = k % 10; g.row0 = sp * MS; e.rowg0 = sp * MS;
                    if (j < 3) { g.col0 = C_QKVA + j * 1024; e.kind = E_QKVA; e.p0 = j; }
                    else if (j == 3) { g.col0 = C_Z; e.kind = E_Z; }
                    else if (j == 4) { g.col0 = C_A; g.ncols = 16; e.kind = E_AB; }
                    else if (j == 5) { g.col0 = C_QB; e.kind = E_ROPE; e.dst = (bf16_t*)(c.R + R_QB); }
                    else if (j == 6) { g.col0 = C_KB; e.kind = E_ROPE; e.dst = (bf16_t*)(c.R + R_KB); }
                    else if (j == 7) { g.col0 = C_VB; e.kind = E_V; e.dst = (bf16_t*)(c.R + R_VB); }
                    else if (j == 8) { g.col0 = C_QI; g.ncols = 512; e.kind = E_QI; }
                    else { g.col0 = C_KI; g.ncols = 72; e.kind = E_KIWI; } }
                else if (k < 24) { const int hf = (k - 20) >> 1, gg = (k - 20) & 1; g.row0 = hf * MS; e.rowg0 = hf * MS; g.col0 = C_GA + gg * 1024; e.kind = E_SG; e.p0 = gg; }
                else if (k < 28) { const int hf = (k - 24) >> 1, wh = (k - 24) & 1; g.row0 = hf * MS; e.rowg0 = hf * MS; g.A = wh ? c.AT : c.OA;
                    g.W = (wh ? c.w_out_dsa : c.w_out_gdn) + (size_t)layer * DM * DM; g.ldw = DM; e.kind = wh ? E_YB : E_YA; }
                else if (k < 30) { const int hf = k - 28; g.row0 = hf * MS; e.rowg0 = hf * MS; g.A = (const bf16_t*)(c.R + R_MG); g.W = c.w_o + (size_t)layer * DM * DM; g.ldw = DM; e.kind = E_WO; e.base = layer == 0 ? c.x : c.out; }
                else if (k < 52) { const int hf = (k - 30) / 11, fg = (k - 30) % 11; g.row0 = hf * MS; e.rowg0 = hf * MS; g.W = c.w_gate_up + (size_t)layer * DM * 2 * FF; g.ldw = 2 * FF; g.col0 = fg * 256; g.ncols = 256;
                    ng = 2; e.kind = E_SWIGLU; e.p0 = fg; }
                else { const int hf = k - 52; g.row0 = hf * MS; e.rowg0 = hf * MS; g.A = (const bf16_t*)(c.R + R_ACT); g.lda = FF; g.K = FF; g.W = c.w_down + (size_t)layer * FF * DM; g.ldw = DM; e.kind = E_DOWN; }
#pragma unroll 1
                for (int q = 0; q < ng; ++q) { if (q == 1) { g.col0 += FF; g.tcol0 = 256; } naive_gemm(g, smem); }
                SYNC();
                epi_phase(c, e);
            }
            else if (type == 1) naive_conv(c, layer);
            else if (type == 2) naive_l2norm(c);
            else if (type == 3) naive_scan(c, smem);
            else if (type == 4) naive_gate(c, layer, split);
            else if (type == 5) naive_dsa(c, split, smem);
            else if (type == 6) phase_rmsnorm(c.out, c.norm_ffn + layer * DM, c.XN, nullptr);
            else { if (layer + 1 < DEPTH) phase_rmsnorm(c.out, c.norm_mix + (layer + 1) * DM, c.XN, nullptr); else phase_rmsnorm(c.out, c.norm_final, nullptr, c.out); }
            SYNC();
        }
    }
}

extern "C" void kernel_launch(void* const* d_in, const int* in_sizes, int n_in, void* d_out, int out_size, void* d_ws, size_t ws_size, hipStream_t stream) {
    static int grid = 0;
    if (grid == 0) {
        if (n_in != 14 || out_size != M * DM || ws_size < WS_END) { fprintf(stderr, "kernel_launch: unexpected problem (n_in %d out %d ws %zu need %zu)\n", n_in, out_size, ws_size, (size_t)WS_END); grid = -1; return; }
        int dev = 0, cus = 0, per_cu = 0;
        hipGetDevice(&dev); hipDeviceGetAttribute(&cus, hipDeviceAttributeMultiprocessorCount, dev);
        hipFuncSetAttribute((const void*)fwd_kernel, hipFuncAttributeMaxDynamicSharedMemorySize, LDS_BYTES);
        hipOccupancyMaxActiveBlocksPerMultiprocessor(&per_cu, (const void*)fwd_kernel, 512, LDS_BYTES);
        if (per_cu < 1) { fprintf(stderr, "kernel_launch: occupancy query says %d blocks/CU\n", per_cu); grid = -1; return; }
        grid = cus;
        (void)hipGetLastError();
    }
    if (grid < 0) return;
    hipMemsetAsync((char*)d_ws + WS_CTL, 0, 1 * MiB, stream);
    Args a{};
    for (int i = 0; i < 14; ++i) a.in[i] = (const float*)d_in[i];
    a.out = (float*)d_out; a.ws = (unsigned char*)d_ws;
    void* args[] = {&a};
    hipError_t e = hipLaunchCooperativeKernel((const void*)fwd_kernel, dim3(grid), dim3(512), args, LDS_BYTES, stream);
    if (e != hipSuccess) fprintf(stderr, "cooperative launch failed: %s (grid %d)\n", hipGetErrorString(e), grid);
}
```

```cpp
#include <hip/hip_runtime.h>
#include <hip/hip_cooperative_groups.h>
#include <cstdio>
#include <cstdint>
namespace cg = cooperative_groups;

typedef unsigned short bf16_t;
typedef float f32x4 __attribute__((ext_vector_type(4)));

constexpr int BATCH = 4, SEQ = 4096, DM = 1024, M = BATCH * SEQ, DEPTH = 2;
constexpr int GH = 8, GD = 128, CONVK = 4, CH = 64;
constexpr int AH = 8, AD = 128, IH = 8, ID = 64, TOPK = 256;
constexpr int FF = 2816, INC = 9816;
constexpr int NSPLIT = 2, MS = M / NSPLIT, BPS = BATCH / NSPLIT;
constexpr float EPS = 1e-6f;
constexpr int C_QKVA = 0, C_Z = 3072, C_A = 4096, C_B = 4104, C_QB = 4112, C_KB = 5136, C_VB = 6160, C_QI = 7184, C_KI = 7696, C_WI = 7760, C_GA = 7768, C_GB = 8792;

constexpr size_t MiB = 1u << 20;
constexpr size_t WS_CTL = 0;
constexpr size_t WS_WT = 1 * MiB;
constexpr size_t WS_TAB = 43 * MiB;
constexpr size_t WS_XN = 46 * MiB;
constexpr size_t WS_OA = 78 * MiB;
constexpr size_t WS_AT = 110 * MiB;
constexpr size_t WS_R = 142 * MiB;
constexpr size_t R_QKVA = 0, R_ZS = 48 * MiB, R_QB = 64 * MiB, R_KB = 80 * MiB, R_VB = 96 * MiB, R_QI = 112 * MiB, R_KI = 120 * MiB;
constexpr size_t R_WI = 121 * MiB, R_GG = R_WI + 256 * 1024, R_BETA = R_GG + 256 * 1024, R_HALO = 122 * MiB;
constexpr size_t R_P2 = 124 * MiB + 256 * 1024;
constexpr size_t R_TMP = R_P2;
constexpr size_t R_SG = 0, R_M1 = 64 * MiB, R_MG = R_M1;
constexpr size_t R_ACT = 0;
constexpr size_t WS_END = WS_R + R_P2 + 32 * MiB;
static_assert(WS_END <= 321650688ull, "workspace map exceeds the guaranteed d_ws size");
constexpr int LDS_BYTES = 147456;

struct Args { const float* in[14]; float* out; unsigned char* ws; };

__device__ __forceinline__ int otid() { int t = threadIdx.x; asm volatile("" : "+v"(t)); return t; }
__device__ __forceinline__ float bf2f(unsigned v) { return __uint_as_float(v << 16); }
__device__ __forceinline__ bf16_t f2bf(float f) { unsigned u = __float_as_uint(f); u += 0x7fffu + ((u >> 16) & 1u); return (bf16_t)(u >> 16); }
__device__ __forceinline__ float sigmoidf_(float x) { return 1.f / (1.f + __expf(-x)); }
__device__ __forceinline__ float siluf_(float x) { return x / (1.f + __expf(-x)); }
__device__ __forceinline__ float softplusf_(float x) { return fmaxf(x, 0.f) + log1pf(__expf(-fabsf(x))); }
__device__ __forceinline__ float wave_sum(float v) {
#pragma unroll
    for (int o = 1; o < 64; o <<= 1) v += __shfl_xor(v, o);
    return v;
}
__device__ __forceinline__ float wave_max(float v) {
#pragma unroll
    for (int o = 1; o < 64; o <<= 1) v = fmaxf(v, __shfl_xor(v, o));
    return v;
}

struct Ctx {
    const float* x; const float* norm_mix; const float* w_in; const float* conv_w; const float* a_log; const float* dt_bias; const float* gdn_norm;
    const float* w_out_gdn; const float* w_out_dsa; const float* w_o; const float* norm_ffn; const float* w_gate_up; const float* w_down; const float* norm_final;
    float* out; unsigned char* ws; unsigned char* R;
    float *cosA, *sinA, *cosI, *sinI;
    bf16_t *XN, *OA, *AT;
};

__device__ const double ROPE_INVF[64] = {1.0, 0.8659643233600653, 0.7498942093324559, 0.6493816315762113, 0.5623413251903491, 0.4869675251658631, 0.4216965034285822, 0.3651741272548377, 0.31622776601683794, 0.27384196342643613, 0.23713737056616552, 0.2053525026457146, 0.1778279410038923, 0.1539926526059492, 0.1333521432163324, 0.11547819846894582, 0.1, 0.08659643233600653, 0.07498942093324558, 0.06493816315762113, 0.05623413251903491, 0.04869675251658631, 0.042169650342858224, 0.03651741272548377, 0.03162277660168379, 0.027384196342643614, 0.023713737056616554, 0.02053525026457146, 0.01778279410038923, 0.01539926526059492, 0.01333521432163324, 0.011547819846894581, 0.01, 0.008659643233600654, 0.007498942093324558, 0.006493816315762113, 0.005623413251903491, 0.004869675251658631, 0.004216965034285823, 0.003651741272548377, 0.0031622776601683794, 0.0027384196342643613, 0.0023713737056616554, 0.002053525026457146, 0.0017782794100389228, 0.001539926526059492, 0.001333521432163324, 0.0011547819846894581, 0.001, 0.0008659643233600654, 0.0007498942093324559, 0.0006493816315762113, 0.0005623413251903491, 0.0004869675251658631, 0.00042169650342858224, 0.0003651741272548377, 0.00031622776601683794, 0.0002738419634264361, 0.00023713737056616554, 0.0002053525026457146, 0.00017782794100389227, 0.0001539926526059492, 0.0001333521432163324, 0.00011547819846894582};
__device__ __forceinline__ void rope_cs(int t, double invf, float& cs, float& sn) {
    const double ang = (double)t * invf; const double k = rint(ang * 0.15915494309189535); const float r = (float)(ang - k * 6.283185307179586);
    cs = cosf(r); sn = sinf(r);
}
__device__ void phase_tables(const Ctx& c) {
    const int gt = blockIdx.x * blockDim.x + otid(), nt = gridDim.x * blockDim.x;
    for (int i = gt; i < SEQ * 64; i += nt) { const int t = i >> 6, d = i & 63; float cs, sn; rope_cs(t, ROPE_INVF[d], cs, sn); c.cosA[i] = cs; c.sinA[i] = sn; }
    for (int i = gt; i < SEQ * 32; i += nt) { const int t = i >> 5, d = i & 31; float cs, sn; rope_cs(t, ROPE_INVF[2 * d], cs, sn); c.cosI[i] = cs; c.sinI[i] = sn; }
}

__device__ void phase_rmsnorm(const float* src, const float* gain, bf16_t* dst_bf, float* dst_f) {
    const int lane = otid() & 63, gw = (blockIdx.x * blockDim.x + otid()) >> 6, nw = (gridDim.x * blockDim.x) >> 6;
    for (int r = gw; r < M; r += nw) {
        const f32x4* xr = (const f32x4*)(src + (size_t)r * DM) + lane;
        f32x4 v[4]; float s = 0.f;
#pragma unroll
        for (int j = 0; j < 4; ++j) { v[j] = xr[64 * j]; s += v[j].x * v[j].x + v[j].y * v[j].y + v[j].z * v[j].z + v[j].w * v[j].w; }
        const float rs = rsqrtf(wave_sum(s) * (1.f / DM) + EPS);
#pragma unroll
        for (int j = 0; j < 4; ++j) {
            const f32x4 g = ((const f32x4*)gain)[lane + 64 * j]; const f32x4 o = v[j] * rs * g;
            if (dst_bf) { uint2 w; w.x = f2bf(o.x) | ((unsigned)f2bf(o.y) << 16); w.y = f2bf(o.z) | ((unsigned)f2bf(o.w) << 16); ((uint2*)(dst_bf + (size_t)r * DM))[lane + 64 * j] = w; }
            else ((f32x4*)(dst_f + (size_t)r * DM))[lane + 64 * j] = o;
        }
    }
}

struct NG { const bf16_t* A; int lda; const float* W; int ldw; int col0; int ncols; int row0; int nrows; int K; float* T; int ldt; int tcol0; };
__device__ void naive_gemm(const NG& g, unsigned char* smem) {
    float* As = (float*)smem; float* Bs = As + 16 * 132;
    const int tid = otid(), ty = tid >> 4, tx = tid & 15;
    const int ntr = g.nrows / 128, ntc = (g.ncols + 63) / 64;
    for (int u = blockIdx.x; u < ntr * ntc; u += gridDim.x) {
        const int tr = u % ntr, tc = u / ntr, r0 = tr * 128, c0 = tc * 64;
        float acc[4][4];
#pragma unroll
        for (int i = 0; i < 4; ++i)
#pragma unroll
            for (int j = 0; j < 4; ++j) acc[i][j] = 0.f;
        for (int k0 = 0; k0 < g.K; k0 += 16) {
            { const int row = tid >> 2, kq = (tid & 3) * 4;
              const uint2 raw = *(const uint2*)(g.A + (size_t)(g.row0 + r0 + row) * g.lda + k0 + kq);
              As[(kq + 0) * 132 + row] = bf2f(raw.x & 0xffffu); As[(kq + 1) * 132 + row] = bf2f(raw.x >> 16);
              As[(kq + 2) * 132 + row] = bf2f(raw.y & 0xffffu); As[(kq + 3) * 132 + row] = bf2f(raw.y >> 16); }
            { const int k = tid >> 5, cc = (tid & 31) * 2;
              const float* wp = g.W + (size_t)(k0 + k) * g.ldw + g.col0 + c0 + cc;
              Bs[k * 68 + cc] = (c0 + cc < g.ncols) ? wp[0] : 0.f; Bs[k * 68 + cc + 1] = (c0 + cc + 1 < g.ncols) ? wp[1] : 0.f; }
            __syncthreads();
#pragma unroll
            for (int kk = 0; kk < 16; ++kk) {
                const f32x4 a = *(const f32x4*)&As[kk * 132 + ty * 4]; const f32x4 b = *(const f32x4*)&Bs[kk * 68 + tx * 4];
#pragma unroll
                for (int i = 0; i < 4; ++i)
#pragma unroll
                    for (int j = 0; j < 4; ++j) acc[i][j] += a[i] * b[j];
            }
            __syncthreads();
        }
#pragma unroll
        for (int i = 0; i < 4; ++i)
#pragma unroll
            for (int j = 0; j < 4; ++j) { const int cc = c0 + tx * 4 + j; if (cc < g.ncols) g.T[(size_t)(r0 + ty * 4 + i) * g.ldt + g.tcol0 + cc] = acc[i][j]; }
    }
}

enum { E_QKVA, E_Z, E_AB, E_ROPE, E_V, E_QI, E_KIWI, E_SG, E_YA, E_YB, E_WO, E_SWIGLU, E_DOWN };
struct EP { int kind; int nrows; int rowg0; int p0; int layer; bf16_t* dst; const float* base; };
__device__ void epi_phase(const Ctx& c, const EP& e) {
    const float* T = (const float*)(c.R + R_TMP);
    const int gt = blockIdx.x * blockDim.x + otid(), nt = gridDim.x * blockDim.x;
    int W;
    switch (e.kind) { case E_QKVA: case E_Z: case E_V: case E_SG: case E_YA: case E_YB: case E_WO: case E_DOWN: W = 1024; break;
        case E_AB: W = 16; break; case E_ROPE: W = 512; break; case E_QI: W = 256; break; case E_KIWI: W = 40; break; default: W = 256; break; }
    const long total = (long)e.nrows * W;
    for (long idx = gt; idx < total; idx += nt) {
        const int r = (int)(idx / W), j = (int)(idx % W);
        const int rowg = e.rowg0 + r, rs = rowg % MS, pos = rowg % SEQ;
        const float* Tr = T + (size_t)r * 1024;
        switch (e.kind) {
        case E_QKVA: { const int col = e.p0 * 1024 + j; const bf16_t v = f2bf(Tr[j]); ((bf16_t*)(c.R + R_QKVA))[(size_t)rs * 3072 + col] = v;
                       if ((rs & 63) >= 61) ((bf16_t*)(c.R + R_HALO))[((size_t)(rs >> 6) * 3 + ((rs & 63) - 61)) * 3072 + col] = v; } break;
        case E_Z: ((bf16_t*)(c.R + R_ZS))[(size_t)rs * 1024 + j] = f2bf(siluf_(Tr[j])); break;
        case E_AB: { const int h = j & 7;
                     if (j < 8) ((float*)(c.R + R_GG))[rs * 8 + h] = -__expf(c.a_log[e.layer * 8 + h]) * softplusf_(Tr[j] + c.dt_bias[e.layer * 8 + h]);
                     else ((float*)(c.R + R_BETA))[rs * 8 + h] = sigmoidf_(Tr[j]); } break;
        case E_ROPE: { const int h = j >> 6, d = j & 63; const float x1 = Tr[h * 128 + d], x2 = Tr[h * 128 + 64 + d], cs = c.cosA[pos * 64 + d], sn = c.sinA[pos * 64 + d];
                       bf16_t* dst = e.dst + (size_t)rs * 1024 + h * 128 + d; dst[0] = f2bf(x1 * cs - x2 * sn); dst[64] = f2bf(x2 * cs + x1 * sn); } break;
        case E_V: e.dst[(size_t)rs * 1024 + j] = f2bf(Tr[j]); break;
        case E_QI: { const int h = j >> 5, d = j & 31; const float x1 = Tr[h * 64 + d], x2 = Tr[h * 64 + 32 + d], cs = c.cosI[pos * 32 + d], sn = c.sinI[pos * 32 + d];
                     bf16_t* dst = (bf16_t*)(c.R + R_QI) + (size_t)rs * 512 + h * 64 + d; dst[0] = f2bf(x1 * cs - x2 * sn); dst[32] = f2bf(x2 * cs + x1 * sn); } break;
        case E_KIWI: { if (j < 32) { const int d = j; const float x1 = Tr[d], x2 = Tr[32 + d], cs = c.cosI[pos * 32 + d], sn = c.sinI[pos * 32 + d];
                           bf16_t* dst = (bf16_t*)(c.R + R_KI) + (size_t)rs * 64 + d; dst[0] = f2bf((x1 * cs - x2 * sn) * 0.125f); dst[32] = f2bf((x2 * cs + x1 * sn) * 0.125f); }
                       else ((float*)(c.R + R_WI))[rs * 8 + (j - 32)] = Tr[64 + (j - 32)] * 0.35355339059327373f; } break;
        case E_SG: ((bf16_t*)(c.R + R_SG))[(size_t)rowg * 2048 + e.p0 * 1024 + j] = f2bf(sigmoidf_(Tr[j])); break;
        case E_YA: ((bf16_t*)(c.R + R_M1))[(size_t)rowg * 1024 + j] = f2bf(bf2f(((const bf16_t*)(c.R + R_SG))[(size_t)rowg * 2048 + j]) * Tr[j]); break;
        case E_YB: ((bf16_t*)(c.R + R_MG))[(size_t)rowg * 1024 + j] = f2bf(bf2f(((const bf16_t*)(c.R + R_M1))[(size_t)rowg * 1024 + j]) + bf2f(((const bf16_t*)(c.R + R_SG))[(size_t)rowg * 2048 + 1024 + j]) * Tr[j]); break;
        case E_WO: c.out[(size_t)rowg * 1024 + j] = e.base[(size_t)rowg * 1024 + j] + Tr[j]; break;
        case E_SWIGLU: ((bf16_t*)(c.R + R_ACT))[(size_t)rowg * FF + e.p0 * 256 + j] = f2bf(siluf_(Tr[j]) * Tr[256 + j]); break;
        case E_DOWN: c.out[(size_t)rowg * 1024 + j] += Tr[j]; break;
        }
    }
}

__device__ void naive_conv(const Ctx& c, int layer) {
    bf16_t* Q = (bf16_t*)(c.R + R_QKVA); const bf16_t* H = (const bf16_t*)(c.R + R_HALO); const float* cw = c.conv_w + (size_t)layer * 4 * 3072;
    const int gt = blockIdx.x * blockDim.x + otid(), nt = gridDim.x * blockDim.x;
    for (int idx = gt; idx < (MS / 64) * 3072; idx += nt) {
        const int ch = idx % 3072, ck = idx / 3072;
        const float w0 = cw[ch], w1 = cw[3072 + ch], w2 = cw[2 * 3072 + ch], w3 = cw[3 * 3072 + ch];
        float x3 = 0.f, x2 = 0.f, x1 = 0.f;
        if ((ck * 64) % SEQ != 0) { const bf16_t* hp = H + (size_t)(ck - 1) * 3 * 3072 + ch; x3 = bf2f(hp[0]); x2 = bf2f(hp[3072]); x1 = bf2f(hp[2 * 3072]); }
        bf16_t* p = Q + (size_t)ck * 64 * 3072 + ch;
        for (int r = 0; r < 64; ++r) { const float xv = bf2f(p[(size_t)r * 3072]); const float y = w0 * x3 + w1 * x2 + w2 * x1 + w3 * xv; p[(size_t)r * 3072] = f2bf(siluf_(y)); x3 = x2; x2 = x1; x1 = xv; }
    }
}
__device__ void naive_l2norm(const Ctx& c) {
    bf16_t* Q = (bf16_t*)(c.R + R_QKVA);
    const int lane = otid() & 63, gw = (blockIdx.x * blockDim.x + otid()) >> 6, nw = (gridDim.x * blockDim.x) >> 6;
    for (int t = gw; t < MS * 16; t += nw) {
        const int r = t >> 4, hh = t & 15;
        unsigned* p = (unsigned*)(Q + (size_t)r * 3072 + hh * 128) + lane; const unsigned raw = *p;
        const float a = bf2f(raw & 0xffffu), b = bf2f(raw >> 16); const float rs = rsqrtf(wave_sum(a * a + b * b) + EPS);
        *p = f2bf(a * rs) | ((unsigned)f2bf(b * rs) << 16);
    }
}
__device__ void naive_scan(const Ctx& c, unsigned char* smem) {
    const bf16_t* Q = (const bf16_t*)(c.R + R_QKVA); const float* GG = (const float*)(c.R + R_GG); const float* BT = (const float*)(c.R + R_BETA); float* O = (float*)(c.R + R_TMP);
    const int lane = otid() & 63, wv = otid() >> 6, gw = blockIdx.x * 8 + wv, nw = gridDim.x * 8;
    float* kL = (float*)smem + wv * 4096; float* qL = kL + 2048;
    const int dq = lane >> 4, el = lane & 15;
    for (int task = gw; task < BPS * 8 * 8; task += nw) {
        const int eb = task & 7, h = (task >> 3) & 7, bl = task >> 6, e = eb * 16 + el;
        float S[32];
#pragma unroll
        for (int i = 0; i < 32; ++i) S[i] = 0.f;
        for (int t0 = 0; t0 < SEQ; t0 += 16) {
            for (int tk = 0; tk < 16; ++tk) { const size_t row = (size_t)bl * SEQ + t0 + tk;
                const unsigned qr = *((const unsigned*)(Q + row * 3072 + h * 128) + lane), kr = *((const unsigned*)(Q + row * 3072 + 1024 + h * 128) + lane);
                qL[tk * 128 + lane * 2] = bf2f(qr & 0xffffu); qL[tk * 128 + lane * 2 + 1] = bf2f(qr >> 16); kL[tk * 128 + lane * 2] = bf2f(kr & 0xffffu); kL[tk * 128 + lane * 2 + 1] = bf2f(kr >> 16); }
            __builtin_amdgcn_s_waitcnt(0); __builtin_amdgcn_wave_barrier();
            for (int tk = 0; tk < 16; ++tk) { const size_t row = (size_t)bl * SEQ + t0 + tk;
                const float eg = __expf(GG[row * 8 + h]), bt = BT[row * 8 + h], v = bf2f(Q[row * 3072 + 2048 + h * 128 + e]);
                const float* kp = kL + tk * 128 + dq * 32; const float* qp = qL + tk * 128 + dq * 32;
                float ks = 0.f;
#pragma unroll
                for (int i = 0; i < 32; ++i) ks += kp[i] * S[i];
                ks += __shfl_xor(ks, 16); ks += __shfl_xor(ks, 32);
                const float cc = bt * (v - eg * ks); float o = 0.f;
#pragma unroll
                for (int i = 0; i < 32; ++i) { S[i] = eg * S[i] + kp[i] * cc; o += qp[i] * S[i]; }
                o += __shfl_xor(o, 16); o += __shfl_xor(o, 32);
                if (dq == 0) O[row * 1024 + h * 128 + e] = o * 0.08838834764831845f;
            }
            __builtin_amdgcn_s_waitcnt(0); __builtin_amdgcn_wave_barrier();
        }
    }
}
__device__ void naive_gate(const Ctx& c, int layer, int split) {
    const float* O = (const float*)(c.R + R_TMP); const bf16_t* Z = (const bf16_t*)(c.R + R_ZS); const float* gn = c.gdn_norm + layer * 128;
    const int lane = otid() & 63, gw = (blockIdx.x * blockDim.x + otid()) >> 6, nw = (gridDim.x * blockDim.x) >> 6;
    for (int t = gw; t < MS * 8; t += nw) {
        const int r = t >> 3, h = t & 7; const size_t off = (size_t)r * 1024 + h * 128 + lane * 2;
        const float a = O[off], b = O[off + 1]; const float rs = rsqrtf(wave_sum(a * a + b * b) * (1.f / 128.f) + EPS);
        const unsigned z = *(const unsigned*)(Z + off);
        *(unsigned*)(c.OA + (size_t)split * MS * 1024 + off) = f2bf(a * rs * gn[lane * 2] * bf2f(z & 0xffffu)) | ((unsigned)f2bf(b * rs * gn[lane * 2 + 1] * bf2f(z >> 16)) << 16);
    }
}

__device__ void naive_dsa(const Ctx& c, int split, unsigned char* smem) {
    const bf16_t* QB = (const bf16_t*)(c.R + R_QB); const bf16_t* KB = (const bf16_t*)(c.R + R_KB); const bf16_t* VB = (const bf16_t*)(c.R + R_VB);
    const bf16_t* QI = (const bf16_t*)(c.R + R_QI); const bf16_t* KI = (const bf16_t*)(c.R + R_KI); const float* WI = (const float*)(c.R + R_WI);
    float* qi = (float*)smem; float* qf = qi + 512; float* sc = qf + 1024; float* scores = sc + 2048; unsigned* sel = (unsigned*)(scores + 4096); float* wi = (float*)(sel + 256); unsigned* cnt = (unsigned*)(wi + 8);
    const int tid = otid(), lane = tid & 63, wv = tid >> 6;
    for (int row = blockIdx.x; row < MS; row += gridDim.x) {
        const int t = row % SEQ, rb = row - t, n = t + 1;
        __syncthreads();
        qi[tid] = bf2f(QI[(size_t)row * 512 + tid]); qf[tid] = bf2f(QB[(size_t)row * 1024 + tid]); qf[tid + 512] = bf2f(QB[(size_t)row * 1024 + 512 + tid]);
        if (tid < 8) wi[tid] = WI[row * 8 + tid];
        if (tid == 0) { cnt[0] = 0; cnt[1] = 0; cnt[2] = 0; cnt[3] = 0; }
        __syncthreads();
        for (int s = tid; s < n; s += 512) {
            const uint4* kp = (const uint4*)(KI + (size_t)(rb + s) * 64);
            float acc = 0.f;
#pragma unroll 1
            for (int h = 0; h < 8; ++h) { float d = 0.f;
#pragma unroll 2
                for (int i = 0; i < 8; ++i) { const uint4 w = kp[i]; const float* qp = qi + h * 64 + i * 8;
                    d += qp[0] * bf2f(w.x & 0xffffu) + qp[1] * bf2f(w.x >> 16) + qp[2] * bf2f(w.y & 0xffffu) + qp[3] * bf2f(w.y >> 16)
                       + qp[4] * bf2f(w.z & 0xffffu) + qp[5] * bf2f(w.z >> 16) + qp[6] * bf2f(w.w & 0xffffu) + qp[7] * bf2f(w.w >> 16); }
                acc += wi[h] * fmaxf(d, 0.f); }
            scores[s] = acc + 0.f;
        }
        __syncthreads();
        int nsel;
        if (n <= TOPK) { for (int s = tid; s < n; s += 512) sel[s] = s; nsel = n; }
        else {
            unsigned T = 0;
            for (int bit = 31; bit >= 0; --bit) {
                const unsigned cand = T | (1u << bit); unsigned my = 0;
                for (int s = tid; s < n; s += 512) { unsigned u = __float_as_uint(scores[s]); u = (u & 0x80000000u) ? ~u : (u | 0x80000000u); my += (u >= cand) ? 1u : 0u; }
                my = (unsigned)wave_sum((float)my);
                if (lane == 0) atomicAdd(&cnt[1], my);
                __syncthreads();
                const unsigned tot = cnt[1];
                __syncthreads();
                if (tid == 0) cnt[1] = 0;
                if (tot >= (unsigned)TOPK) T = cand;
                __syncthreads();
            }
            unsigned mgt = 0, meq = 0;
            for (int s = tid; s < n; s += 512) { unsigned u = __float_as_uint(scores[s]); u = (u & 0x80000000u) ? ~u : (u | 0x80000000u); mgt += (u > T); meq += (u == T); }
            mgt = (unsigned)wave_sum((float)mgt); meq = (unsigned)wave_sum((float)meq);
            if (lane == 0) { atomicAdd(&cnt[2], mgt); atomicAdd(&cnt[3], meq); }
            __syncthreads();
            const unsigned cgt = cnt[2], ceq = cnt[3], need = TOPK - cgt;
            if (ceq == need) { for (int s = tid; s < n; s += 512) { unsigned u = __float_as_uint(scores[s]); u = (u & 0x80000000u) ? ~u : (u | 0x80000000u); if (u >= T) { const unsigned p = atomicAdd(&cnt[0], 1u); sel[p] = s; } } }
            else { for (int s = tid; s < n; s += 512) { unsigned u = __float_as_uint(scores[s]); u = (u & 0x80000000u) ? ~u : (u | 0x80000000u); if (u > T) { const unsigned p = atomicAdd(&cnt[0], 1u); sel[p] = s; } }
                   __syncthreads();
                   if (tid == 0) { unsigned p = cnt[0], left = need; for (int s = 0; s < n && left; ++s) { unsigned u = __float_as_uint(scores[s]); u = (u & 0x80000000u) ? ~u : (u | 0x80000000u); if (u == T) { sel[p++] = s; --left; } } } }
            nsel = TOPK;
        }
        __syncthreads();
        for (int p = tid; p < 8 * TOPK; p += 512) { const int h = p >> 8, j = p & 255;
            if (j < nsel) { const uint4* kp = (const uint4*)(KB + (size_t)(rb + sel[j]) * 1024 + h * 128); const float* qp = qf + h * 128; float d = 0.f;
#pragma unroll 4
                for (int i = 0; i < 16; ++i) { const uint4 w = kp[i]; d += qp[i * 8] * bf2f(w.x & 0xffffu) + qp[i * 8 + 1] * bf2f(w.x >> 16) + qp[i * 8 + 2] * bf2f(w.y & 0xffffu) + qp[i * 8 + 3] * bf2f(w.y >> 16)
                        + qp[i * 8 + 4] * bf2f(w.z & 0xffffu) + qp[i * 8 + 5] * bf2f(w.z >> 16) + qp[i * 8 + 6] * bf2f(w.w & 0xffffu) + qp[i * 8 + 7] * bf2f(w.w >> 16); }
                sc[h * 256 + j] = d * 0.08838834764831845f; } }
        __syncthreads();
        { float* sp = sc + wv * 256; float mx = -3.0e38f; for (int j = lane; j < nsel; j += 64) mx = fmaxf(mx, sp[j]); mx = wave_max(mx);
          float sm = 0.f; for (int j = lane; j < nsel; j += 64) { const float pz = __expf(sp[j] - mx); sp[j] = pz; sm += pz; } sm = wave_sum(sm); const float inv = 1.f / sm;
          for (int j = lane; j < nsel; j += 64) sp[j] *= inv; }
        __syncthreads();
        { const int o = tid * 2, h = o >> 7; const float* sp = sc + h * 256; float a0 = 0.f, a1 = 0.f;
          for (int j = 0; j < nsel; ++j) { const unsigned w = *(const unsigned*)(VB + (size_t)(rb + sel[j]) * 1024 + o); const float pz = sp[j]; a0 += pz * bf2f(w & 0xffffu); a1 += pz * bf2f(w >> 16); }
          *(unsigned*)(c.AT + ((size_t)split * MS + row) * 1024 + o) = f2bf(a0) | ((unsigned)f2bf(a1) << 16); }
    }
}

namespace pg8 {
#define PG8_LAS __attribute__((address_space(3)))
typedef unsigned short bf16_t;
typedef short bf16x8 __attribute__((ext_vector_type(8)));
typedef float f32x4 __attribute__((ext_vector_type(4)));
typedef unsigned u32x4 __attribute__((ext_vector_type(4)));
constexpr int BM = 256, BK = 64, HALF = 128, HTB = HALF * BK * 2  , STAGE_BYTES = 8 * HTB, NXCD = 8, WGM = 8;

__host__ __device__ __forceinline__ int lds_byte(int r, int c) { const int st = (r >> 4) * 2 + (c >> 5), rr = r & 15, cc = c & 31, ob = rr * 64 + cc * 2; return st * 1024 + (ob ^ (((ob >> 9) & 1) << 5)); }
__host__ __device__ __forceinline__ void stage_rc(int b, int& R, int& C) { const int st = b / 1024, sb = b % 1024, swz = sb ^ (((sb >> 9) & 1) << 5); R = (st >> 1) * 16 + swz / 64; C = (st & 1) * 32 + (swz % 64) / 2; }
__host__ __device__ __forceinline__ int perm32(int rho) { const int n = rho >> 4, i = rho & 15; return 8 * (i >> 2) + 4 * n + (i & 3); }

struct Unit { int pm, pn; };
struct Gemm { const bf16_t* A; const bf16_t* Bt; int M, N, K; };

struct StaticOrder {
    int nM, nN, nwg, G, c;
    __host__ __device__ void init(int M, int N, int G_, int c_) { nM = M / BM; nN = N / BM; nwg = nM * nN; G = G_; c = c_; }
    __host__ __device__ bool next(int i, Unit& u) const {
        const long L = (long)i * G + c; if (L >= nwg) return false;
        int wgid = (int)L; { const int q = nwg / NXCD, r = nwg % NXCD, xcd = wgid % NXCD, off = wgid / NXCD; wgid = (xcd < r ? xcd * (q + 1) : r * (q + 1) + (xcd - r) * q) + off; }
        const int nig = WGM * nN, gid = wgid / nig, fm = gid * WGM, gsz = (nM - fm) < WGM ? (nM - fm) : WGM;
        u.pm = fm + ((wgid % nig) % gsz); u.pn = (wgid % nig) / gsz; return true;
    }
    __device__ __forceinline__ void a_ready(const Unit&) const {}
    __device__ __forceinline__ void done(const Unit&) const {}
};


__device__ __forceinline__ unsigned cvt_pk_bf16(float lo, float hi) { unsigned r; asm volatile("v_cvt_pk_bf16_f32 %0, %1, %2" : "=v"(r) : "v"(lo), "v"(hi)); return r; }

template <class Epi, class Sched, bool ALIGN_EPI = false, bool SP2 = false>
__device__ __forceinline__ void gemm_phase(PG8_LAS unsigned char* lds, const Gemm g, const Sched& S, const Epi& E) {
    const int tid = otid(), wid = __builtin_amdgcn_readfirstlane(tid >> 6), lane = tid & 63, wr = wid >> 2, wc = wid & 3, fr = lane & 15, fq = lane >> 4;
    const int K = g.K, nt = K / BK;
    unsigned voffA[2], voffB[2];
#pragma unroll
    for (int i = 0; i < 2; ++i) { int R, C; stage_rc(tid * 16 + i * 8192, R, C); const int Rb = Epi::PERM ? ((R & ~31) + perm32(R & 31)) : R;
        voffA[i] = (unsigned)(R * K + C) * 2u; voffB[i] = (unsigned)(Rb * K + C) * 2u; }
    const size_t kstep = (size_t)(BK * 2);
    const size_t hstep = (size_t)HALF * K * 2;
    const size_t tstep = 2 * hstep;
    const unsigned ldsw = (unsigned)wid * 1024u;
    const int aoff = lds_byte(wr * 64 + fr, fq * 8), boff = lds_byte(wc * 32 + fr, fq * 8);
#define PG8_SA(b, h) (((b) * 2 + (h)) * HTB)
#define PG8_SB(b, h) ((4 + (b) * 2 + (h)) * HTB)
#define PG8_STAGE(bufoff, gbase, voff) do { _Pragma("unroll") for (int _i = 0; _i < 2; ++_i) \
        __builtin_amdgcn_global_load_lds((const unsigned*)((const char*)(gbase) + (voff)[_i]), (PG8_LAS unsigned*)(lds + (bufoff) + ldsw + _i * 8192), 16, 0, 0); } while (0)
#define PG8_LDA(dst, b, h) do { _Pragma("unroll") for (int m = 0; m < 4; ++m) _Pragma("unroll") for (int k = 0; k < 2; ++k) dst[m][k] = *(const PG8_LAS bf16x8*)(lds + PG8_SA(b, h) + aoff + m * 2048 + k * 1024); } while (0)
#define PG8_LDB(dst, b, h) do { _Pragma("unroll") for (int n = 0; n < 2; ++n) _Pragma("unroll") for (int k = 0; k < 2; ++k) dst[n][k] = *(const PG8_LAS bf16x8*)(lds + PG8_SB(b, h) + boff + n * 2048 + k * 1024); } while (0)
#define PG8_MMA(ai, bj, At, Bt) do { __builtin_amdgcn_s_setprio(1); _Pragma("unroll") for (int m = 0; m < 4; ++m) _Pragma("unroll") for (int n = 0; n < 2; ++n) _Pragma("unroll") for (int k = 0; k < 2; ++k) \
        acc[ai][bj][m][n] = __builtin_amdgcn_mfma_f32_16x16x32_bf16(Bt[n][k], At[m][k], acc[ai][bj][m][n], 0, 0, 0); __builtin_amdgcn_s_setprio(0); } while (0)
#define PG8_WAIT_V(n) asm volatile("s_waitcnt vmcnt(" #n ")" ::: "memory")
#define PG8_WAIT_L(n) asm volatile("s_waitcnt lgkmcnt(" #n ")" ::: "memory")
#define PG8_BAR __builtin_amdgcn_s_barrier()
#define PG8_SCHED __builtin_amdgcn_sched_barrier(0)
    Unit cur, nxt; int ui = 0;
    if (!S.next(0, cur)) return;
    f32x4 acc[2][2][4][2];
#pragma unroll
    for (int a = 0; a < 2; ++a)
#pragma unroll
        for (int b = 0; b < 2; ++b)
#pragma unroll
            for (int m = 0; m < 4; ++m)
#pragma unroll
                for (int n = 0; n < 2; ++n) acc[a][b][m][n] = (f32x4){0.f, 0.f, 0.f, 0.f};
    bf16x8 At[4][2], B0[2][2], B1[2][2];
    const char* cA = (const char*)g.A + (size_t)cur.pm * tstep; const char* cB = (const char*)g.Bt + (size_t)cur.pn * tstep;
    S.a_ready(cur);
    if constexpr (SP2) {
        PG8_STAGE(PG8_SB(0, 0), cB, voffB); PG8_STAGE(PG8_SB(0, 1), cB + hstep, voffB); PG8_STAGE(PG8_SA(0, 0), cA, voffA); PG8_STAGE(PG8_SA(0, 1), cA + hstep, voffA);
        if (wr == 1) PG8_BAR;
        PG8_WAIT_V(2); PG8_BAR;
        PG8_STAGE(PG8_SB(1, 0), cB + kstep, voffB); PG8_STAGE(PG8_SA(1, 0), cA + kstep, voffA); PG8_STAGE(PG8_SB(1, 1), cB + hstep + kstep, voffB);
        PG8_WAIT_V(6); PG8_BAR;
    } else {
        PG8_STAGE(PG8_SB(0, 0), cB, voffB); PG8_STAGE(PG8_SA(0, 0), cA, voffA); PG8_STAGE(PG8_SB(0, 1), cB + hstep, voffB); PG8_STAGE(PG8_SA(0, 1), cA + hstep, voffA);
        if (wr == 1) PG8_BAR;
        PG8_WAIT_V(4); PG8_BAR;
        PG8_STAGE(PG8_SB(1, 0), cB + kstep, voffB); PG8_STAGE(PG8_SA(1, 0), cA + kstep, voffA); PG8_STAGE(PG8_SB(1, 1), cB + hstep + kstep, voffB);
        PG8_WAIT_V(6); PG8_BAR;
    }
    for (;;) {
        const bool has_next = S.next(ui + 1, nxt);
        const char* nA = has_next ? (const char*)g.A + (size_t)nxt.pm * tstep : cA; const char* nB = has_next ? (const char*)g.Bt + (size_t)nxt.pn * tstep : cB;
        for (int t = 0; t < nt; t += 2) {
            const bool last = (t == nt - 2);
            const char* a1 = cA + (size_t)(t + 1) * kstep;
            const char* a2 = last ? nA : cA + (size_t)(t + 2) * kstep; const char* b2 = last ? nB : cB + (size_t)(t + 2) * kstep;
            const char* a3 = a2 + kstep; const char* b3 = b2 + kstep;
            if (last && has_next) S.a_ready(nxt);
            if constexpr (SP2) {
            PG8_LDB(B0, 0, 0); PG8_LDB(B1, 0, 1); PG8_SCHED; PG8_LDA(At, 0, 0); PG8_STAGE(PG8_SA(1, 1), a1 + hstep, voffA);
            PG8_WAIT_V(8); PG8_WAIT_L(0); PG8_BAR; PG8_MMA(0, 0, At, B0); PG8_MMA(0, 1, At, B1); PG8_BAR; PG8_SCHED;
            PG8_LDA(At, 0, 1); PG8_STAGE(PG8_SB(0, 0), b2, voffB); PG8_STAGE(PG8_SB(0, 1), b2 + hstep, voffB); PG8_STAGE(PG8_SA(0, 0), a2, voffA);
            PG8_WAIT_V(8); PG8_WAIT_L(0); PG8_BAR; PG8_MMA(1, 0, At, B0); PG8_MMA(1, 1, At, B1); PG8_BAR; PG8_SCHED;
            PG8_LDB(B0, 1, 0); PG8_LDB(B1, 1, 1); PG8_SCHED; PG8_LDA(At, 1, 0); PG8_STAGE(PG8_SA(0, 1), a2 + hstep, voffA);
            PG8_WAIT_V(8); PG8_WAIT_L(0); PG8_BAR; PG8_MMA(0, 0, At, B0); PG8_MMA(0, 1, At, B1); PG8_BAR; PG8_SCHED;
            PG8_LDA(At, 1, 1); PG8_STAGE(PG8_SB(1, 0), b3, voffB); PG8_STAGE(PG8_SB(1, 1), b3 + hstep, voffB); PG8_STAGE(PG8_SA(1, 0), a3, voffA);
            PG8_WAIT_V(8); PG8_WAIT_L(0); PG8_BAR; PG8_MMA(1, 0, At, B0); PG8_MMA(1, 1, At, B1); PG8_BAR; PG8_SCHED;
            } else {
            PG8_LDB(B0, 0, 0); PG8_SCHED; PG8_LDA(At, 0, 0); PG8_STAGE(PG8_SA(1, 1), a1 + hstep, voffA);
            PG8_WAIT_L(8); PG8_BAR; PG8_WAIT_L(0); PG8_MMA(0, 0, At, B0); PG8_BAR; PG8_SCHED;
            PG8_LDB(B1, 0, 1); PG8_STAGE(PG8_SB(0, 0), b2, voffB);
            PG8_BAR; PG8_WAIT_L(0); PG8_MMA(0, 1, At, B1); PG8_BAR;
            PG8_LDA(At, 0, 1); PG8_STAGE(PG8_SA(0, 0), a2, voffA);
            PG8_BAR; PG8_WAIT_L(0); PG8_MMA(1, 0, At, B0); PG8_BAR; PG8_SCHED;
            PG8_STAGE(PG8_SB(0, 1), b2 + hstep, voffB);
            PG8_WAIT_V(6); PG8_BAR; PG8_MMA(1, 1, At, B1); PG8_BAR;
            PG8_LDB(B0, 1, 0); PG8_SCHED; PG8_LDA(At, 1, 0); PG8_STAGE(PG8_SA(0, 1), a2 + hstep, voffA);
            PG8_WAIT_L(8); PG8_BAR; PG8_WAIT_L(0); PG8_MMA(0, 0, At, B0); PG8_BAR; PG8_SCHED;
            PG8_LDB(B1, 1, 1); PG8_STAGE(PG8_SB(1, 0), b3, voffB);
            PG8_BAR; PG8_WAIT_L(0); PG8_MMA(0, 1, At, B1); PG8_BAR;
            PG8_LDA(At, 1, 1); PG8_STAGE(PG8_SA(1, 0), a3, voffA);
            PG8_BAR; PG8_WAIT_L(0); PG8_MMA(1, 0, At, B0); PG8_BAR; PG8_SCHED;
            PG8_STAGE(PG8_SB(1, 1), b3 + hstep, voffB);
            PG8_WAIT_V(6); PG8_BAR; PG8_MMA(1, 1, At, B1); PG8_BAR;
            }
        }
        if constexpr (ALIGN_EPI) { if (wr == 0) PG8_BAR; }
        if constexpr (!Epi::AFTER_DRAIN) { E(acc, cur, wr, wc, fr, fq); S.done(cur); }
        if (!has_next) break;
#pragma unroll
        for (int a = 0; a < 2; ++a)
#pragma unroll
            for (int b = 0; b < 2; ++b)
#pragma unroll
                for (int m = 0; m < 4; ++m)
#pragma unroll
                    for (int n = 0; n < 2; ++n) acc[a][b][m][n] = (f32x4){0.f, 0.f, 0.f, 0.f};
        cur = nxt; cA = nA; cB = nB; ++ui;
        if constexpr (ALIGN_EPI) { if (wr == 1) PG8_BAR; }
    }
    PG8_WAIT_V(0);
    if constexpr (!ALIGN_EPI) { if (wr == 0) PG8_BAR; }
    PG8_BAR;
    if constexpr (Epi::AFTER_DRAIN) { E.fused(acc, cur, wr, wc, fr, fq, lds, wid, lane); S.done(cur); }
#undef PG8_SA
#undef PG8_SB
#undef PG8_STAGE
#undef PG8_LDA
#undef PG8_LDB
#undef PG8_MMA
#undef PG8_WAIT_V
#undef PG8_WAIT_L
#undef PG8_BAR
#undef PG8_SCHED
}
}

#define STAGE_OPT_INPROJ 1
#define STAGE_OPT_GATES 1
#define STAGE_OPT_Y 1
#define STAGE_OPT_WO 1
#define STAGE_OPT_GU 1
#define STAGE_OPT_DN 1
constexpr bool ANY_OPT_GEMM = STAGE_OPT_INPROJ || STAGE_OPT_GATES || STAGE_OPT_Y || STAGE_OPT_WO || STAGE_OPT_GU || STAGE_OPT_DN;
constexpr int WIN_ROWS = 39 * 256;
constexpr size_t WT_IN = 0, WT_OG = WT_IN + (size_t)WIN_ROWS * 1024 * 2, WT_OD = WT_OG + 2 * MiB, WT_O = WT_OD + 2 * MiB, WT_GU = WT_O + 2 * MiB, WT_DN = WT_GU + (size_t)2 * FF * 1024 * 2, WT_END = WT_DN + (size_t)1024 * FF * 2;
static_assert(WT_END <= 42 * MiB, "weight region");
typedef unsigned u32x4 __attribute__((ext_vector_type(4)));
typedef unsigned u32x2 __attribute__((ext_vector_type(2)));
__device__ __forceinline__ unsigned pk2(float lo, float hi) { return pg8::cvt_pk_bf16(lo, hi); }
__device__ __forceinline__ u32x2 pk4(f32x4 v) { u32x2 w; w.x = pk2(v[0], v[1]); w.y = pk2(v[2], v[3]); return w; }
__device__ __forceinline__ u32x4 pk8(f32x4 a, f32x4 b) { u32x4 w; w.x = pk2(a[0], a[1]); w.y = pk2(a[2], a[3]); w.z = pk2(b[0], b[1]); w.w = pk2(b[2], b[3]); return w; }
__device__ __forceinline__ f32x4 unpk4lo(u32x4 w) { return (f32x4){bf2f(w.x & 0xffffu), bf2f(w.x >> 16), bf2f(w.y & 0xffffu), bf2f(w.y >> 16)}; }
__device__ __forceinline__ f32x4 unpk4hi(u32x4 w) { return (f32x4){bf2f(w.z & 0xffffu), bf2f(w.z >> 16), bf2f(w.w & 0xffffu), bf2f(w.w >> 16)}; }
__device__ __forceinline__ f32x4 sig4(f32x4 v) { return (f32x4){sigmoidf_(v[0]), sigmoidf_(v[1]), sigmoidf_(v[2]), sigmoidf_(v[3])}; }
__device__ __forceinline__ f32x4 silu4(f32x4 v) { return (f32x4){siluf_(v[0]), siluf_(v[1]), siluf_(v[2]), siluf_(v[3])}; }

__device__ __forceinline__ int rope_pos(int d, int half) { const int n = d / half, dl = d % half; return 32 * (dl >> 4) + 8 * ((dl >> 2) & 3) + 4 * n + (dl & 3); }
__device__ __forceinline__ int map_win(int n) {
    if (n < C_A) return n;
    if (n < C_B) return 30 * 256 + 72 + (n - C_A);
    if (n < C_QB) return 30 * 256 + 80 + (n - C_B);
    if (n < C_VB) { const int m = n - C_QB, hd = m >> 7, d = m & 127; return (16 + (hd >> 1)) * 256 + (hd & 1) * 128 + rope_pos(d, 64); }
    if (n < C_QI) return 24 * 256 + (n - C_VB);
    if (n < C_KI) { const int m = n - C_QI, hd = m >> 6, d = m & 63; return (28 + (hd >> 2)) * 256 + ((hd >> 1) & 1) * 128 + (hd & 1) * 64 + rope_pos(d, 32); }
    if (n < C_WI) return 30 * 256 + rope_pos(n - C_KI, 32);
    if (n < C_GA) return 30 * 256 + 64 + (n - C_WI);
    return 31 * 256 + (n - C_GA);
}
__device__ __forceinline__ int map_gu(int cidx) { const int nn = cidx >= FF ? 1 : 0, f = cidx - nn * FF; return 8 * (f >> 2) + 4 * nn + (f & 3); }
template <int MAPK> __device__ __forceinline__ void transpose_item(const float* W, int K, int N, bf16_t* WT, float* scr, int item, int lane) {
    const int nblk = (N + 31) / 32, kb = item / nblk, nb = item % nblk, k0 = 64 * kb, n0 = 32 * nb;
    const int nn = n0 + (lane & 31);
#pragma unroll 8
    for (int i = 0; i < 32; ++i) { const int kk = 2 * i + (lane >> 5); scr[kk * 33 + (lane & 31)] = nn < N ? W[(size_t)(k0 + kk) * N + nn] : 0.f; }
    asm volatile("s_waitcnt lgkmcnt(0)" ::: "memory");
    const int cch = lane & 7;
#pragma unroll
    for (int j = 0; j < 4; ++j) { const int n = (lane >> 3) + 8 * j;
        if (n0 + n < N) { const float* sp = scr + (8 * cch) * 33 + n; const int row = MAPK == 1 ? map_win(n0 + n) : (MAPK == 2 ? map_gu(n0 + n) : n0 + n);
            u32x4 o; o.x = pk2(sp[0], sp[33]); o.y = pk2(sp[2 * 33], sp[3 * 33]); o.z = pk2(sp[4 * 33], sp[5 * 33]); o.w = pk2(sp[6 * 33], sp[7 * 33]);
            *(u32x4*)(WT + (size_t)row * K + k0 + 8 * cch) = o; } }
    asm volatile("s_waitcnt lgkmcnt(0)" ::: "memory");
}
__device__ void phase_convert_weights(const Ctx& c, int layer, unsigned char* smem) {
    const int lane = otid() & 63, wv = otid() >> 6, gw = blockIdx.x * 8 + wv, nw = gridDim.x * 8;
    float* scr = (float*)smem + wv * (64 * 33);
    unsigned char* wt = c.ws + WS_WT;
    constexpr int I_IN = 16 * ((INC + 31) / 32), I_SQ = 16 * 32, I_GU = 16 * (2 * FF / 32), I_DN = (FF / 64) * 32;
    for (int it = gw; it < I_IN + 3 * I_SQ + I_GU + I_DN; it += nw) {
        int r = it;
        if (r < I_IN) { transpose_item<1>(c.w_in + (size_t)layer * DM * INC, DM, INC, (bf16_t*)(wt + WT_IN), scr, r, lane); continue; } r -= I_IN;
        if (r < I_SQ) { transpose_item<0>(c.w_out_gdn + (size_t)layer * DM * DM, DM, DM, (bf16_t*)(wt + WT_OG), scr, r, lane); continue; } r -= I_SQ;
        if (r < I_SQ) { transpose_item<0>(c.w_out_dsa + (size_t)layer * DM * DM, DM, DM, (bf16_t*)(wt + WT_OD), scr, r, lane); continue; } r -= I_SQ;
        if (r < I_SQ) { transpose_item<0>(c.w_o + (size_t)layer * DM * DM, DM, DM, (bf16_t*)(wt + WT_O), scr, r, lane); continue; } r -= I_SQ;
        if (r < I_GU) { transpose_item<2>(c.w_gate_up + (size_t)layer * DM * 2 * FF, DM, 2 * FF, (bf16_t*)(wt + WT_GU), scr, r, lane); continue; } r -= I_GU;
        transpose_item<0>(c.w_down + (size_t)layer * FF * DM, FF, DM, (bf16_t*)(wt + WT_DN), scr, r, lane);
    }
}

#define EPI_ROWS(...) _Pragma("unroll") for (int ai = 0; ai < 2; ++ai) _Pragma("unroll") for (int m = 0; m < 4; ++m) { const int r = u.pm * 256 + ai * 128 + wr * 64 + m * 16 + fr; __VA_ARGS__ asm volatile("" ::: "memory"); }
struct EpiInProj {
    static constexpr bool PERM = true, AFTER_DRAIN = false;
    unsigned char* R; const float *cosA, *sinA, *cosI, *sinI, *a_log, *dt_bias;
    __device__ __forceinline__ void operator()(const f32x4 (&acc)[2][2][4][2], const pg8::Unit& u, int wr, int wc, int fr, int fq) const {
        asm volatile("" : "+v"(fr), "+v"(fq));
        const int pn = u.pn, cw = wc * 32 + 8 * fq;
        if (pn < 12) { bf16_t* Q = (bf16_t*)(R + R_QKVA); bf16_t* H = (bf16_t*)(R + R_HALO);
            EPI_ROWS(_Pragma("unroll") for (int bj = 0; bj < 2; ++bj) { const int col = pn * 256 + bj * 128 + cw; const u32x4 w = pk8(acc[ai][bj][m][0], acc[ai][bj][m][1]);
                *(u32x4*)(Q + (size_t)r * 3072 + col) = w; if (m == 3 && fr >= 13) *(u32x4*)(H + ((size_t)(r >> 6) * 3 + (fr - 13)) * 3072 + col) = w; }) }
        else if (pn < 16) { bf16_t* Z = (bf16_t*)(R + R_ZS);
            EPI_ROWS(_Pragma("unroll") for (int bj = 0; bj < 2; ++bj) { const int col = (pn - 12) * 256 + bj * 128 + cw; *(u32x4*)(Z + (size_t)r * 1024 + col) = pk8(silu4(acc[ai][bj][m][0]), silu4(acc[ai][bj][m][1])); }) }
        else if (pn < 24) { bf16_t* D = (bf16_t*)(R + ((pn - 16) >> 2 ? R_KB : R_QB)); const int dl = 16 * wc + 4 * fq;
            EPI_ROWS(const int pos = r % SEQ; const f32x4 cs = *(const f32x4*)(cosA + pos * 64 + dl), sn = *(const f32x4*)(sinA + pos * 64 + dl);
                _Pragma("unroll") for (int bj = 0; bj < 2; ++bj) { const int hd = ((pn - 16) & 3) * 2 + bj; const f32x4 x1 = acc[ai][bj][m][0], x2 = acc[ai][bj][m][1];
                    bf16_t* dp = D + (size_t)r * 1024 + hd * 128 + dl; *(u32x2*)dp = pk4(x1 * cs - x2 * sn); *(u32x2*)(dp + 64) = pk4(x2 * cs + x1 * sn); }) }
        else if (pn < 28) { bf16_t* V = (bf16_t*)(R + R_VB);
            EPI_ROWS(_Pragma("unroll") for (int bj = 0; bj < 2; ++bj) { const int col = (pn - 24) * 256 + bj * 128 + cw; *(u32x4*)(V + (size_t)r * 1024 + col) = pk8(acc[ai][bj][m][0], acc[ai][bj][m][1]); }) }
        else if (pn < 30) { bf16_t* QI = (bf16_t*)(R + R_QI); const int dl = 16 * (wc & 1) + 4 * fq;
            EPI_ROWS(const int pos = r % SEQ; const f32x4 cs = *(const f32x4*)(cosI + pos * 32 + dl), sn = *(const f32x4*)(sinI + pos * 32 + dl);
                _Pragma("unroll") for (int bj = 0; bj < 2; ++bj) { const int hd = (pn - 28) * 4 + bj * 2 + (wc >> 1); const f32x4 x1 = acc[ai][bj][m][0], x2 = acc[ai][bj][m][1];
                    bf16_t* dp = QI + (size_t)r * 512 + hd * 64 + dl; *(u32x2*)dp = pk4(x1 * cs - x2 * sn); *(u32x2*)(dp + 32) = pk4(x2 * cs + x1 * sn); }) }
        else {
            if (wc < 2) { bf16_t* KI = (bf16_t*)(R + R_KI); const int dl = 16 * wc + 4 * fq;
                EPI_ROWS(const int pos = r % SEQ; const f32x4 cs = *(const f32x4*)(cosI + pos * 32 + dl), sn = *(const f32x4*)(sinI + pos * 32 + dl);
                    const f32x4 x1 = acc[ai][0][m][0], x2 = acc[ai][0][m][1]; bf16_t* dp = KI + (size_t)r * 64 + dl;
                    *(u32x2*)dp = pk4((x1 * cs - x2 * sn) * 0.125f); *(u32x2*)(dp + 32) = pk4((x2 * cs + x1 * sn) * 0.125f);) }
            else if (wc == 2) {
                if (fq == 0) { float* WI = (float*)(R + R_WI); EPI_ROWS(*(f32x4*)(WI + r * 8) = acc[ai][0][m][0] * 0.35355339059327373f; *(f32x4*)(WI + r * 8 + 4) = acc[ai][0][m][1] * 0.35355339059327373f;) }
                else if (fq == 1) { float* GG = (float*)(R + R_GG);
                    EPI_ROWS(_Pragma("unroll") for (int n = 0; n < 2; ++n) { f32x4 o; _Pragma("unroll") for (int j = 0; j < 4; ++j) o[j] = -__expf(a_log[n * 4 + j]) * softplusf_(acc[ai][0][m][n][j] + dt_bias[n * 4 + j]); *(f32x4*)(GG + r * 8 + n * 4) = o; }) }
                else if (fq == 2) { float* BT = (float*)(R + R_BETA); EPI_ROWS(*(f32x4*)(BT + r * 8) = sig4(acc[ai][0][m][0]); *(f32x4*)(BT + r * 8 + 4) = sig4(acc[ai][0][m][1]);) }
            }
        }
    }
};
struct EpiGates {
    static constexpr bool PERM = true, AFTER_DRAIN = false; bf16_t* SG;
    __device__ __forceinline__ void operator()(const f32x4 (&acc)[2][2][4][2], const pg8::Unit& u, int wr, int wc, int fr, int fq) const {
        EPI_ROWS(_Pragma("unroll") for (int bj = 0; bj < 2; ++bj) { const int col = u.pn * 256 + bj * 128 + wc * 32 + 8 * fq; *(u32x4*)(SG + (size_t)r * 2048 + col) = pk8(sig4(acc[ai][bj][m][0]), sig4(acc[ai][bj][m][1])); })
    }
};
template <int WHICH> struct EpiY {
    static constexpr bool PERM = true, AFTER_DRAIN = false; const bf16_t* SG; bf16_t* MG;
    __device__ __forceinline__ void operator()(const f32x4 (&acc)[2][2][4][2], const pg8::Unit& u, int wr, int wc, int fr, int fq) const {
        EPI_ROWS(_Pragma("unroll") for (int bj = 0; bj < 2; ++bj) { const int col = u.pn * 256 + bj * 128 + wc * 32 + 8 * fq;
            const u32x4 g = *(const u32x4*)(SG + (size_t)r * 2048 + WHICH * 1024 + col); f32x4 lo = unpk4lo(g) * acc[ai][bj][m][0], hi = unpk4hi(g) * acc[ai][bj][m][1];
            if (WHICH == 1) { const u32x4 p = *(const u32x4*)(MG + (size_t)r * 1024 + col); lo += unpk4lo(p); hi += unpk4hi(p); }
            *(u32x4*)(MG + (size_t)r * 1024 + col) = pk8(lo, hi); })
    }
};
struct EpiResid {
    static constexpr bool PERM = true, AFTER_DRAIN = false; const float* base; float* out;
    __device__ __forceinline__ void operator()(const f32x4 (&acc)[2][2][4][2], const pg8::Unit& u, int wr, int wc, int fr, int fq) const {
        EPI_ROWS(_Pragma("unroll") for (int bj = 0; bj < 2; ++bj) { const size_t off = (size_t)r * 1024 + u.pn * 256 + bj * 128 + wc * 32 + 8 * fq;
            const f32x4 b0 = *(const f32x4*)(base + off), b1 = *(const f32x4*)(base + off + 4); *(f32x4*)(out + off) = b0 + acc[ai][bj][m][0]; *(f32x4*)(out + off + 4) = b1 + acc[ai][bj][m][1]; })
    }
};
struct EpiSwiglu {
    static constexpr bool PERM = true, AFTER_DRAIN = false; bf16_t* ACT;
    __device__ __forceinline__ void operator()(const f32x4 (&acc)[2][2][4][2], const pg8::Unit& u, int wr, int wc, int fr, int fq) const {
        EPI_ROWS(_Pragma("unroll") for (int bj = 0; bj < 2; ++bj) { const int f0 = u.pn * 128 + bj * 64 + wc * 16 + 4 * fq; *(u32x2*)(ACT + (size_t)r * FF + f0) = pk4(silu4(acc[ai][bj][m][0]) * acc[ai][bj][m][1]); })
    }
};

typedef const __attribute__((address_space(4))) Args* KArgsP;
__device__ __forceinline__ Ctx make_ctx() {
    KArgsP a = (KArgsP)__builtin_amdgcn_kernarg_segment_ptr(); asm volatile("" : "+s"(a));
    Ctx c;
    c.x = a->in[0]; c.norm_mix = a->in[1]; c.w_in = a->in[2]; c.conv_w = a->in[3]; c.a_log = a->in[4]; c.dt_bias = a->in[5]; c.gdn_norm = a->in[6];
    c.w_out_gdn = a->in[7]; c.w_out_dsa = a->in[8]; c.w_o = a->in[9]; c.norm_ffn = a->in[10]; c.w_gate_up = a->in[11]; c.w_down = a->in[12]; c.norm_final = a->in[13];
    c.out = a->out; c.ws = a->ws; c.R = c.ws + WS_R;
    c.cosA = (float*)(c.ws + WS_TAB); c.sinA = c.cosA + SEQ * 64; c.cosI = c.sinA + SEQ * 64; c.sinI = c.cosI + SEQ * 32;
    c.XN = (bf16_t*)(c.ws + WS_XN); c.OA = (bf16_t*)(c.ws + WS_OA); c.AT = (bf16_t*)(c.ws + WS_AT);
    return c;
}
__global__ void __launch_bounds__(512, 2) fwd_kernel(Args a) {
    extern __shared__ __attribute__((aligned(16))) unsigned char smem[];
    cg::grid_group grid = cg::this_grid();
    PG8_LAS unsigned char* lds = (PG8_LAS unsigned char*)smem;
#define SYNC() grid.sync()
    { const Ctx c = make_ctx(); phase_tables(c); }
    if (ANY_OPT_GEMM) { const Ctx c = make_ctx(); phase_convert_weights(c, 0, smem); }
    { const Ctx c = make_ctx(); phase_rmsnorm(c.x, c.norm_mix, c.XN, nullptr); }
    SYNC();
#pragma unroll 1
    for (int layer = 0; layer < DEPTH; ++layer) {
#pragma unroll 1
        for (int pc = 0; pc < 19; ++pc) {
            int st, split = 0;
            if (pc < 12) { split = pc / 6; st = pc % 6; } else st = pc - 6;
            int k0 = 0, k1 = 0;
            if (st == 0) { if (STAGE_OPT_INPROJ) { const Ctx c = make_ctx(); unsigned char* wt = c.ws + WS_WT; pg8::Gemm g{c.XN + (size_t)split * MS * DM, (const bf16_t*)(wt + WT_IN), MS, 31 * 256, DM}; pg8::StaticOrder S; S.init(MS, 31 * 256, gridDim.x, blockIdx.x);
                    EpiInProj E{c.R, c.cosA, c.sinA, c.cosI, c.sinI, c.a_log + layer * 8, c.dt_bias + layer * 8}; pg8::gemm_phase<EpiInProj, pg8::StaticOrder, true, true>(lds, g, S, E); }
                else { k0 = split * 10; k1 = k0 + 10; } }
            else if (st == 1) { const Ctx c = make_ctx(); naive_conv(c, layer); }
            else if (st == 2) { const Ctx c = make_ctx(); naive_l2norm(c); }
            else if (st == 3) { const Ctx c = make_ctx(); naive_scan(c, smem); }
            else if (st == 4) { const Ctx c = make_ctx(); naive_gate(c, layer, split); }
            else if (st == 5) { const Ctx c = make_ctx(); naive_dsa(c, split, smem); }
            else if (st == 6) { if (STAGE_OPT_GATES) { const Ctx c = make_ctx(); unsigned char* wt = c.ws + WS_WT; pg8::Gemm g{c.XN, (const bf16_t*)(wt + WT_IN) + (size_t)31 * 256 * DM, M, 2048, DM}; pg8::StaticOrder S; S.init(M, 2048, gridDim.x, blockIdx.x);
                    EpiGates E{(bf16_t*)(c.R + R_SG)}; pg8::gemm_phase<EpiGates, pg8::StaticOrder, true, true>(lds, g, S, E); }
                else { k0 = 20; k1 = 24; } }
            else if (st == 7) { if (STAGE_OPT_Y) { const Ctx c = make_ctx(); unsigned char* wt = c.ws + WS_WT; pg8::StaticOrder S; S.init(M, DM, gridDim.x, blockIdx.x);
                    { pg8::Gemm g{c.OA, (const bf16_t*)(wt + WT_OG), M, DM, DM}; EpiY<0> E{(const bf16_t*)(c.R + R_SG), (bf16_t*)(c.R + R_MG)}; pg8::gemm_phase<EpiY<0>, pg8::StaticOrder, false, true>(lds, g, S, E); }
                    { pg8::Gemm g{c.AT, (const bf16_t*)(wt + WT_OD), M, DM, DM}; EpiY<1> E{(const bf16_t*)(c.R + R_SG), (bf16_t*)(c.R + R_MG)}; pg8::gemm_phase<EpiY<1>, pg8::StaticOrder, false, true>(lds, g, S, E); } }
                else { k0 = 24; k1 = 28; } }
            else if (st == 8) { if (STAGE_OPT_WO) { const Ctx c = make_ctx(); unsigned char* wt = c.ws + WS_WT; pg8::Gemm g{(const bf16_t*)(c.R + R_MG), (const bf16_t*)(wt + WT_O), M, DM, DM}; pg8::StaticOrder S; S.init(M, DM, gridDim.x, blockIdx.x);
                    EpiResid E{layer == 0 ? c.x : c.out, c.out}; pg8::gemm_phase<EpiResid, pg8::StaticOrder, false, true>(lds, g, S, E); }
                else { k0 = 28; k1 = 30; } }
            else if (st == 9) { const Ctx c = make_ctx(); phase_rmsnorm(c.out, c.norm_ffn + layer * DM, c.XN, nullptr); }
            else if (st == 10) { if (STAGE_OPT_GU) { const Ctx c = make_ctx(); unsigned char* wt = c.ws + WS_WT; pg8::Gemm g{c.XN, (const bf16_t*)(wt + WT_GU), M, 2 * FF, DM}; pg8::StaticOrder S; S.init(M, 2 * FF, gridDim.x, blockIdx.x);
                    EpiSwiglu E{(bf16_t*)(c.R + R_ACT)}; pg8::gemm_phase<EpiSwiglu, pg8::StaticOrder, true, true>(lds, g, S, E); }
                else { k0 = 30; k1 = 52; } }
            else if (st == 11) { if (STAGE_OPT_DN) { const Ctx c = make_ctx(); unsigned char* wt = c.ws + WS_WT; pg8::Gemm g{(const bf16_t*)(c.R + R_ACT), (const bf16_t*)(wt + WT_DN), M, DM, FF}; pg8::StaticOrder S; S.init(M, DM, gridDim.x, blockIdx.x);
                    EpiResid E{c.out, c.out}; pg8::gemm_phase<EpiResid, pg8::StaticOrder, false, true>(lds, g, S, E); }
                else { k0 = 52; k1 = 54; } }
            else { const Ctx c = make_ctx(); if (layer + 1 < DEPTH) { phase_rmsnorm(c.out, c.norm_mix + (layer + 1) * DM, c.XN, nullptr); if (ANY_OPT_GEMM) phase_convert_weights(c, layer + 1, smem); }
                   else phase_rmsnorm(c.out, c.norm_final, nullptr, c.out); }
#pragma unroll 1
            for (int k = k0; k < k1; ++k) {
                const Ctx c = make_ctx(); const float* w_in = c.w_in + (size_t)layer * DM * INC; float* TMP = (float*)(c.R + R_TMP);
                NG g; EP e; int ng = 1;
                g.A = c.XN; g.lda = DM; g.W = w_in; g.ldw = INC; g.col0 = 0; g.ncols = 1024; g.row0 = 0; g.nrows = MS; g.K = DM; g.T = TMP; g.ldt = 1024; g.tcol0 = 0;
                e.kind = E_V; e.nrows = MS; e.rowg0 = 0; e.p0 = 0; e.layer = layer; e.dst = nullptr; e.base = nullptr;
                if (k < 20) { const int sp = k / 10, j = k % 10; g.row0 = sp * MS; e.rowg0 = sp * MS;
                    if (j < 3) { g.col0 = C_QKVA + j * 1024; e.kind = E_QKVA; e.p0 = j; }
                    else if (j == 3) { g.col0 = C_Z; e.kind = E_Z; }
                    else if (j == 4) { g.col0 = C_A; g.ncols = 16; e.kind = E_AB; }
                    else if (j == 5) { g.col0 = C_QB; e.kind = E_ROPE; e.dst = (bf16_t*)(c.R + R_QB); }
                    else if (j == 6) { g.col0 = C_KB; e.kind = E_ROPE; e.dst = (bf16_t*)(c.R + R_KB); }
                    else if (j == 7) { g.col0 = C_VB; e.kind = E_V; e.dst = (bf16_t*)(c.R + R_VB); }
                    else if (j == 8) { g.col0 = C_QI; g.ncols = 512; e.kind = E_QI; }
                    else { g.col0 = C_KI; g.ncols = 72; e.kind = E_KIWI; } }
                else if (k < 24) { const int hf = (k - 20) >> 1, gg = (k - 20) & 1; g.row0 = hf * MS; e.rowg0 = hf * MS; g.col0 = C_GA + gg * 1024; e.kind = E_SG; e.p0 = gg; }
                else if (k < 28) { const int hf = (k - 24) >> 1, wh = (k - 24) & 1; g.row0 = hf * MS; e.rowg0 = hf * MS; g.A = wh ? c.AT : c.OA;
                    g.W = (wh ? c.w_out_dsa : c.w_out_gdn) + (size_t)layer * DM * DM; g.ldw = DM; e.kind = wh ? E_YB : E_YA; }
                else if (k < 30) { const int hf = k - 28; g.row0 = hf * MS; e.rowg0 = hf * MS; g.A = (const bf16_t*)(c.R + R_MG); g.W = c.w_o + (size_t)layer * DM * DM; g.ldw = DM; e.kind = E_WO; e.base = layer == 0 ? c.x : c.out; }
                else if (k < 52) { const int hf = (k - 30) / 11, fg = (k - 30) % 11; g.row0 = hf * MS; e.rowg0 = hf * MS; g.W = c.w_gate_up + (size_t)layer * DM * 2 * FF; g.ldw = 2 * FF; g.col0 = fg * 256; g.ncols = 256;
                    ng = 2; e.kind = E_SWIGLU; e.p0 = fg; }
                else { const int hf = k - 52; g.row0 = hf * MS; e.rowg0 = hf * MS; g.A = (const bf16_t*)(c.R + R_ACT); g.lda = FF; g.K = FF; g.W = c.w_down + (size_t)layer * FF * DM; g.ldw = DM; e.kind = E_DOWN; }
#pragma unroll 1
                for (int q = 0; q < ng; ++q) { if (q == 1) { g.col0 += FF; g.tcol0 = 256; } naive_gemm(g, smem); }
                SYNC();
                epi_phase(c, e);
                if (k + 1 < k1) SYNC();
            }
            SYNC();
        }
    }
}

extern "C" void kernel_launch(void* const* d_in, const int* in_sizes, int n_in, void* d_out, int out_size, void* d_ws, size_t ws_size, hipStream_t stream) {
    static int grid = 0;
    if (grid == 0) {
        if (n_in != 14 || out_size != M * DM || ws_size < WS_END) { fprintf(stderr, "kernel_launch: unexpected problem (n_in %d out %d ws %zu need %zu)\n", n_in, out_size, ws_size, (size_t)WS_END); grid = -1; return; }
        int dev = 0, cus = 0, per_cu = 0;
        hipGetDevice(&dev); hipDeviceGetAttribute(&cus, hipDeviceAttributeMultiprocessorCount, dev);
        hipFuncSetAttribute((const void*)fwd_kernel, hipFuncAttributeMaxDynamicSharedMemorySize, LDS_BYTES);
        hipOccupancyMaxActiveBlocksPerMultiprocessor(&per_cu, (const void*)fwd_kernel, 512, LDS_BYTES);
        if (per_cu < 1) { fprintf(stderr, "kernel_launch: occupancy query says %d blocks/CU\n", per_cu); grid = -1; return; }
        grid = cus;
        (void)hipGetLastError();
    }
    if (grid < 0) return;
    hipMemsetAsync((char*)d_ws + WS_CTL, 0, 1 * MiB, stream);
    Args a{};
    for (int i = 0; i < 14; ++i) a.in[i] = (const float*)d_in[i];
    a.out = (float*)d_out; a.ws = (unsigned char*)d_ws;
    void* args[] = {&a};
    hipError_t e = hipLaunchCooperativeKernel((const void*)fwd_kernel, dim3(grid), dim3(512), args, LDS_BYTES, stream);
    if (e != hipSuccess) fprintf(stderr, "cooperative launch failed: %s (grid %d)\n", hipGetErrorString(e), grid);
}
```

```cpp
#include <hip/hip_runtime.h>
#include <hip/hip_cooperative_groups.h>
#include <cstdio>
#include <cstdint>
namespace cg = cooperative_groups;

typedef unsigned short bf16_t;
typedef float f32x4 __attribute__((ext_vector_type(4)));

constexpr int BATCH = 4, SEQ = 4096, DM = 1024, M = BATCH * SEQ, DEPTH = 2;
constexpr int GH = 8, GD = 128, CONVK = 4, CH = 64;
constexpr int AH = 8, AD = 128, IH = 8, ID = 64, TOPK = 256;
constexpr int FF = 2816, INC = 9816;
constexpr int NSPLIT = 2, MS = M / NSPLIT, BPS = BATCH / NSPLIT;
constexpr float EPS = 1e-6f;
constexpr int C_QKVA = 0, C_Z = 3072, C_A = 4096, C_B = 4104, C_QB = 4112, C_KB = 5136, C_VB = 6160, C_QI = 7184, C_KI = 7696, C_WI = 7760, C_GA = 7768, C_GB = 8792;

constexpr size_t MiB = 1u << 20;
constexpr size_t WS_CTL = 0;
constexpr size_t WS_WT = 1 * MiB;
constexpr size_t WS_TAB = 43 * MiB;
constexpr size_t WS_XN = 46 * MiB;
constexpr size_t WS_OA = 78 * MiB;
constexpr size_t WS_AT = 110 * MiB;
constexpr size_t WS_R = 142 * MiB;
constexpr size_t R_QKVA = 0, R_ZS = 48 * MiB, R_QB = 64 * MiB, R_KB = 80 * MiB, R_VB = 96 * MiB, R_QI = 112 * MiB, R_KI = 120 * MiB;
constexpr size_t R_WI = 121 * MiB, R_GG = R_WI + 256 * 1024, R_BETA = R_GG + 256 * 1024, R_HALO = 122 * MiB;
constexpr size_t R_P2 = 124 * MiB + 256 * 1024;
constexpr size_t R_TMP = R_P2;
constexpr size_t R_SG = 0, R_M1 = 64 * MiB, R_MG = R_M1;
constexpr size_t R_ACT = 0;
constexpr size_t WS_END = WS_R + R_P2 + 32 * MiB;
static_assert(WS_END <= 321650688ull, "workspace map exceeds the guaranteed d_ws size");
constexpr int LDS_BYTES = 163840;

struct Args { const float* in[14]; float* out; unsigned char* ws; };

__device__ __forceinline__ int otid() { int t = threadIdx.x; asm volatile("" : "+v"(t)); return t; }
__device__ __forceinline__ float bf2f(unsigned v) { return __uint_as_float(v << 16); }
__device__ __forceinline__ bf16_t f2bf(float f) { unsigned u = __float_as_uint(f); u += 0x7fffu + ((u >> 16) & 1u); return (bf16_t)(u >> 16); }
__device__ __forceinline__ float sigmoidf_(float x) { return 1.f / (1.f + __expf(-x)); }
__device__ __forceinline__ float siluf_(float x) { return x / (1.f + __expf(-x)); }
__device__ __forceinline__ float softplusf_(float x) { return fmaxf(x, 0.f) + log1pf(__expf(-fabsf(x))); }
__device__ __forceinline__ float wave_sum(float v) {
#pragma unroll
    for (int o = 1; o < 64; o <<= 1) v += __shfl_xor(v, o);
    return v;
}
__device__ __forceinline__ float wave_max(float v) {
#pragma unroll
    for (int o = 1; o < 64; o <<= 1) v = fmaxf(v, __shfl_xor(v, o));
    return v;
}

struct Ctx {
    const float* x; const float* norm_mix; const float* w_in; const float* conv_w; const float* a_log; const float* dt_bias; const float* gdn_norm;
    const float* w_out_gdn; const float* w_out_dsa; const float* w_o; const float* norm_ffn; const float* w_gate_up; const float* w_down; const float* norm_final;
    float* out; unsigned char* ws; unsigned char* R;
    float *cosA, *sinA, *cosI, *sinI;
    bf16_t *XN, *OA, *AT;
};

__device__ const double ROPE_INVF[64] = {1.0, 0.8659643233600653, 0.7498942093324559, 0.6493816315762113, 0.5623413251903491, 0.4869675251658631, 0.4216965034285822, 0.3651741272548377, 0.31622776601683794, 0.27384196342643613, 0.23713737056616552, 0.2053525026457146, 0.1778279410038923, 0.1539926526059492, 0.1333521432163324, 0.11547819846894582, 0.1, 0.08659643233600653, 0.07498942093324558, 0.06493816315762113, 0.05623413251903491, 0.04869675251658631, 0.042169650342858224, 0.03651741272548377, 0.03162277660168379, 0.027384196342643614, 0.023713737056616554, 0.02053525026457146, 0.01778279410038923, 0.01539926526059492, 0.01333521432163324, 0.011547819846894581, 0.01, 0.008659643233600654, 0.007498942093324558, 0.006493816315762113, 0.005623413251903491, 0.004869675251658631, 0.004216965034285823, 0.003651741272548377, 0.0031622776601683794, 0.0027384196342643613, 0.0023713737056616554, 0.002053525026457146, 0.0017782794100389228, 0.001539926526059492, 0.001333521432163324, 0.0011547819846894581, 0.001, 0.0008659643233600654, 0.0007498942093324559, 0.0006493816315762113, 0.0005623413251903491, 0.0004869675251658631, 0.00042169650342858224, 0.0003651741272548377, 0.00031622776601683794, 0.0002738419634264361, 0.00023713737056616554, 0.0002053525026457146, 0.00017782794100389227, 0.0001539926526059492, 0.0001333521432163324, 0.00011547819846894582};
__device__ __forceinline__ void rope_cs(int t, double invf, float& cs, float& sn) {
    const double ang = (double)t * invf; const double k = rint(ang * 0.15915494309189535); const float r = (float)(ang - k * 6.283185307179586);
    cs = cosf(r); sn = sinf(r);
}
__device__ void phase_tables(const Ctx& c) {
    const int gt = blockIdx.x * blockDim.x + otid(), nt = gridDim.x * blockDim.x;
    for (int i = gt; i < SEQ * 64; i += nt) { const int t = i >> 6, d = i & 63; float cs, sn; rope_cs(t, ROPE_INVF[d], cs, sn); c.cosA[i] = cs; c.sinA[i] = sn; }
    for (int i = gt; i < SEQ * 32; i += nt) { const int t = i >> 5, d = i & 31; float cs, sn; rope_cs(t, ROPE_INVF[2 * d], cs, sn); c.cosI[i] = cs; c.sinI[i] = sn; }
}

__device__ void phase_rmsnorm(const float* src, const float* gain, bf16_t* dst_bf, float* dst_f) {
    const int lane = otid() & 63, gw = (blockIdx.x * blockDim.x + otid()) >> 6, nw = (gridDim.x * blockDim.x) >> 6;
    for (int r = gw; r < M; r += nw) {
        const f32x4* xr = (const f32x4*)(src + (size_t)r * DM) + lane;
        f32x4 v[4]; float s = 0.f;
#pragma unroll
        for (int j = 0; j < 4; ++j) { v[j] = xr[64 * j]; s += v[j].x * v[j].x + v[j].y * v[j].y + v[j].z * v[j].z + v[j].w * v[j].w; }
        const float rs = rsqrtf(wave_sum(s) * (1.f / DM) + EPS);
#pragma unroll
        for (int j = 0; j < 4; ++j) {
            const f32x4 g = ((const f32x4*)gain)[lane + 64 * j]; const f32x4 o = v[j] * rs * g;
            if (dst_bf) { uint2 w; w.x = f2bf(o.x) | ((unsigned)f2bf(o.y) << 16); w.y = f2bf(o.z) | ((unsigned)f2bf(o.w) << 16); ((uint2*)(dst_bf + (size_t)r * DM))[lane + 64 * j] = w; }
            else ((f32x4*)(dst_f + (size_t)r * DM))[lane + 64 * j] = o;
        }
    }
}

struct NG { const bf16_t* A; int lda; const float* W; int ldw; int col0; int ncols; int row0; int nrows; int K; float* T; int ldt; int tcol0; };
__device__ void naive_gemm(const NG& g, unsigned char* smem) {
    float* As = (float*)smem; float* Bs = As + 16 * 132;
    const int tid = otid(), ty = tid >> 4, tx = tid & 15;
    const int ntr = g.nrows / 128, ntc = (g.ncols + 63) / 64;
    for (int u = blockIdx.x; u < ntr * ntc; u += gridDim.x) {
        const int tr = u % ntr, tc = u / ntr, r0 = tr * 128, c0 = tc * 64;
        float acc[4][4];
#pragma unroll
        for (int i = 0; i < 4; ++i)
#pragma unroll
            for (int j = 0; j < 4; ++j) acc[i][j] = 0.f;
        for (int k0 = 0; k0 < g.K; k0 += 16) {
            { const int row = tid >> 2, kq = (tid & 3) * 4;
              const uint2 raw = *(const uint2*)(g.A + (size_t)(g.row0 + r0 + row) * g.lda + k0 + kq);
              As[(kq + 0) * 132 + row] = bf2f(raw.x & 0xffffu); As[(kq + 1) * 132 + row] = bf2f(raw.x >> 16);
              As[(kq + 2) * 132 + row] = bf2f(raw.y & 0xffffu); As[(kq + 3) * 132 + row] = bf2f(raw.y >> 16); }
            { const int k = tid >> 5, cc = (tid & 31) * 2;
              const float* wp = g.W + (size_t)(k0 + k) * g.ldw + g.col0 + c0 + cc;
              Bs[k * 68 + cc] = (c0 + cc < g.ncols) ? wp[0] : 0.f; Bs[k * 68 + cc + 1] = (c0 + cc + 1 < g.ncols) ? wp[1] : 0.f; }
            __syncthreads();
#pragma unroll
            for (int kk = 0; kk < 16; ++kk) {
                const f32x4 a = *(const f32x4*)&As[kk * 132 + ty * 4]; const f32x4 b = *(const f32x4*)&Bs[kk * 68 + tx * 4];
#pragma unroll
                for (int i = 0; i < 4; ++i)
#pragma unroll
                    for (int j = 0; j < 4; ++j) acc[i][j] += a[i] * b[j];
            }
            __syncthreads();
        }
#pragma unroll
        for (int i = 0; i < 4; ++i)
#pragma unroll
            for (int j = 0; j < 4; ++j) { const int cc = c0 + tx * 4 + j; if (cc < g.ncols) g.T[(size_t)(r0 + ty * 4 + i) * g.ldt + g.tcol0 + cc] = acc[i][j]; }
    }
}

enum { E_QKVA, E_Z, E_AB, E_ROPE, E_V, E_QI, E_KIWI, E_SG, E_YA, E_YB, E_WO, E_SWIGLU, E_DOWN };
struct EP { int kind; int nrows; int rowg0; int p0; int layer; bf16_t* dst; const float* base; };
__device__ void epi_phase(const Ctx& c, const EP& e) {
    const float* T = (const float*)(c.R + R_TMP);
    const int gt = blockIdx.x * blockDim.x + otid(), nt = gridDim.x * blockDim.x;
    int W;
    switch (e.kind) { case E_QKVA: case E_Z: case E_V: case E_SG: case E_YA: case E_YB: case E_WO: case E_DOWN: W = 1024; break;
        case E_AB: W = 16; break; case E_ROPE: W = 512; break; case E_QI: W = 256; break; case E_KIWI: W = 40; break; default: W = 256; break; }
    const long total = (long)e.nrows * W;
    for (long idx = gt; idx < total; idx += nt) {
        const int r = (int)(idx / W), j = (int)(idx % W);
        const int rowg = e.rowg0 + r, rs = rowg % MS, pos = rowg % SEQ;
        const float* Tr = T + (size_t)r * 1024;
        switch (e.kind) {
        case E_QKVA: { const int col = e.p0 * 1024 + j; const bf16_t v = f2bf(Tr[j]); ((bf16_t*)(c.R + R_QKVA))[(size_t)rs * 3072 + col] = v;
                       if ((rs & 63) >= 61) ((bf16_t*)(c.R + R_HALO))[((size_t)(rs >> 6) * 3 + ((rs & 63) - 61)) * 3072 + col] = v; } break;
        case E_Z: ((bf16_t*)(c.R + R_ZS))[(size_t)rs * 1024 + j] = f2bf(siluf_(Tr[j])); break;
        case E_AB: { const int h = j & 7;
                     if (j < 8) ((float*)(c.R + R_GG))[rs * 8 + h] = -__expf(c.a_log[e.layer * 8 + h]) * softplusf_(Tr[j] + c.dt_bias[e.layer * 8 + h]);
                     else ((float*)(c.R + R_BETA))[rs * 8 + h] = sigmoidf_(Tr[j]); } break;
        case E_ROPE: { const int h = j >> 6, d = j & 63; const float x1 = Tr[h * 128 + d], x2 = Tr[h * 128 + 64 + d], cs = c.cosA[pos * 64 + d], sn = c.sinA[pos * 64 + d];
                       bf16_t* dst = e.dst + (size_t)rs * 1024 + h * 128 + d; dst[0] = f2bf(x1 * cs - x2 * sn); dst[64] = f2bf(x2 * cs + x1 * sn); } break;
        case E_V: e.dst[(size_t)rs * 1024 + j] = f2bf(Tr[j]); break;
        case E_QI: { const int h = j >> 5, d = j & 31; const float x1 = Tr[h * 64 + d], x2 = Tr[h * 64 + 32 + d], cs = c.cosI[pos * 32 + d], sn = c.sinI[pos * 32 + d];
                     bf16_t* dst = (bf16_t*)(c.R + R_QI) + (size_t)rs * 512 + h * 64 + d; dst[0] = f2bf(x1 * cs - x2 * sn); dst[32] = f2bf(x2 * cs + x1 * sn); } break;
        case E_KIWI: { if (j < 32) { const int d = j; const float x1 = Tr[d], x2 = Tr[32 + d], cs = c.cosI[pos * 32 + d], sn = c.sinI[pos * 32 + d];
                           bf16_t* dst = (bf16_t*)(c.R + R_KI) + (size_t)rs * 64 + d; dst[0] = f2bf((x1 * cs - x2 * sn) * 0.125f); dst[32] = f2bf((x2 * cs + x1 * sn) * 0.125f); }
                       else ((float*)(c.R + R_WI))[rs * 8 + (j - 32)] = Tr[64 + (j - 32)] * 0.35355339059327373f; } break;
        case E_SG: ((bf16_t*)(c.R + R_SG))[(size_t)rowg * 2048 + e.p0 * 1024 + j] = f2bf(sigmoidf_(Tr[j])); break;
        case E_YA: ((bf16_t*)(c.R + R_M1))[(size_t)rowg * 1024 + j] = f2bf(bf2f(((const bf16_t*)(c.R + R_SG))[(size_t)rowg * 2048 + j]) * Tr[j]); break;
        case E_YB: ((bf16_t*)(c.R + R_MG))[(size_t)rowg * 1024 + j] = f2bf(bf2f(((const bf16_t*)(c.R + R_M1))[(size_t)rowg * 1024 + j]) + bf2f(((const bf16_t*)(c.R + R_SG))[(size_t)rowg * 2048 + 1024 + j]) * Tr[j]); break;
        case E_WO: c.out[(size_t)rowg * 1024 + j] = e.base[(size_t)rowg * 1024 + j] + Tr[j]; break;
        case E_SWIGLU: ((bf16_t*)(c.R + R_ACT))[(size_t)rowg * FF + e.p0 * 256 + j] = f2bf(siluf_(Tr[j]) * Tr[256 + j]); break;
        case E_DOWN: c.out[(size_t)rowg * 1024 + j] += Tr[j]; break;
        }
    }
}

__device__ void naive_conv(const Ctx& c, int layer) {
    bf16_t* Q = (bf16_t*)(c.R + R_QKVA); const bf16_t* H = (const bf16_t*)(c.R + R_HALO); const float* cw = c.conv_w + (size_t)layer * 4 * 3072;
    const int gt = blockIdx.x * blockDim.x + otid(), nt = gridDim.x * blockDim.x;
    for (int idx = gt; idx < (MS / 64) * 3072; idx += nt) {
        const int ch = idx % 3072, ck = idx / 3072;
        const float w0 = cw[ch], w1 = cw[3072 + ch], w2 = cw[2 * 3072 + ch], w3 = cw[3 * 3072 + ch];
        float x3 = 0.f, x2 = 0.f, x1 = 0.f;
        if ((ck * 64) % SEQ != 0) { const bf16_t* hp = H + (size_t)(ck - 1) * 3 * 3072 + ch; x3 = bf2f(hp[0]); x2 = bf2f(hp[3072]); x1 = bf2f(hp[2 * 3072]); }
        bf16_t* p = Q + (size_t)ck * 64 * 3072 + ch;
        for (int r = 0; r < 64; ++r) { const float xv = bf2f(p[(size_t)r * 3072]); const float y = w0 * x3 + w1 * x2 + w2 * x1 + w3 * xv; p[(size_t)r * 3072] = f2bf(siluf_(y)); x3 = x2; x2 = x1; x1 = xv; }
    }
}
__device__ void naive_l2norm(const Ctx& c) {
    bf16_t* Q = (bf16_t*)(c.R + R_QKVA);
    const int lane = otid() & 63, gw = (blockIdx.x * blockDim.x + otid()) >> 6, nw = (gridDim.x * blockDim.x) >> 6;
    for (int t = gw; t < MS * 16; t += nw) {
        const int r = t >> 4, hh = t & 15;
        unsigned* p = (unsigned*)(Q + (size_t)r * 3072 + hh * 128) + lane; const unsigned raw = *p;
        const float a = bf2f(raw & 0xffffu), b = bf2f(raw >> 16); const float rs = rsqrtf(wave_sum(a * a + b * b) + EPS);
        *p = f2bf(a * rs) | ((unsigned)f2bf(b * rs) << 16);
    }
}
__device__ void naive_scan(const Ctx& c, unsigned char* smem) {
    const bf16_t* Q = (const bf16_t*)(c.R + R_QKVA); const float* GG = (const float*)(c.R + R_GG); const float* BT = (const float*)(c.R + R_BETA); float* O = (float*)(c.R + R_TMP);
    const int lane = otid() & 63, wv = otid() >> 6, gw = blockIdx.x * 8 + wv, nw = gridDim.x * 8;
    float* kL = (float*)smem + wv * 4096; float* qL = kL + 2048;
    const int dq = lane >> 4, el = lane & 15;
    for (int task = gw; task < BPS * 8 * 8; task += nw) {
        const int eb = task & 7, h = (task >> 3) & 7, bl = task >> 6, e = eb * 16 + el;
        float S[32];
#pragma unroll
        for (int i = 0; i < 32; ++i) S[i] = 0.f;
        for (int t0 = 0; t0 < SEQ; t0 += 16) {
            for (int tk = 0; tk < 16; ++tk) { const size_t row = (size_t)bl * SEQ + t0 + tk;
                const unsigned qr = *((const unsigned*)(Q + row * 3072 + h * 128) + lane), kr = *((const unsigned*)(Q + row * 3072 + 1024 + h * 128) + lane);
                qL[tk * 128 + lane * 2] = bf2f(qr & 0xffffu); qL[tk * 128 + lane * 2 + 1] = bf2f(qr >> 16); kL[tk * 128 + lane * 2] = bf2f(kr & 0xffffu); kL[tk * 128 + lane * 2 + 1] = bf2f(kr >> 16); }
            __builtin_amdgcn_s_waitcnt(0); __builtin_amdgcn_wave_barrier();
            for (int tk = 0; tk < 16; ++tk) { const size_t row = (size_t)bl * SEQ + t0 + tk;
                const float eg = __expf(GG[row * 8 + h]), bt = BT[row * 8 + h], v = bf2f(Q[row * 3072 + 2048 + h * 128 + e]);
                const float* kp = kL + tk * 128 + dq * 32; const float* qp = qL + tk * 128 + dq * 32;
                float ks = 0.f;
#pragma unroll
                for (int i = 0; i < 32; ++i) ks += kp[i] * S[i];
                ks += __shfl_xor(ks, 16); ks += __shfl_xor(ks, 32);
                const float cc = bt * (v - eg * ks); float o = 0.f;
#pragma unroll
                for (int i = 0; i < 32; ++i) { S[i] = eg * S[i] + kp[i] * cc; o += qp[i] * S[i]; }
                o += __shfl_xor(o, 16); o += __shfl_xor(o, 32);
                if (dq == 0) O[row * 1024 + h * 128 + e] = o * 0.08838834764831845f;
            }
            __builtin_amdgcn_s_waitcnt(0); __builtin_amdgcn_wave_barrier();
        }
    }
}
__device__ void naive_gate(const Ctx& c, int layer, int split) {
    const float* O = (const float*)(c.R + R_TMP); const bf16_t* Z = (const bf16_t*)(c.R + R_ZS); const float* gn = c.gdn_norm + layer * 128;
    const int lane = otid() & 63, gw = (blockIdx.x * blockDim.x + otid()) >> 6, nw = (gridDim.x * blockDim.x) >> 6;
    for (int t = gw; t < MS * 8; t += nw) {
        const int r = t >> 3, h = t & 7; const size_t off = (size_t)r * 1024 + h * 128 + lane * 2;
        const float a = O[off], b = O[off + 1]; const float rs = rsqrtf(wave_sum(a * a + b * b) * (1.f / 128.f) + EPS);
        const unsigned z = *(const unsigned*)(Z + off);
        *(unsigned*)(c.OA + (size_t)split * MS * 1024 + off) = f2bf(a * rs * gn[lane * 2] * bf2f(z & 0xffffu)) | ((unsigned)f2bf(b * rs * gn[lane * 2 + 1] * bf2f(z >> 16)) << 16);
    }
}

__device__ void naive_dsa(const Ctx& c, int split, unsigned char* smem) {
    const bf16_t* QB = (const bf16_t*)(c.R + R_QB); const bf16_t* KB = (const bf16_t*)(c.R + R_KB); const bf16_t* VB = (const bf16_t*)(c.R + R_VB);
    const bf16_t* QI = (const bf16_t*)(c.R + R_QI); const bf16_t* KI = (const bf16_t*)(c.R + R_KI); const float* WI = (const float*)(c.R + R_WI);
    float* qi = (float*)smem; float* qf = qi + 512; float* sc = qf + 1024; float* scores = sc + 2048; unsigned* sel = (unsigned*)(scores + 4096); float* wi = (float*)(sel + 272); unsigned* cnt = (unsigned*)(wi + 8);
    const int tid = otid(), lane = tid & 63, wv = tid >> 6;
    for (int row = blockIdx.x; row < MS; row += gridDim.x) {
        const int t = row % SEQ, rb = row - t, n = t + 1;
        __syncthreads();
        qi[tid] = bf2f(QI[(size_t)row * 512 + tid]); qf[tid] = bf2f(QB[(size_t)row * 1024 + tid]); qf[tid + 512] = bf2f(QB[(size_t)row * 1024 + 512 + tid]);
        if (tid < 8) wi[tid] = WI[row * 8 + tid];
        if (tid == 0) { cnt[0] = 0; cnt[1] = 0; cnt[2] = 0; cnt[3] = 0; }
        __syncthreads();
        for (int s = tid; s < n; s += 512) {
            const uint4* kp = (const uint4*)(KI + (size_t)(rb + s) * 64);
            float acc = 0.f;
#pragma unroll 1
            for (int h = 0; h < 8; ++h) { float d = 0.f;
#pragma unroll 2
                for (int i = 0; i < 8; ++i) { const uint4 w = kp[i]; const float* qp = qi + h * 64 + i * 8;
                    d += qp[0] * bf2f(w.x & 0xffffu) + qp[1] * bf2f(w.x >> 16) + qp[2] * bf2f(w.y & 0xffffu) + qp[3] * bf2f(w.y >> 16)
                       + qp[4] * bf2f(w.z & 0xffffu) + qp[5] * bf2f(w.z >> 16) + qp[6] * bf2f(w.w & 0xffffu) + qp[7] * bf2f(w.w >> 16); }
                acc += wi[h] * fmaxf(d, 0.f); }
            scores[s] = acc + 0.f;
        }
        __syncthreads();
        int nsel;
        if (n <= TOPK) { for (int s = tid; s < n; s += 512) sel[s] = s; nsel = n; }
        else {
            unsigned T = 0;
            for (int bit = 31; bit >= 0; --bit) {
                const unsigned cand = T | (1u << bit); unsigned my = 0;
                for (int s = tid; s < n; s += 512) { unsigned u = __float_as_uint(scores[s]); u = (u & 0x80000000u) ? ~u : (u | 0x80000000u); my += (u >= cand) ? 1u : 0u; }
                my = (unsigned)wave_sum((float)my);
                if (lane == 0) atomicAdd(&cnt[1], my);
                __syncthreads();
                const unsigned tot = cnt[1];
                __syncthreads();
                if (tid == 0) cnt[1] = 0;
                if (tot >= (unsigned)TOPK) T = cand;
                __syncthreads();
            }
            unsigned mgt = 0, meq = 0;
            for (int s = tid; s < n; s += 512) { unsigned u = __float_as_uint(scores[s]); u = (u & 0x80000000u) ? ~u : (u | 0x80000000u); mgt += (u > T); meq += (u == T); }
            mgt = (unsigned)wave_sum((float)mgt); meq = (unsigned)wave_sum((float)meq);
            if (lane == 0) { atomicAdd(&cnt[2], mgt); atomicAdd(&cnt[3], meq); }
            __syncthreads();
            const unsigned cgt = cnt[2], ceq = cnt[3], need = TOPK - cgt;
            unsigned base = 0, eqbase = 0;
            for (int s0 = 0; s0 < n; s0 += 512) {
                const int s = s0 + tid; unsigned u = 0; if (s < n) { u = __float_as_uint(scores[s]); u = (u & 0x80000000u) ? ~u : (u | 0x80000000u); }
                const bool gt = (s < n) && (u > T), eq = (s < n) && (u == T);
                const unsigned long long bg = __ballot(gt), be = __ballot(eq), lm = (1ull << lane) - 1ull;
                if (lane == 0) { sel[256 + wv] = (unsigned)__popcll(bg); sel[264 + wv] = (unsigned)__popcll(be); }
                __syncthreads();
                unsigned pg = 0, pe = 0, tg = 0, te = 0;
                for (int w = 0; w < 8; ++w) { const unsigned a = sel[256 + w], e = sel[264 + w]; if (w < wv) { pg += a; pe += e; } tg += a; te += e; }
                const unsigned eqrank = eqbase + pe + (unsigned)__popcll(be & lm);
                const unsigned eqbefore = min(eqbase + pe + (unsigned)__popcll(be & lm), need);
                (void)eqbefore;
                const unsigned gtbefore = base + pg + (unsigned)__popcll(bg & lm);
                if (gt) sel[gtbefore + min(eqbase + pe + (unsigned)__popcll(be & lm), need)] = s;
                else if (eq && eqrank < need) sel[gtbefore + eqrank] = s;
                __syncthreads();
                base += tg; eqbase += te;
            }
            nsel = TOPK;
        }
        __syncthreads();
        for (int p = tid; p < 8 * TOPK; p += 512) { const int h = p >> 8, j = p & 255;
            if (j < nsel) { const uint4* kp = (const uint4*)(KB + (size_t)(rb + sel[j]) * 1024 + h * 128); const float* qp = qf + h * 128; float d = 0.f;
#pragma unroll 4
                for (int i = 0; i < 16; ++i) { const uint4 w = kp[i]; d += qp[i * 8] * bf2f(w.x & 0xffffu) + qp[i * 8 + 1] * bf2f(w.x >> 16) + qp[i * 8 + 2] * bf2f(w.y & 0xffffu) + qp[i * 8 + 3] * bf2f(w.y >> 16)
                        + qp[i * 8 + 4] * bf2f(w.z & 0xffffu) + qp[i * 8 + 5] * bf2f(w.z >> 16) + qp[i * 8 + 6] * bf2f(w.w & 0xffffu) + qp[i * 8 + 7] * bf2f(w.w >> 16); }
                sc[h * 256 + j] = d * 0.08838834764831845f; } }
        __syncthreads();
        { float* sp = sc + wv * 256; float mx = -3.0e38f; for (int j = lane; j < nsel; j += 64) mx = fmaxf(mx, sp[j]); mx = wave_max(mx);
          float sm = 0.f; for (int j = lane; j < nsel; j += 64) { const float pz = __expf(sp[j] - mx); sp[j] = pz; sm += pz; } sm = wave_sum(sm); const float inv = 1.f / sm;
          for (int j = lane; j < nsel; j += 64) sp[j] *= inv; }
        __syncthreads();
        { const int o = tid * 2, h = o >> 7; const float* sp = sc + h * 256; float a0 = 0.f, a1 = 0.f;
          for (int j = 0; j < nsel; ++j) { const unsigned w = *(const unsigned*)(VB + (size_t)(rb + sel[j]) * 1024 + o); const float pz = sp[j]; a0 += pz * bf2f(w & 0xffffu); a1 += pz * bf2f(w >> 16); }
          *(unsigned*)(c.AT + ((size_t)split * MS + row) * 1024 + o) = f2bf(a0) | ((unsigned)f2bf(a1) << 16); }
    }
}

namespace pg8 {
#define PG8_LAS __attribute__((address_space(3)))
typedef unsigned short bf16_t;
typedef short bf16x8 __attribute__((ext_vector_type(8)));
typedef float f32x4 __attribute__((ext_vector_type(4)));
typedef unsigned u32x4 __attribute__((ext_vector_type(4)));
constexpr int BM = 256, BK = 64, HALF = 128, HTB = HALF * BK * 2  , STAGE_BYTES = 8 * HTB, NXCD = 8, WGM = 8;

__host__ __device__ __forceinline__ int lds_byte(int r, int c) { const int st = (r >> 4) * 2 + (c >> 5), rr = r & 15, cc = c & 31, ob = rr * 64 + cc * 2; return st * 1024 + (ob ^ (((ob >> 9) & 1) << 5)); }
__host__ __device__ __forceinline__ void stage_rc(int b, int& R, int& C) { const int st = b / 1024, sb = b % 1024, swz = sb ^ (((sb >> 9) & 1) << 5); R = (st >> 1) * 16 + swz / 64; C = (st & 1) * 32 + (swz % 64) / 2; }
__host__ __device__ __forceinline__ int perm32(int rho) { const int n = rho >> 4, i = rho & 15; return 8 * (i >> 2) + 4 * n + (i & 3); }

struct Unit { int pm, pn; };
struct Gemm { const bf16_t* A; const bf16_t* Bt; int M, N, K; };

struct StaticOrder {
    int nM, nN, nwg, G, c;
    __host__ __device__ void init(int M, int N, int G_, int c_) { nM = M / BM; nN = N / BM; nwg = nM * nN; G = G_; c = c_; }
    __host__ __device__ bool next(int i, Unit& u) const {
        const long L = (long)i * G + c; if (L >= nwg) return false;
        int wgid = (int)L; { const int q = nwg / NXCD, r = nwg % NXCD, xcd = wgid % NXCD, off = wgid / NXCD; wgid = (xcd < r ? xcd * (q + 1) : r * (q + 1) + (xcd - r) * q) + off; }
        const int nig = WGM * nN, gid = wgid / nig, fm = gid * WGM, gsz = (nM - fm) < WGM ? (nM - fm) : WGM;
        u.pm = fm + ((wgid % nig) % gsz); u.pn = (wgid % nig) / gsz; return true;
    }
    __device__ __forceinline__ void a_ready(const Unit&) const {}
    __device__ __forceinline__ void done(const Unit&) const {}
};


__device__ __forceinline__ unsigned cvt_pk_bf16(float lo, float hi) { unsigned r; asm volatile("v_cvt_pk_bf16_f32 %0, %1, %2" : "=v"(r) : "v"(lo), "v"(hi)); return r; }

template <class Epi, class Sched, bool ALIGN_EPI = false, bool SP2 = false>
__device__ __forceinline__ void gemm_phase(PG8_LAS unsigned char* lds, const Gemm g, const Sched& S, const Epi& E) {
    const int tid = otid(), wid = __builtin_amdgcn_readfirstlane(tid >> 6), lane = tid & 63, wr = wid >> 2, wc = wid & 3, fr = lane & 15, fq = lane >> 4;
    const int K = g.K, nt = K / BK;
    unsigned voffA[2], voffB[2];
#pragma unroll
    for (int i = 0; i < 2; ++i) { int R, C; stage_rc(tid * 16 + i * 8192, R, C); const int Rb = Epi::PERM ? ((R & ~31) + perm32(R & 31)) : R;
        voffA[i] = (unsigned)(R * K + C) * 2u; voffB[i] = (unsigned)(Rb * K + C) * 2u; }
    const size_t kstep = (size_t)(BK * 2);
    const size_t hstep = (size_t)HALF * K * 2;
    const size_t tstep = 2 * hstep;
    const unsigned ldsw = (unsigned)wid * 1024u;
    const int aoff = lds_byte(wr * 64 + fr, fq * 8), boff = lds_byte(wc * 32 + fr, fq * 8);
#define PG8_SA(b, h) (((b) * 2 + (h)) * HTB)
#define PG8_SB(b, h) ((4 + (b) * 2 + (h)) * HTB)
#define PG8_STAGE(bufoff, gbase, voff) do { _Pragma("unroll") for (int _i = 0; _i < 2; ++_i) \
        __builtin_amdgcn_global_load_lds((const unsigned*)((const char*)(gbase) + (voff)[_i]), (PG8_LAS unsigned*)(lds + (bufoff) + ldsw + _i * 8192), 16, 0, 0); } while (0)
#define PG8_LDA(dst, b, h) do { _Pragma("unroll") for (int m = 0; m < 4; ++m) _Pragma("unroll") for (int k = 0; k < 2; ++k) dst[m][k] = *(const PG8_LAS bf16x8*)(lds + PG8_SA(b, h) + aoff + m * 2048 + k * 1024); } while (0)
#define PG8_LDB(dst, b, h) do { _Pragma("unroll") for (int n = 0; n < 2; ++n) _Pragma("unroll") for (int k = 0; k < 2; ++k) dst[n][k] = *(const PG8_LAS bf16x8*)(lds + PG8_SB(b, h) + boff + n * 2048 + k * 1024); } while (0)
#define PG8_MMA(ai, bj, At, Bt) do { __builtin_amdgcn_s_setprio(1); _Pragma("unroll") for (int m = 0; m < 4; ++m) _Pragma("unroll") for (int n = 0; n < 2; ++n) _Pragma("unroll") for (int k = 0; k < 2; ++k) \
        acc[ai][bj][m][n] = __builtin_amdgcn_mfma_f32_16x16x32_bf16(Bt[n][k], At[m][k], acc[ai][bj][m][n], 0, 0, 0); __builtin_amdgcn_s_setprio(0); } while (0)
#define PG8_WAIT_V(n) asm volatile("s_waitcnt vmcnt(" #n ")" ::: "memory")
#define PG8_WAIT_L(n) asm volatile("s_waitcnt lgkmcnt(" #n ")" ::: "memory")
#define PG8_BAR __builtin_amdgcn_s_barrier()
#define PG8_SCHED __builtin_amdgcn_sched_barrier(0)
    Unit cur, nxt; int ui = 0;
    if (!S.next(0, cur)) return;
    f32x4 acc[2][2][4][2];
#pragma unroll
    for (int a = 0; a < 2; ++a)
#pragma unroll
        for (int b = 0; b < 2; ++b)
#pragma unroll
            for (int m = 0; m < 4; ++m)
#pragma unroll
                for (int n = 0; n < 2; ++n) acc[a][b][m][n] = (f32x4){0.f, 0.f, 0.f, 0.f};
    bf16x8 At[4][2], B0[2][2], B1[2][2];
    const char* cA = (const char*)g.A + (size_t)cur.pm * tstep; const char* cB = (const char*)g.Bt + (size_t)cur.pn * tstep;
    S.a_ready(cur);
    if constexpr (SP2) {
        PG8_STAGE(PG8_SB(0, 0), cB, voffB); PG8_STAGE(PG8_SB(0, 1), cB + hstep, voffB); PG8_STAGE(PG8_SA(0, 0), cA, voffA); PG8_STAGE(PG8_SA(0, 1), cA + hstep, voffA);
        if (wr == 1) PG8_BAR;
        PG8_WAIT_V(2); PG8_BAR;
        PG8_STAGE(PG8_SB(1, 0), cB + kstep, voffB); PG8_STAGE(PG8_SA(1, 0), cA + kstep, voffA); PG8_STAGE(PG8_SB(1, 1), cB + hstep + kstep, voffB);
        PG8_WAIT_V(6); PG8_BAR;
    } else {
        PG8_STAGE(PG8_SB(0, 0), cB, voffB); PG8_STAGE(PG8_SA(0, 0), cA, voffA); PG8_STAGE(PG8_SB(0, 1), cB + hstep, voffB); PG8_STAGE(PG8_SA(0, 1), cA + hstep, voffA);
        if (wr == 1) PG8_BAR;
        PG8_WAIT_V(4); PG8_BAR;
        PG8_STAGE(PG8_SB(1, 0), cB + kstep, voffB); PG8_STAGE(PG8_SA(1, 0), cA + kstep, voffA); PG8_STAGE(PG8_SB(1, 1), cB + hstep + kstep, voffB);
        PG8_WAIT_V(6); PG8_BAR;
    }
    for (;;) {
        const bool has_next = S.next(ui + 1, nxt);
        const char* nA = has_next ? (const char*)g.A + (size_t)nxt.pm * tstep : cA; const char* nB = has_next ? (const char*)g.Bt + (size_t)nxt.pn * tstep : cB;
        for (int t = 0; t < nt; t += 2) {
            const bool last = (t == nt - 2);
            const char* a1 = cA + (size_t)(t + 1) * kstep;
            const char* a2 = last ? nA : cA + (size_t)(t + 2) * kstep; const char* b2 = last ? nB : cB + (size_t)(t + 2) * kstep;
            const char* a3 = a2 + kstep; const char* b3 = b2 + kstep;
            if (last && has_next) S.a_ready(nxt);
            if constexpr (SP2) {
            PG8_LDB(B0, 0, 0); PG8_LDB(B1, 0, 1); PG8_SCHED; PG8_LDA(At, 0, 0); PG8_STAGE(PG8_SA(1, 1), a1 + hstep, voffA);
            PG8_WAIT_V(8); PG8_WAIT_L(0); PG8_BAR; PG8_MMA(0, 0, At, B0); PG8_MMA(0, 1, At, B1); PG8_BAR; PG8_SCHED;
            PG8_LDA(At, 0, 1); PG8_STAGE(PG8_SB(0, 0), b2, voffB); PG8_STAGE(PG8_SB(0, 1), b2 + hstep, voffB); PG8_STAGE(PG8_SA(0, 0), a2, voffA);
            PG8_WAIT_V(8); PG8_WAIT_L(0); PG8_BAR; PG8_MMA(1, 0, At, B0); PG8_MMA(1, 1, At, B1); PG8_BAR; PG8_SCHED;
            PG8_LDB(B0, 1, 0); PG8_LDB(B1, 1, 1); PG8_SCHED; PG8_LDA(At, 1, 0); PG8_STAGE(PG8_SA(0, 1), a2 + hstep, voffA);
            PG8_WAIT_V(8); PG8_WAIT_L(0); PG8_BAR; PG8_MMA(0, 0, At, B0); PG8_MMA(0, 1, At, B1); PG8_BAR; PG8_SCHED;
            PG8_LDA(At, 1, 1); PG8_STAGE(PG8_SB(1, 0), b3, voffB); PG8_STAGE(PG8_SB(1, 1), b3 + hstep, voffB); PG8_STAGE(PG8_SA(1, 0), a3, voffA);
            PG8_WAIT_V(8); PG8_WAIT_L(0); PG8_BAR; PG8_MMA(1, 0, At, B0); PG8_MMA(1, 1, At, B1); PG8_BAR; PG8_SCHED;
            } else {
            PG8_LDB(B0, 0, 0); PG8_SCHED; PG8_LDA(At, 0, 0); PG8_STAGE(PG8_SA(1, 1), a1 + hstep, voffA);
            PG8_WAIT_L(8); PG8_BAR; PG8_WAIT_L(0); PG8_MMA(0, 0, At, B0); PG8_BAR; PG8_SCHED;
            PG8_LDB(B1, 0, 1); PG8_STAGE(PG8_SB(0, 0), b2, voffB);
            PG8_BAR; PG8_WAIT_L(0); PG8_MMA(0, 1, At, B1); PG8_BAR;
            PG8_LDA(At, 0, 1); PG8_STAGE(PG8_SA(0, 0), a2, voffA);
            PG8_BAR; PG8_WAIT_L(0); PG8_MMA(1, 0, At, B0); PG8_BAR; PG8_SCHED;
            PG8_STAGE(PG8_SB(0, 1), b2 + hstep, voffB);
            PG8_WAIT_V(6); PG8_BAR; PG8_MMA(1, 1, At, B1); PG8_BAR;
            PG8_LDB(B0, 1, 0); PG8_SCHED; PG8_LDA(At, 1, 0); PG8_STAGE(PG8_SA(0, 1), a2 + hstep, voffA);
            PG8_WAIT_L(8); PG8_BAR; PG8_WAIT_L(0); PG8_MMA(0, 0, At, B0); PG8_BAR; PG8_SCHED;
            PG8_LDB(B1, 1, 1); PG8_STAGE(PG8_SB(1, 0), b3, voffB);
            PG8_BAR; PG8_WAIT_L(0); PG8_MMA(0, 1, At, B1); PG8_BAR;
            PG8_LDA(At, 1, 1); PG8_STAGE(PG8_SA(1, 0), a3, voffA);
            PG8_BAR; PG8_WAIT_L(0); PG8_MMA(1, 0, At, B0); PG8_BAR; PG8_SCHED;
            PG8_STAGE(PG8_SB(1, 1), b3 + hstep, voffB);
            PG8_WAIT_V(6); PG8_BAR; PG8_MMA(1, 1, At, B1); PG8_BAR;
            }
        }
        if constexpr (ALIGN_EPI) { if (wr == 0) PG8_BAR; }
        if constexpr (!Epi::AFTER_DRAIN) { E(acc, cur, wr, wc, fr, fq); S.done(cur); }
        if (!has_next) break;
#pragma unroll
        for (int a = 0; a < 2; ++a)
#pragma unroll
            for (int b = 0; b < 2; ++b)
#pragma unroll
                for (int m = 0; m < 4; ++m)
#pragma unroll
                    for (int n = 0; n < 2; ++n) acc[a][b][m][n] = (f32x4){0.f, 0.f, 0.f, 0.f};
        cur = nxt; cA = nA; cB = nB; ++ui;
        if constexpr (ALIGN_EPI) { if (wr == 1) PG8_BAR; }
    }
    PG8_WAIT_V(0);
    if constexpr (!ALIGN_EPI) { if (wr == 0) PG8_BAR; }
    PG8_BAR;
    if constexpr (Epi::AFTER_DRAIN) { E.fused(acc, cur, wr, wc, fr, fq, lds, wid, lane); S.done(cur); }
#undef PG8_SA
#undef PG8_SB
#undef PG8_STAGE
#undef PG8_LDA
#undef PG8_LDB
#undef PG8_MMA
#undef PG8_WAIT_V
#undef PG8_WAIT_L
#undef PG8_BAR
#undef PG8_SCHED
}
}

#define STAGE_OPT_INPROJ 1
#define STAGE_OPT_GATES 1
#define STAGE_OPT_Y 1
#define STAGE_OPT_WO 1
#define STAGE_OPT_GU 1
#define STAGE_OPT_DN 1
constexpr bool ANY_OPT_GEMM = STAGE_OPT_INPROJ || STAGE_OPT_GATES || STAGE_OPT_Y || STAGE_OPT_WO || STAGE_OPT_GU || STAGE_OPT_DN;
constexpr int WIN_ROWS = 39 * 256;
constexpr size_t WT_IN = 0, WT_OG = WT_IN + (size_t)WIN_ROWS * 1024 * 2, WT_OD = WT_OG + 2 * MiB, WT_O = WT_OD + 2 * MiB, WT_GU = WT_O + 2 * MiB, WT_DN = WT_GU + (size_t)2 * FF * 1024 * 2, WT_END = WT_DN + (size_t)1024 * FF * 2;
static_assert(WT_END <= 42 * MiB, "weight region");
typedef unsigned u32x4 __attribute__((ext_vector_type(4)));
typedef unsigned u32x2 __attribute__((ext_vector_type(2)));
__device__ __forceinline__ unsigned pk2(float lo, float hi) { return pg8::cvt_pk_bf16(lo, hi); }
__device__ __forceinline__ u32x2 pk4(f32x4 v) { u32x2 w; w.x = pk2(v[0], v[1]); w.y = pk2(v[2], v[3]); return w; }
__device__ __forceinline__ u32x4 pk8(f32x4 a, f32x4 b) { u32x4 w; w.x = pk2(a[0], a[1]); w.y = pk2(a[2], a[3]); w.z = pk2(b[0], b[1]); w.w = pk2(b[2], b[3]); return w; }
__device__ __forceinline__ f32x4 unpk4lo(u32x4 w) { return (f32x4){bf2f(w.x & 0xffffu), bf2f(w.x >> 16), bf2f(w.y & 0xffffu), bf2f(w.y >> 16)}; }
__device__ __forceinline__ f32x4 unpk4hi(u32x4 w) { return (f32x4){bf2f(w.z & 0xffffu), bf2f(w.z >> 16), bf2f(w.w & 0xffffu), bf2f(w.w >> 16)}; }
__device__ __forceinline__ f32x4 sig4(f32x4 v) { return (f32x4){sigmoidf_(v[0]), sigmoidf_(v[1]), sigmoidf_(v[2]), sigmoidf_(v[3])}; }
__device__ __forceinline__ f32x4 silu4(f32x4 v) { return (f32x4){siluf_(v[0]), siluf_(v[1]), siluf_(v[2]), siluf_(v[3])}; }

__device__ __forceinline__ int rope_pos(int d, int half) { const int n = d / half, dl = d % half; return 32 * (dl >> 4) + 8 * ((dl >> 2) & 3) + 4 * n + (dl & 3); }
__device__ __forceinline__ int map_win(int n) {
    if (n < C_A) return n;
    if (n < C_B) return 30 * 256 + 72 + (n - C_A);
    if (n < C_QB) return 30 * 256 + 80 + (n - C_B);
    if (n < C_VB) { const int m = n - C_QB, hd = m >> 7, d = m & 127; return (16 + (hd >> 1)) * 256 + (hd & 1) * 128 + rope_pos(d, 64); }
    if (n < C_QI) return 24 * 256 + (n - C_VB);
    if (n < C_KI) { const int m = n - C_QI, hd = m >> 6, d = m & 63; return (28 + (hd >> 2)) * 256 + ((hd >> 1) & 1) * 128 + (hd & 1) * 64 + rope_pos(d, 32); }
    if (n < C_WI) return 30 * 256 + rope_pos(n - C_KI, 32);
    if (n < C_GA) return 30 * 256 + 64 + (n - C_WI);
    return 31 * 256 + (n - C_GA);
}
__device__ __forceinline__ int map_gu(int cidx) { const int nn = cidx >= FF ? 1 : 0, f = cidx - nn * FF; return 8 * (f >> 2) + 4 * nn + (f & 3); }
template <int MAPK> __device__ __forceinline__ void transpose_item(const float* W, int K, int N, bf16_t* WT, float* scr, int item, int lane) {
    const int nblk = (N + 31) / 32, kb = item / nblk, nb = item % nblk, k0 = 64 * kb, n0 = 32 * nb;
    const int nn = n0 + (lane & 31);
#pragma unroll 8
    for (int i = 0; i < 32; ++i) { const int kk = 2 * i + (lane >> 5); scr[kk * 33 + (lane & 31)] = nn < N ? W[(size_t)(k0 + kk) * N + nn] : 0.f; }
    asm volatile("s_waitcnt lgkmcnt(0)" ::: "memory");
    const int cch = lane & 7;
#pragma unroll
    for (int j = 0; j < 4; ++j) { const int n = (lane >> 3) + 8 * j;
        if (n0 + n < N) { const float* sp = scr + (8 * cch) * 33 + n; const int row = MAPK == 1 ? map_win(n0 + n) : (MAPK == 2 ? map_gu(n0 + n) : n0 + n);
            u32x4 o; o.x = pk2(sp[0], sp[33]); o.y = pk2(sp[2 * 33], sp[3 * 33]); o.z = pk2(sp[4 * 33], sp[5 * 33]); o.w = pk2(sp[6 * 33], sp[7 * 33]);
            *(u32x4*)(WT + (size_t)row * K + k0 + 8 * cch) = o; } }
    asm volatile("s_waitcnt lgkmcnt(0)" ::: "memory");
}
__device__ void phase_convert_weights(const Ctx& c, int layer, unsigned char* smem) {
    const int lane = otid() & 63, wv = otid() >> 6, gw = blockIdx.x * 8 + wv, nw = gridDim.x * 8;
    float* scr = (float*)smem + wv * (64 * 33);
    unsigned char* wt = c.ws + WS_WT;
    constexpr int I_IN = 16 * ((INC + 31) / 32), I_SQ = 16 * 32, I_GU = 16 * (2 * FF / 32), I_DN = (FF / 64) * 32;
    for (int it = gw; it < I_IN + 3 * I_SQ + I_GU + I_DN; it += nw) {
        int r = it;
        if (r < I_IN) { transpose_item<1>(c.w_in + (size_t)layer * DM * INC, DM, INC, (bf16_t*)(wt + WT_IN), scr, r, lane); continue; } r -= I_IN;
        if (r < I_SQ) { transpose_item<0>(c.w_out_gdn + (size_t)layer * DM * DM, DM, DM, (bf16_t*)(wt + WT_OG), scr, r, lane); continue; } r -= I_SQ;
        if (r < I_SQ) { transpose_item<0>(c.w_out_dsa + (size_t)layer * DM * DM, DM, DM, (bf16_t*)(wt + WT_OD), scr, r, lane); continue; } r -= I_SQ;
        if (r < I_SQ) { transpose_item<0>(c.w_o + (size_t)layer * DM * DM, DM, DM, (bf16_t*)(wt + WT_O), scr, r, lane); continue; } r -= I_SQ;
        if (r < I_GU) { transpose_item<2>(c.w_gate_up + (size_t)layer * DM * 2 * FF, DM, 2 * FF, (bf16_t*)(wt + WT_GU), scr, r, lane); continue; } r -= I_GU;
        transpose_item<0>(c.w_down + (size_t)layer * FF * DM, FF, DM, (bf16_t*)(wt + WT_DN), scr, r, lane);
    }
}

#define EPI_ROWS(...) _Pragma("unroll") for (int ai = 0; ai < 2; ++ai) _Pragma("unroll") for (int m = 0; m < 4; ++m) { const int r = u.pm * 256 + ai * 128 + wr * 64 + m * 16 + fr; __VA_ARGS__ asm volatile("" ::: "memory"); }
struct EpiInProj {
    static constexpr bool PERM = true, AFTER_DRAIN = false;
    unsigned char* R; const float *cosA, *sinA, *cosI, *sinI, *a_log, *dt_bias;
    __device__ __forceinline__ void operator()(const f32x4 (&acc)[2][2][4][2], const pg8::Unit& u, int wr, int wc, int fr, int fq) const {
        asm volatile("" : "+v"(fr), "+v"(fq));
        const int pn = u.pn, cw = wc * 32 + 8 * fq;
        if (pn < 12) { bf16_t* Q = (bf16_t*)(R + R_QKVA); bf16_t* H = (bf16_t*)(R + R_HALO);
            EPI_ROWS(_Pragma("unroll") for (int bj = 0; bj < 2; ++bj) { const int col = pn * 256 + bj * 128 + cw; const u32x4 w = pk8(acc[ai][bj][m][0], acc[ai][bj][m][1]);
                *(u32x4*)(Q + (size_t)r * 3072 + col) = w; if (m == 3 && fr >= 13) *(u32x4*)(H + ((size_t)(r >> 6) * 3 + (fr - 13)) * 3072 + col) = w; }) }
        else if (pn < 16) { bf16_t* Z = (bf16_t*)(R + R_ZS);
            EPI_ROWS(_Pragma("unroll") for (int bj = 0; bj < 2; ++bj) { const int col = (pn - 12) * 256 + bj * 128 + cw; *(u32x4*)(Z + (size_t)r * 1024 + col) = pk8(silu4(acc[ai][bj][m][0]), silu4(acc[ai][bj][m][1])); }) }
        else if (pn < 24) { bf16_t* D = (bf16_t*)(R + ((pn - 16) >> 2 ? R_KB : R_QB)); const int dl = 16 * wc + 4 * fq;
            EPI_ROWS(const int pos = r % SEQ; const f32x4 cs = *(const f32x4*)(cosA + pos * 64 + dl), sn = *(const f32x4*)(sinA + pos * 64 + dl);
                _Pragma("unroll") for (int bj = 0; bj < 2; ++bj) { const int hd = ((pn - 16) & 3) * 2 + bj; const f32x4 x1 = acc[ai][bj][m][0], x2 = acc[ai][bj][m][1];
                    bf16_t* dp = D + (size_t)r * 1024 + hd * 128 + dl; *(u32x2*)dp = pk4(x1 * cs - x2 * sn); *(u32x2*)(dp + 64) = pk4(x2 * cs + x1 * sn); }) }
        else if (pn < 28) { bf16_t* V = (bf16_t*)(R + R_VB);
            EPI_ROWS(_Pragma("unroll") for (int bj = 0; bj < 2; ++bj) { const int col = (pn - 24) * 256 + bj * 128 + cw; *(u32x4*)(V + (size_t)r * 1024 + col) = pk8(acc[ai][bj][m][0], acc[ai][bj][m][1]); }) }
        else if (pn < 30) { bf16_t* QI = (bf16_t*)(R + R_QI); const int dl = 16 * (wc & 1) + 4 * fq;
            EPI_ROWS(const int pos = r % SEQ; const f32x4 cs = *(const f32x4*)(cosI + pos * 32 + dl), sn = *(const f32x4*)(sinI + pos * 32 + dl);
                _Pragma("unroll") for (int bj = 0; bj < 2; ++bj) { const int hd = (pn - 28) * 4 + bj * 2 + (wc >> 1); const f32x4 x1 = acc[ai][bj][m][0], x2 = acc[ai][bj][m][1];
                    bf16_t* dp = QI + (size_t)r * 512 + hd * 64 + dl; *(u32x2*)dp = pk4(x1 * cs - x2 * sn); *(u32x2*)(dp + 32) = pk4(x2 * cs + x1 * sn); }) }
        else {
            if (wc < 2) { bf16_t* KI = (bf16_t*)(R + R_KI); const int dl = 16 * wc + 4 * fq;
                EPI_ROWS(const int pos = r % SEQ; const f32x4 cs = *(const f32x4*)(cosI + pos * 32 + dl), sn = *(const f32x4*)(sinI + pos * 32 + dl);
                    const f32x4 x1 = acc[ai][0][m][0], x2 = acc[ai][0][m][1]; bf16_t* dp = KI + (size_t)r * 64 + dl;
                    *(u32x2*)dp = pk4((x1 * cs - x2 * sn) * 0.125f); *(u32x2*)(dp + 32) = pk4((x2 * cs + x1 * sn) * 0.125f);) }
            else if (wc == 2) {
                if (fq == 0) { float* WI = (float*)(R + R_WI); EPI_ROWS(*(f32x4*)(WI + r * 8) = acc[ai][0][m][0] * 0.35355339059327373f; *(f32x4*)(WI + r * 8 + 4) = acc[ai][0][m][1] * 0.35355339059327373f;) }
                else if (fq == 1) { float* GG = (float*)(R + R_GG);
                    EPI_ROWS(_Pragma("unroll") for (int n = 0; n < 2; ++n) { f32x4 o; _Pragma("unroll") for (int j = 0; j < 4; ++j) o[j] = -__expf(a_log[n * 4 + j]) * softplusf_(acc[ai][0][m][n][j] + dt_bias[n * 4 + j]); *(f32x4*)(GG + r * 8 + n * 4) = o; }) }
                else if (fq == 2) { float* BT = (float*)(R + R_BETA); EPI_ROWS(*(f32x4*)(BT + r * 8) = sig4(acc[ai][0][m][0]); *(f32x4*)(BT + r * 8 + 4) = sig4(acc[ai][0][m][1]);) }
            }
        }
    }
};
struct EpiGates {
    static constexpr bool PERM = true, AFTER_DRAIN = false; bf16_t* SG;
    __device__ __forceinline__ void operator()(const f32x4 (&acc)[2][2][4][2], const pg8::Unit& u, int wr, int wc, int fr, int fq) const {
        EPI_ROWS(_Pragma("unroll") for (int bj = 0; bj < 2; ++bj) { const int col = u.pn * 256 + bj * 128 + wc * 32 + 8 * fq; *(u32x4*)(SG + (size_t)r * 2048 + col) = pk8(sig4(acc[ai][bj][m][0]), sig4(acc[ai][bj][m][1])); })
    }
};
template <int WHICH> struct EpiY {
    static constexpr bool PERM = true, AFTER_DRAIN = false; const bf16_t* SG; bf16_t* MG;
    __device__ __forceinline__ void operator()(const f32x4 (&acc)[2][2][4][2], const pg8::Unit& u, int wr, int wc, int fr, int fq) const {
        EPI_ROWS(_Pragma("unroll") for (int bj = 0; bj < 2; ++bj) { const int col = u.pn * 256 + bj * 128 + wc * 32 + 8 * fq;
            const u32x4 g = *(const u32x4*)(SG + (size_t)r * 2048 + WHICH * 1024 + col); f32x4 lo = unpk4lo(g) * acc[ai][bj][m][0], hi = unpk4hi(g) * acc[ai][bj][m][1];
            if (WHICH == 1) { const u32x4 p = *(const u32x4*)(MG + (size_t)r * 1024 + col); lo += unpk4lo(p); hi += unpk4hi(p); }
            *(u32x4*)(MG + (size_t)r * 1024 + col) = pk8(lo, hi); })
    }
};
struct EpiResid {
    static constexpr bool PERM = true, AFTER_DRAIN = false; const float* base; float* out;
    __device__ __forceinline__ void operator()(const f32x4 (&acc)[2][2][4][2], const pg8::Unit& u, int wr, int wc, int fr, int fq) const {
        EPI_ROWS(_Pragma("unroll") for (int bj = 0; bj < 2; ++bj) { const size_t off = (size_t)r * 1024 + u.pn * 256 + bj * 128 + wc * 32 + 8 * fq;
            const f32x4 b0 = *(const f32x4*)(base + off), b1 = *(const f32x4*)(base + off + 4); *(f32x4*)(out + off) = b0 + acc[ai][bj][m][0]; *(f32x4*)(out + off + 4) = b1 + acc[ai][bj][m][1]; })
    }
};
struct EpiSwiglu {
    static constexpr bool PERM = true, AFTER_DRAIN = false; bf16_t* ACT;
    __device__ __forceinline__ void operator()(const f32x4 (&acc)[2][2][4][2], const pg8::Unit& u, int wr, int wc, int fr, int fq) const {
        EPI_ROWS(_Pragma("unroll") for (int bj = 0; bj < 2; ++bj) { const int f0 = u.pn * 128 + bj * 64 + wc * 16 + 4 * fq; *(u32x2*)(ACT + (size_t)r * FF + f0) = pk4(silu4(acc[ai][bj][m][0]) * acc[ai][bj][m][1]); })
    }
};

#define STAGE_OPT_GDN 1
typedef short bf16x8 __attribute__((ext_vector_type(8)));
typedef float f32x16 __attribute__((ext_vector_type(16)));
typedef float f32x2_t __attribute__((ext_vector_type(2)));
typedef __bf16 bf16x2_t __attribute__((ext_vector_type(2)));
__device__ __forceinline__ unsigned cvtpk_s(float lo, float hi) { f32x2_t v = {lo, hi}; bf16x2_t b = __builtin_convertvector(v, bf16x2_t); return __builtin_bit_cast(unsigned, b); }
__device__ __forceinline__ int crow(int r, int hi) { return (r & 3) + 8 * (r >> 2) + 4 * hi; }
#define MFMA32(a, b, c) __builtin_amdgcn_mfma_f32_32x32x16_bf16((a), (b), (c), 0, 0, 0)
__device__ __forceinline__ bf16x8 pack_step(const f32x16& x, int s) {
    u32x4 p; p.x = cvtpk_s(x[8 * s], x[8 * s + 1]); p.y = cvtpk_s(x[8 * s + 2], x[8 * s + 3]); p.z = cvtpk_s(x[8 * s + 4], x[8 * s + 5]); p.w = cvtpk_s(x[8 * s + 6], x[8 * s + 7]);
    return __builtin_bit_cast(bf16x8, p);
}
constexpr int BLOB_WF = 0, BLOB_QDF = 16384, BLOB_KDF = 32768, BLOB_A_BYTES = 49152, BLOB_QKF = 0, BLOB_UF = 8192, BLOB_B_BYTES = 24576;
constexpr size_t P2_BLOBB = 0, P2_GLAST = 24 * MiB, P2_MASK = 25 * MiB;
__device__ __forceinline__ unsigned char* vaddrA(unsigned char* qkva, int ck, int h, int v) { const int i = (v >> 8) & 63, part = v >> 14; return qkva + ((size_t)(ck * 64 + i) * 3072 + part * 1024 + h * 128) * 2 + (v & 255); }
__device__ __forceinline__ u32x4 frag_from_rows(const bf16_t* T, int ld, int it, int ks, int lane) {
    const int r = lane & 31, hh = lane >> 5; const bf16_t* p = T + (size_t)(32 * it + r) * ld + 32 * (ks >> 1) + 16 * (ks & 1) + 4 * hh;
    const u32x2 a = *(const u32x2*)p, b = *(const u32x2*)(p + 8); return (u32x4){a.x, a.y, b.x, b.y};
}

__device__ void gdn_prep_unit(const Ctx& c, int layer, int unit, unsigned char* smem) {
    const int tid = otid(), lane = tid & 63, wv = tid >> 6;
    const int h = unit & 7, ck = unit >> 3;
    bf16_t* Q = (bf16_t*)(c.R + R_QKVA); const bf16_t* HL = (const bf16_t*)(c.R + R_HALO);
    const float* cw = c.conv_w + (size_t)layer * 4 * 3072;
    float* X = (float*)smem;
    float* rq = X + 64 * 388; float* rk = rq + 64; float* gam = rk + 64; float* eg = gam + 64; float* egl = eg + 64; float* bet = egl + 64; float* gg = bet + 64;
    bf16_t* KNb = (bf16_t*)(gg + 64); bf16_t* QNb = KNb + 64 * 136;
    float* AM = (float*)(QNb + 64 * 136);
    const int row0 = ck * 64;
    __syncthreads();
    for (int q = tid; q < 4 * 384; q += 512) {
        const int g = q / 384, ch = q - g * 384, part = ch >> 7, col = part * 1024 + h * 128 + (ch & 127);
        const float w0 = cw[col], w1 = cw[3072 + col], w2 = cw[2 * 3072 + col], w3 = cw[3 * 3072 + col];
        float x3, x2, x1;
        if (g == 0) { if ((row0 % SEQ) == 0) { x3 = 0.f; x2 = 0.f; x1 = 0.f; } else { const bf16_t* hp = HL + (size_t)(ck - 1) * 3 * 3072 + col; x3 = bf2f(hp[0]); x2 = bf2f(hp[3072]); x1 = bf2f(hp[2 * 3072]); } }
        else { const bf16_t* hp = Q + (size_t)(row0 + 16 * g - 3) * 3072 + col; x3 = bf2f(hp[0]); x2 = bf2f(hp[3072]); x1 = bf2f(hp[2 * 3072]); }
        const bf16_t* p = Q + (size_t)(row0 + 16 * g) * 3072 + col;
#pragma unroll 4
        for (int r = 0; r < 16; ++r) { const float xv = bf2f(p[(size_t)r * 3072]); X[(16 * g + r) * 388 + ch] = siluf_(w0 * x3 + w1 * x2 + w2 * x1 + w3 * xv); x3 = x2; x2 = x1; x1 = xv; }
    }
    if (tid < 64) { gg[tid] = ((const float*)(c.R + R_GG))[(row0 + tid) * 8 + h]; bet[tid] = ((const float*)(c.R + R_BETA))[(row0 + tid) * 8 + h]; }
    __syncthreads();
    for (int p = wv * 16; p < wv * 16 + 16; ++p) { const int which = p & 1, i = p >> 1; const f32x2_t v = *(const f32x2_t*)(X + i * 388 + which * 128 + lane * 2);
        const float rs = rsqrtf(wave_sum(v.x * v.x + v.y * v.y) + EPS); if (lane == 0) { if (which) rk[i] = rs; else rq[i] = rs; } }
    if (wv == 7) { float v = gg[lane];
#pragma unroll
        for (int o = 1; o < 64; o <<= 1) { const float t = __shfl_up(v, o); if (lane >= o) v += t; }
        const float gl = __shfl(v, 63); gam[lane] = v; eg[lane] = __expf(v); egl[lane] = __expf(gl - v);
        if (lane == 0) ((float*)(c.R + R_P2 + P2_GLAST))[ck * 8 + h] = __expf(gl); }
    __syncthreads();
    for (int q = tid; q < 64 * 64; q += 512) { const int i = q >> 6, d = (q & 63) * 2; const f32x2_t a = *(const f32x2_t*)(X + i * 388 + d), b = *(const f32x2_t*)(X + i * 388 + 128 + d);
        const float sq = rq[i] * 0.08838834764831845f, sk = rk[i];
        *(unsigned*)(QNb + i * 136 + d) = cvtpk_s(a.x * sq, a.y * sq); *(unsigned*)(KNb + i * 136 + d) = cvtpk_s(b.x * sk, b.y * sk); }
    __syncthreads();
    { const int prod = wv >> 2, ti = (wv >> 1) & 1, tj = wv & 1, r = lane & 31, hh = lane >> 5;
      const bf16_t* Ab = (prod ? QNb : KNb) + (32 * ti + r) * 136 + 8 * hh; const bf16_t* Bb = KNb + (32 * tj + r) * 136 + 8 * hh;
      f32x16 acc = {};
#pragma unroll
      for (int ks = 0; ks < 8; ++ks) acc = MFMA32(*(const bf16x8*)(Ab + 16 * ks), *(const bf16x8*)(Bb + 16 * ks), acc);
      const int jj = 32 * tj + r; const float gj = gam[jj];
#pragma unroll
      for (int rr = 0; rr < 16; ++rr) { const int i = 32 * ti + crow(rr, hh); const float dec = __expf(gam[i] - gj);
          if (prod == 0) AM[i * 68 + jj] = (jj < i) ? bet[i] * acc[rr] * dec : 0.f;
          else ((bf16_t*)((unsigned char*)(X + i * 388) + 528))[jj] = f2bf((jj <= i) ? acc[rr] * dec : 0.f); } }
    __syncthreads();
    unsigned char* Qb = (unsigned char*)Q; unsigned char* PB = c.R + R_P2 + P2_BLOBB + (size_t)(ck * 8 + h) * BLOB_B_BYTES;
    int zl = 0; asm volatile("" : "+v"(zl));
    if (wv < 4) {
        float xs[64];
        if (tid < 128) {
#pragma unroll
            for (int i = 0; i < 64; ++i) xs[i] = X[i * 388 + 256 + tid] * bet[i + zl]; }
        else {
#pragma unroll
            for (int i = 0; i < 64; ++i) xs[i] = bf2f(KNb[i * 136 + (tid - 128)]) * (bet[i + zl] * eg[i + zl]); }
#pragma unroll
        for (int i = 1; i < 64; ++i) { float a = xs[i];
#pragma unroll
            for (int j4 = 0; j4 < i; j4 += 4) { const f32x4 am = *(const f32x4*)(AM + i * 68 + j4 + zl);
                a -= am[0] * xs[j4]; if (j4 + 1 < i) a -= am[1] * xs[j4 + 1]; if (j4 + 2 < i) a -= am[2] * xs[j4 + 2]; if (j4 + 3 < i) a -= am[3] * xs[j4 + 3]; }
            xs[i] = a; }
#pragma unroll
        for (int i = 0; i < 64; ++i) ((bf16_t*)(X + i * 388))[tid] = f2bf(xs[i]);
    } else {
        const int t4 = tid - 256;
        for (int f = t4; f < 1024; f += 256) {
            const int ln = f & 63, ks = (f >> 6) & 7, it = f >> 9; const u32x4 w = frag_from_rows(QNb, 136, it, ks, ln); const float sc = eg[32 * it + (ln & 31)];
            const f32x4 lo = unpk4lo(w) * sc, hi = unpk4hi(w) * sc; *(u32x4*)vaddrA(Qb, ck, h, BLOB_QDF + f * 16) = pk8(lo, hi); }
        for (int f = t4; f < 1024; f += 256) {
            const int ln = f & 63, ks = (f >> 6) & 3, dt = f >> 8, r = ln & 31, hh = ln >> 5, d = 32 * dt + r, ib = 32 * (ks >> 1) + 16 * (ks & 1) + 4 * hh; float v[8];
#pragma unroll
            for (int j = 0; j < 8; ++j) { const int i = ib + 8 * (j >> 2) + (j & 3); v[j] = bf2f(KNb[i * 136 + d]) * egl[i]; }
            *(u32x4*)vaddrA(Qb, ck, h, BLOB_KDF + f * 16) = pk8((f32x4){v[0], v[1], v[2], v[3]}, (f32x4){v[4], v[5], v[6], v[7]}); }
        for (int f = t4; f < 512; f += 256) {
            const int ln = f & 63, ks = (f >> 6) & 3, it = f >> 8; *(u32x4*)(PB + BLOB_QKF + f * 16) = frag_from_rows((const bf16_t*)((const unsigned char*)X + 528), 776, it, ks, ln); }
    }
    __syncthreads();
    for (int f = tid; f < 1024; f += 512) { const int ln = f & 63, ks = (f >> 6) & 7, it = f >> 9; *(u32x4*)vaddrA(Qb, ck, h, BLOB_WF + f * 16) = frag_from_rows((const bf16_t*)X + 128, 776, it, ks, ln); }
    { const int ln = tid & 63, it = (tid >> 6) & 1, eb = tid >> 7, cc = ln & 31, hi = ln >> 5; unsigned wds[8];
#pragma unroll
      for (int rp = 0; rp < 8; ++rp) { const int i0 = 32 * it + crow(2 * rp, hi), i1 = 32 * it + crow(2 * rp + 1, hi);
          wds[rp] = (unsigned)((const bf16_t*)(X + i0 * 388))[32 * eb + cc] | ((unsigned)((const bf16_t*)(X + i1 * 388))[32 * eb + cc] << 16); }
      u32x4* dst = (u32x4*)(PB + BLOB_UF + ((eb * 2 + it) * 64 + ln) * 32); dst[0] = (u32x4){wds[0], wds[1], wds[2], wds[3]}; dst[1] = (u32x4){wds[4], wds[5], wds[6], wds[7]}; }
}

constexpr int SC_BUF = 57344, SC_OBUF = 2 * SC_BUF, SC_OLD = 136;
__device__ void gdn_scan_unit(const Ctx& c, int layer, int split, int su, unsigned char* smem) {
    const int tid = otid(), lane = tid & 63, wv = __builtin_amdgcn_readfirstlane(tid >> 6);
    const int bl = su >> 3, h = su & 7, ck0 = bl * (SEQ / 64);
    unsigned char* Qb = c.R + R_QKVA; const unsigned char* PB0 = c.R + R_P2 + P2_BLOBB; const float* GL = (const float*)(c.R + R_P2 + P2_GLAST);
    const bf16_t* ZS = (const bf16_t*)(c.R + R_ZS); const float* gn = c.gdn_norm + layer * 128;
    __syncthreads();
#pragma unroll
    for (int q = 0; q < 7; ++q) { const int v = (q * 512 + tid) * 16; const unsigned char* src = q < 6 ? vaddrA(Qb, ck0, h, v) : PB0 + (size_t)(ck0 * 8 + h) * BLOB_B_BYTES + BLOB_QKF + (v - BLOB_A_BYTES);
        *(u32x4*)(smem + v) = *(const u32x4*)src; }
    f32x16 S[4] = {};
    u32x4 un[4];
    if (wv < 4) { const u32x4* up = (const u32x4*)(PB0 + (size_t)(ck0 * 8 + h) * BLOB_B_BYTES + BLOB_UF + (wv * 2 * 64 + lane) * 32); un[0] = up[0]; un[1] = up[1]; un[2] = up[128]; un[3] = up[129]; }
    __syncthreads();
    constexpr int NCH = SEQ / 64;
#pragma unroll 1
    for (int n = 0; n <= NCH; ++n) {
        const int ck = ck0 + n; unsigned char* buf = smem + (n & 1) * SC_BUF; bf16_t* ob = (bf16_t*)(smem + SC_OBUF) + (n & 1) * 64 * SC_OLD;
        if (wv < 4) {
          if (n < NCH) {
            int lane = tid & 63; asm volatile("" : "+v"(lane));
            const float gl = GL[ck * 8 + h];
            bf16x8 Sb[8];
#pragma unroll
            for (int t = 0; t < 4; ++t) { Sb[2 * t] = pack_step(S[t], 0); Sb[2 * t + 1] = pack_step(S[t], 1); }
            f32x16 vn[2], o[2];
#pragma unroll
            for (int it = 0; it < 2; ++it) { f32x16 a = {};
#pragma unroll
                for (int ks = 0; ks < 8; ++ks) a = MFMA32(*(const bf16x8*)(buf + BLOB_WF + ((it * 8 + ks) * 64 + lane) * 16), Sb[ks], a);
                const u32x4 u0 = un[2 * it], u1 = un[2 * it + 1];
                const unsigned uw[8] = {u0.x, u0.y, u0.z, u0.w, u1.x, u1.y, u1.z, u1.w};
#pragma unroll
                for (int r = 0; r < 16; ++r) vn[it][r] = bf2f((r & 1) ? (uw[r >> 1] >> 16) : (uw[r >> 1] & 0xffffu)) - a[r];
                __builtin_amdgcn_sched_barrier(0); }
            if (n + 1 < NCH) { const u32x4* up = (const u32x4*)(PB0 + (size_t)((ck + 1) * 8 + h) * BLOB_B_BYTES + BLOB_UF + (wv * 2 * 64 + lane) * 32); un[0] = up[0]; un[1] = up[1]; un[2] = up[128]; un[3] = up[129]; }
#pragma unroll
            for (int it = 0; it < 2; ++it) { f32x16 b = {};
#pragma unroll
                for (int ks = 0; ks < 8; ++ks) b = MFMA32(*(const bf16x8*)(buf + BLOB_QDF + ((it * 8 + ks) * 64 + lane) * 16), Sb[ks], b);
                o[it] = b; __builtin_amdgcn_sched_barrier(0); }
            bf16x8 vb[4];
#pragma unroll
            for (int it = 0; it < 2; ++it) { vb[2 * it] = pack_step(vn[it], 0); vb[2 * it + 1] = pack_step(vn[it], 1); }
#pragma unroll
            for (int it = 0; it < 2; ++it)
#pragma unroll
                for (int ks = 0; ks < 4; ++ks) o[it] = MFMA32(*(const bf16x8*)(buf + BLOB_A_BYTES + BLOB_QKF + ((it * 4 + ks) * 64 + lane) * 16), vb[ks], o[it]);
            __builtin_amdgcn_sched_barrier(0);
#pragma unroll
            for (int t = 0; t < 4; ++t) { S[t] = S[t] * gl;
#pragma unroll
                for (int ks = 0; ks < 4; ++ks) S[t] = MFMA32(*(const bf16x8*)(buf + BLOB_KDF + ((t * 4 + ks) * 64 + lane) * 16), vb[ks], S[t]);
                __builtin_amdgcn_sched_barrier(0); }
            { const int cc = lane & 31, hi = lane >> 5;
#pragma unroll
              for (int it = 0; it < 2; ++it)
#pragma unroll
                  for (int r = 0; r < 16; ++r) ob[(32 * it + crow(r, hi)) * SC_OLD + 32 * wv + cc] = f2bf(o[it][r]); }
          }
        } else {
            int t4 = tid - 256; asm volatile("" : "+v"(t4));
            if (n + 1 < NCH) {
                const unsigned char* pa = Qb + ((size_t)((ck + 1) * 64 + (t4 >> 4)) * 3072 + h * 128) * 2 + (t4 & 15) * 16;
                const unsigned char* pb = PB0 + (size_t)((ck + 1) * 8 + h) * BLOB_B_BYTES + BLOB_QKF + t4 * 16;
                PG8_LAS unsigned char* nb = (PG8_LAS unsigned char*)smem + ((n + 1) & 1) * SC_BUF + (wv - 4) * 1024;
#pragma unroll
                for (int q = 0; q < 12; ++q) __builtin_amdgcn_global_load_lds((const unsigned*)(pa + (size_t)(q & 3) * 16 * 6144 + (q >> 2) * 2048), (PG8_LAS unsigned*)(nb + q * 4096), 16, 0, 0);
                __builtin_amdgcn_global_load_lds((const unsigned*)pb, (PG8_LAS unsigned*)(nb + 12 * 4096), 16, 0, 0);
                __builtin_amdgcn_global_load_lds((const unsigned*)(pb + 4096), (PG8_LAS unsigned*)(nb + 13 * 4096), 16, 0, 0); }
            if (n > 0) {
                const bf16_t* po = (const bf16_t*)(smem + SC_OBUF) + ((n - 1) & 1) * 64 * SC_OLD; const int i = t4 >> 2, qc = (t4 & 3) * 32;
                const size_t rowl = (size_t)(ck - 1) * 64 + i; float ss = 0.f;
#pragma unroll
                for (int q = 0; q < 4; ++q) { const u32x4 w = *(const u32x4*)(po + i * SC_OLD + qc + 8 * q); const f32x4 a = unpk4lo(w), b = unpk4hi(w);
#pragma unroll
                    for (int j = 0; j < 4; ++j) ss += a[j] * a[j] + b[j] * b[j]; }
                ss += __shfl_xor(ss, 1); ss += __shfl_xor(ss, 2); const float rs = rsqrtf(ss * (1.f / 128.f) + EPS);
#pragma unroll
                for (int q = 0; q < 4; ++q) { const u32x4 w = *(const u32x4*)(po + i * SC_OLD + qc + 8 * q); const u32x4 z = *(const u32x4*)(ZS + rowl * 1024 + h * 128 + qc + 8 * q);
                    const f32x4 ga = *(const f32x4*)(gn + qc + 8 * q), gb = *(const f32x4*)(gn + qc + 8 * q + 4);
                    const f32x4 oa = unpk4lo(w) * rs * ga * unpk4lo(z), obv = unpk4hi(w) * rs * gb * unpk4hi(z);
                    *(u32x4*)(c.OA + ((size_t)split * MS + rowl) * 1024 + h * 128 + qc + 8 * q) = pk8(oa, obv); asm volatile("" ::: "memory"); } }
            asm volatile("s_waitcnt vmcnt(0)" ::: "memory");
        }
        __syncthreads();
    }
}
__device__ void phase_gdn_prep(const Ctx& c, int layer, unsigned char* smem) { for (int u = blockIdx.x; u < (MS / 64) * 8; u += gridDim.x) gdn_prep_unit(c, layer, u, smem); }
__device__ void phase_gdn_scan(const Ctx& c, int layer, int split, unsigned char* smem) { for (int u = blockIdx.x; u < BPS * 8; u += gridDim.x) gdn_scan_unit(c, layer, split, u, smem); }

typedef const __attribute__((address_space(4))) Args* KArgsP;
__device__ __forceinline__ Ctx make_ctx() {
    KArgsP a = (KArgsP)__builtin_amdgcn_kernarg_segment_ptr(); asm volatile("" : "+s"(a));
    Ctx c;
    c.x = a->in[0]; c.norm_mix = a->in[1]; c.w_in = a->in[2]; c.conv_w = a->in[3]; c.a_log = a->in[4]; c.dt_bias = a->in[5]; c.gdn_norm = a->in[6];
    c.w_out_gdn = a->in[7]; c.w_out_dsa = a->in[8]; c.w_o = a->in[9]; c.norm_ffn = a->in[10]; c.w_gate_up = a->in[11]; c.w_down = a->in[12]; c.norm_final = a->in[13];
    c.out = a->out; c.ws = a->ws; c.R = c.ws + WS_R;
    c.cosA = (float*)(c.ws + WS_TAB); c.sinA = c.cosA + SEQ * 64; c.cosI = c.sinA + SEQ * 64; c.sinI = c.cosI + SEQ * 32;
    c.XN = (bf16_t*)(c.ws + WS_XN); c.OA = (bf16_t*)(c.ws + WS_OA); c.AT = (bf16_t*)(c.ws + WS_AT);
    return c;
}
__global__ void __launch_bounds__(512, 2) fwd_kernel(Args a) {
    extern __shared__ __attribute__((aligned(16))) unsigned char smem[];
    cg::grid_group grid = cg::this_grid();
    PG8_LAS unsigned char* lds = (PG8_LAS unsigned char*)smem;
#define SYNC() grid.sync()
    { const Ctx c = make_ctx(); phase_tables(c); }
    if (ANY_OPT_GEMM) { const Ctx c = make_ctx(); phase_convert_weights(c, 0, smem); }
    { const Ctx c = make_ctx(); phase_rmsnorm(c.x, c.norm_mix, c.XN, nullptr); }
    SYNC();
#pragma unroll 1
    for (int layer = 0; layer < DEPTH; ++layer) {
#pragma unroll 1
        for (int pc = 0; pc < 19; ++pc) {
            int st, split = 0;
            if (pc < 12) { split = pc / 6; st = pc % 6; } else st = pc - 6;
            int k0 = 0, k1 = 0;
            if (st == 0) { if (STAGE_OPT_INPROJ) { const Ctx c = make_ctx(); unsigned char* wt = c.ws + WS_WT; pg8::Gemm g{c.XN + (size_t)split * MS * DM, (const bf16_t*)(wt + WT_IN), MS, 31 * 256, DM}; pg8::StaticOrder S; S.init(MS, 31 * 256, gridDim.x, blockIdx.x);
                    EpiInProj E{c.R, c.cosA, c.sinA, c.cosI, c.sinI, c.a_log + layer * 8, c.dt_bias + layer * 8}; pg8::gemm_phase<EpiInProj, pg8::StaticOrder, true, true>(lds, g, S, E); }
                else { k0 = split * 10; k1 = k0 + 10; } }
            else if (st == 1) { const Ctx c = make_ctx(); if (STAGE_OPT_GDN) phase_gdn_prep(c, layer, smem); else naive_conv(c, layer); }
            else if (st == 2) { if (!STAGE_OPT_GDN) { const Ctx c = make_ctx(); naive_l2norm(c); } }
            else if (st == 3) { const Ctx c = make_ctx(); if (STAGE_OPT_GDN) phase_gdn_scan(c, layer, split, smem); else naive_scan(c, smem); }
            else if (st == 4) { if (!STAGE_OPT_GDN) { const Ctx c = make_ctx(); naive_gate(c, layer, split); } }
            else if (st == 5) { const Ctx c = make_ctx(); naive_dsa(c, split, smem); }
            else if (st == 6) { if (STAGE_OPT_GATES) { const Ctx c = make_ctx(); unsigned char* wt = c.ws + WS_WT; pg8::Gemm g{c.XN, (const bf16_t*)(wt + WT_IN) + (size_t)31 * 256 * DM, M, 2048, DM}; pg8::StaticOrder S; S.init(M, 2048, gridDim.x, blockIdx.x);
                    EpiGates E{(bf16_t*)(c.R + R_SG)}; pg8::gemm_phase<EpiGates, pg8::StaticOrder, true, true>(lds, g, S, E); }
                else { k0 = 20; k1 = 24; } }
            else if (st == 7) { if (STAGE_OPT_Y) { const Ctx c = make_ctx(); unsigned char* wt = c.ws + WS_WT; pg8::StaticOrder S; S.init(M, DM, gridDim.x, blockIdx.x);
                    { pg8::Gemm g{c.OA, (const bf16_t*)(wt + WT_OG), M, DM, DM}; EpiY<0> E{(const bf16_t*)(c.R + R_SG), (bf16_t*)(c.R + R_MG)}; pg8::gemm_phase<EpiY<0>, pg8::StaticOrder, false, true>(lds, g, S, E); }
                    { pg8::Gemm g{c.AT, (const bf16_t*)(wt + WT_OD), M, DM, DM}; EpiY<1> E{(const bf16_t*)(c.R + R_SG), (bf16_t*)(c.R + R_MG)}; pg8::gemm_phase<EpiY<1>, pg8::StaticOrder, false, true>(lds, g, S, E); } }
                else { k0 = 24; k1 = 28; } }
            else if (st == 8) { if (STAGE_OPT_WO) { const Ctx c = make_ctx(); unsigned char* wt = c.ws + WS_WT; pg8::Gemm g{(const bf16_t*)(c.R + R_MG), (const bf16_t*)(wt + WT_O), M, DM, DM}; pg8::StaticOrder S; S.init(M, DM, gridDim.x, blockIdx.x);
                    EpiResid E{layer == 0 ? c.x : c.out, c.out}; pg8::gemm_phase<EpiResid, pg8::StaticOrder, false, true>(lds, g, S, E); }
                else { k0 = 28; k1 = 30; } }
            else if (st == 9) { const Ctx c = make_ctx(); phase_rmsnorm(c.out, c.norm_ffn + layer * DM, c.XN, nullptr); }
            else if (st == 10) { if (STAGE_OPT_GU) { const Ctx c = make_ctx(); unsigned char* wt = c.ws + WS_WT; pg8::Gemm g{c.XN, (const bf16_t*)(wt + WT_GU), M, 2 * FF, DM}; pg8::StaticOrder S; S.init(M, 2 * FF, gridDim.x, blockIdx.x);
                    EpiSwiglu E{(bf16_t*)(c.R + R_ACT)}; pg8::gemm_phase<EpiSwiglu, pg8::StaticOrder, true, true>(lds, g, S, E); }
                else { k0 = 30; k1 = 52; } }
            else if (st == 11) { if (STAGE_OPT_DN) { const Ctx c = make_ctx(); unsigned char* wt = c.ws + WS_WT; pg8::Gemm g{(const bf16_t*)(c.R + R_ACT), (const bf16_t*)(wt + WT_DN), M, DM, FF}; pg8::StaticOrder S; S.init(M, DM, gridDim.x, blockIdx.x);
                    EpiResid E{c.out, c.out}; pg8::gemm_phase<EpiResid, pg8::StaticOrder, false, true>(lds, g, S, E); }
                else { k0 = 52; k1 = 54; } }
            else { const Ctx c = make_ctx(); if (layer + 1 < DEPTH) { phase_rmsnorm(c.out, c.norm_mix + (layer + 1) * DM, c.XN, nullptr); if (ANY_OPT_GEMM) phase_convert_weights(c, layer + 1, smem); }
                   else phase_rmsnorm(c.out, c.norm_final, nullptr, c.out); }
#pragma unroll 1
            for (int k = k0; k < k1; ++k) {
                const Ctx c = make_ctx(); const float* w_in = c.w_in + (size_t)layer * DM * INC; float* TMP = (float*)(c.R + R_TMP);
                NG g; EP e; int ng = 1;
                g.A = c.XN; g.lda = DM; g.W = w_in; g.ldw = INC; g.col0 = 0; g.ncols = 1024; g.row0 = 0; g.nrows = MS; g.K = DM; g.T = TMP; g.ldt = 1024; g.tcol0 = 0;
                e.kind = E_V; e.nrows = MS; e.rowg0 = 0; e.p0 = 0; e.layer = layer; e.dst = nullptr; e.base = nullptr;
                if (k < 20) { const int sp = k / 10, j = k % 10; g.row0 = sp * MS; e.rowg0 = sp * MS;
                    if (j < 3) { g.col0 = C_QKVA + j * 1024; e.kind = E_QKVA; e.p0 = j; }
                    else if (j == 3) { g.col0 = C_Z; e.kind = E_Z; }
                    else if (j == 4) { g.col0 = C_A; g.ncols = 16; e.kind = E_AB; }
                    else if (j == 5) { g.col0 = C_QB; e.kind = E_ROPE; e.dst = (bf16_t*)(c.R + R_QB); }
                    else if (j == 6) { g.col0 = C_KB; e.kind = E_ROPE; e.dst = (bf16_t*)(c.R + R_KB); }
                    else if (j == 7) { g.col0 = C_VB; e.kind = E_V; e.dst = (bf16_t*)(c.R + R_VB); }
                    else if (j == 8) { g.col0 = C_QI; g.ncols = 512; e.kind = E_QI; }
                    else { g.col0 = C_KI; g.ncols = 72; e.kind = E_KIWI; } }
                else if (k < 24) { const int hf = (k - 20) >> 1, gg = (k - 20) & 1; g.row0 = hf * MS; e.rowg0 = hf * MS; g.col0 = C_GA + gg * 1024; e.kind = E_SG; e.p0 = gg; }
                else if (k < 28) { const int hf = (k - 24) >> 1, wh = (k - 24) & 1; g.row0 = hf * MS; e.rowg0 = hf * MS; g.A = wh ? c.AT : c.OA;
                    g.W = (wh ? c.w_out_dsa : c.w_out_gdn) + (size_t)layer * DM * DM; g.ldw = DM; e.kind = wh ? E_YB : E_YA; }
                else if (k < 30) { const int hf = k - 28; g.row0 = hf * MS; e.rowg0 = hf * MS; g.A = (const bf16_t*)(c.R + R_MG); g.W = c.w_o + (size_t)layer * DM * DM; g.ldw = DM; e.kind = E_WO; e.base = layer == 0 ? c.x : c.out; }
                else if (k < 52) { const int hf = (k - 30) / 11, fg = (k - 30) % 11; g.row0 = hf * MS; e.rowg0 = hf * MS; g.W = c.w_gate_up + (size_t)layer * DM * 2 * FF; g.ldw = 2 * FF; g.col0 = fg * 256; g.ncols = 256;
                    ng = 2; e.kind = E_SWIGLU; e.p0 = fg; }
                else { const int hf = k - 52; g.row0 = hf * MS; e.rowg0 = hf * MS; g.A = (const bf16_t*)(c.R + R_ACT); g.lda = FF; g.K = FF; g.W = c.w_down + (size_t)layer * FF * DM; g.ldw = DM; e.kind = E_DOWN; }
#pragma unroll 1
                for (int q = 0; q < ng; ++q) { if (q == 1) { g.col0 += FF; g.tcol0 = 256; } naive_gemm(g, smem); }
                SYNC();
                epi_phase(c, e);
                if (k + 1 < k1) SYNC();
            }
            SYNC();
        }
    }
}

extern "C" void kernel_launch(void* const* d_in, const int* in_sizes, int n_in, void* d_out, int out_size, void* d_ws, size_t ws_size, hipStream_t stream) {
    static int grid = 0;
    if (grid == 0) {
        if (n_in != 14 || out_size != M * DM || ws_size < WS_END) { fprintf(stderr, "kernel_launch: unexpected problem (n_in %d out %d ws %zu need %zu)\n", n_in, out_size, ws_size, (size_t)WS_END); grid = -1; return; }
        int dev = 0, cus = 0, per_cu = 0;
        hipGetDevice(&dev); hipDeviceGetAttribute(&cus, hipDeviceAttributeMultiprocessorCount, dev);
        hipFuncSetAttribute((const void*)fwd_kernel, hipFuncAttributeMaxDynamicSharedMemorySize, LDS_BYTES);
        hipOccupancyMaxActiveBlocksPerMultiprocessor(&per_cu, (const void*)fwd_kernel, 512, LDS_BYTES);
        if (per_cu < 1) { fprintf(stderr, "kernel_launch: occupancy query says %d blocks/CU\n", per_cu); grid = -1; return; }
        grid = cus;
        (void)hipGetLastError();
    }
    if (grid < 0) return;
    hipMemsetAsync((char*)d_ws + WS_CTL, 0, 1 * MiB, stream);
    Args a{};
    for (int i = 0; i < 14; ++i) a.in[i] = (const float*)d_in[i];
    a.out = (float*)d_out; a.ws = (unsigned char*)d_ws;
    void* args[] = {&a};
    hipError_t e = hipLaunchCooperativeKernel((const void*)fwd_kernel, dim3(grid), dim3(512), args, LDS_BYTES, stream);
    if (e != hipSuccess) fprintf(stderr, "cooperative launch failed: %s (grid %d)\n", hipGetErrorString(e), grid);
}
```

```cpp
#include <hip/hip_runtime.h>
#include <hip/hip_cooperative_groups.h>
#include <cstdio>
#include <cstdint>
namespace cg = cooperative_groups;

typedef unsigned short bf16_t;
typedef float f32x4 __attribute__((ext_vector_type(4)));

constexpr int BATCH = 4, SEQ = 4096, DM = 1024, M = BATCH * SEQ, DEPTH = 2;
constexpr int GH = 8, GD = 128, CONVK = 4, CH = 64;
constexpr int AH = 8, AD = 128, IH = 8, ID = 64, TOPK = 256;
constexpr int FF = 2816, INC = 9816;
constexpr int NSPLIT = 2, MS = M / NSPLIT, BPS = BATCH / NSPLIT;
constexpr float EPS = 1e-6f;
constexpr int C_QKVA = 0, C_Z = 3072, C_A = 4096, C_B = 4104, C_QB = 4112, C_KB = 5136, C_VB = 6160, C_QI = 7184, C_KI = 7696, C_WI = 7760, C_GA = 7768, C_GB = 8792;

constexpr size_t MiB = 1u << 20;
constexpr size_t WS_CTL = 0;
constexpr size_t WS_WT = 1 * MiB;
constexpr size_t WS_TAB = 43 * MiB;
constexpr size_t WS_XN = 46 * MiB;
constexpr size_t WS_OA = 78 * MiB;
constexpr size_t WS_AT = 110 * MiB;
constexpr size_t WS_R = 142 * MiB;
constexpr size_t R_QKVA = 0, R_ZS = 48 * MiB, R_QB = 64 * MiB, R_KB = 80 * MiB, R_VB = 96 * MiB, R_QI = 112 * MiB, R_KI = 120 * MiB;
constexpr size_t R_WI = 121 * MiB, R_GG = R_WI + 256 * 1024, R_BETA = R_GG + 256 * 1024, R_HALO = 122 * MiB;
constexpr size_t R_P2 = 124 * MiB + 256 * 1024;
constexpr size_t R_TMP = R_P2;
constexpr size_t R_SG = 0, R_M1 = 64 * MiB, R_MG = R_M1;
constexpr size_t R_ACT = 0;
constexpr size_t WS_END = WS_R + R_P2 + 32 * MiB;
static_assert(WS_END <= 321650688ull, "workspace map exceeds the guaranteed d_ws size");
constexpr int LDS_BYTES = 163840;

struct Args { const float* in[14]; float* out; unsigned char* ws; };

__device__ __forceinline__ int otid() { int t = threadIdx.x; asm volatile("" : "+v"(t)); return t; }
__device__ __forceinline__ float bf2f(unsigned v) { return __uint_as_float(v << 16); }
__device__ __forceinline__ bf16_t f2bf(float f) { unsigned u = __float_as_uint(f); u += 0x7fffu + ((u >> 16) & 1u); return (bf16_t)(u >> 16); }
__device__ __forceinline__ float sigmoidf_(float x) { return 1.f / (1.f + __expf(-x)); }
__device__ __forceinline__ float siluf_(float x) { return x / (1.f + __expf(-x)); }
__device__ __forceinline__ float softplusf_(float x) { return fmaxf(x, 0.f) + log1pf(__expf(-fabsf(x))); }
__device__ __forceinline__ float wave_sum(float v) {
#pragma unroll
    for (int o = 1; o < 64; o <<= 1) v += __shfl_xor(v, o);
    return v;
}
__device__ __forceinline__ float wave_max(float v) {
#pragma unroll
    for (int o = 1; o < 64; o <<= 1) v = fmaxf(v, __shfl_xor(v, o));
    return v;
}

struct Ctx {
    const float* x; const float* norm_mix; const float* w_in; const float* conv_w; const float* a_log; const float* dt_bias; const float* gdn_norm;
    const float* w_out_gdn; const float* w_out_dsa; const float* w_o; const float* norm_ffn; const float* w_gate_up; const float* w_down; const float* norm_final;
    float* out; unsigned char* ws; unsigned char* R;
    float *cosA, *sinA, *cosI, *sinI;
    bf16_t *XN, *OA, *AT;
};

__device__ const double ROPE_INVF[64] = {1.0, 0.8659643233600653, 0.7498942093324559, 0.6493816315762113, 0.5623413251903491, 0.4869675251658631, 0.4216965034285822, 0.3651741272548377, 0.31622776601683794, 0.27384196342643613, 0.23713737056616552, 0.2053525026457146, 0.1778279410038923, 0.1539926526059492, 0.1333521432163324, 0.11547819846894582, 0.1, 0.08659643233600653, 0.07498942093324558, 0.06493816315762113, 0.05623413251903491, 0.04869675251658631, 0.042169650342858224, 0.03651741272548377, 0.03162277660168379, 0.027384196342643614, 0.023713737056616554, 0.02053525026457146, 0.01778279410038923, 0.01539926526059492, 0.01333521432163324, 0.011547819846894581, 0.01, 0.008659643233600654, 0.007498942093324558, 0.006493816315762113, 0.005623413251903491, 0.004869675251658631, 0.004216965034285823, 0.003651741272548377, 0.0031622776601683794, 0.0027384196342643613, 0.0023713737056616554, 0.002053525026457146, 0.0017782794100389228, 0.001539926526059492, 0.001333521432163324, 0.0011547819846894581, 0.001, 0.0008659643233600654, 0.0007498942093324559, 0.0006493816315762113, 0.0005623413251903491, 0.0004869675251658631, 0.00042169650342858224, 0.0003651741272548377, 0.00031622776601683794, 0.0002738419634264361, 0.00023713737056616554, 0.0002053525026457146, 0.00017782794100389227, 0.0001539926526059492, 0.0001333521432163324, 0.00011547819846894582};
__device__ __forceinline__ void rope_cs(int t, double invf, float& cs, float& sn) {
    const double ang = (double)t * invf; const double k = rint(ang * 0.15915494309189535); const float r = (float)(ang - k * 6.283185307179586);
    cs = cosf(r); sn = sinf(r);
}
__device__ __forceinline__ void phase_tables(const Ctx& c) {
    const int gt = blockIdx.x * blockDim.x + otid(), nt = gridDim.x * blockDim.x;
    for (int i = gt; i < SEQ * 64; i += nt) { const int t = i >> 6, d = i & 63; float cs, sn; rope_cs(t, ROPE_INVF[d], cs, sn); c.cosA[i] = cs; c.sinA[i] = sn; }
    for (int i = gt; i < SEQ * 32; i += nt) { const int t = i >> 5, d = i & 31; float cs, sn; rope_cs(t, ROPE_INVF[2 * d], cs, sn); c.cosI[i] = cs; c.sinI[i] = sn; }
}

__device__ __forceinline__ void phase_rmsnorm(const float* src, const float* gain, bf16_t* dst_bf, float* dst_f) {
    const int lane = otid() & 63, gw = (blockIdx.x * blockDim.x + otid()) >> 6, nw = (gridDim.x * blockDim.x) >> 6;
    for (int r = gw; r < M; r += nw) {
        const f32x4* xr = (const f32x4*)(src + (size_t)r * DM) + lane;
        f32x4 v[4]; float s = 0.f;
#pragma unroll
        for (int j = 0; j < 4; ++j) { v[j] = xr[64 * j]; s += v[j].x * v[j].x + v[j].y * v[j].y + v[j].z * v[j].z + v[j].w * v[j].w; }
        const float rs = rsqrtf(wave_sum(s) * (1.f / DM) + EPS);
#pragma unroll
        for (int j = 0; j < 4; ++j) {
            const f32x4 g = ((const f32x4*)gain)[lane + 64 * j]; const f32x4 o = v[j] * rs * g;
            if (dst_bf) { uint2 w; w.x = f2bf(o.x) | ((unsigned)f2bf(o.y) << 16); w.y = f2bf(o.z) | ((unsigned)f2bf(o.w) << 16); ((uint2*)(dst_bf + (size_t)r * DM))[lane + 64 * j] = w; }
            else ((f32x4*)(dst_f + (size_t)r * DM))[lane + 64 * j] = o;
        }
    }
}

struct NG { const bf16_t* A; int lda; const float* W; int ldw; int col0; int ncols; int row0; int nrows; int K; float* T; int ldt; int tcol0; };
__device__ __forceinline__ void naive_gemm(const NG& g, unsigned char* smem) {
    float* As = (float*)smem; float* Bs = As + 16 * 132;
    const int tid = otid(), ty = tid >> 4, tx = tid & 15;
    const int ntr = g.nrows / 128, ntc = (g.ncols + 63) / 64;
    for (int u = blockIdx.x; u < ntr * ntc; u += gridDim.x) {
        const int tr = u % ntr, tc = u / ntr, r0 = tr * 128, c0 = tc * 64;
        float acc[4][4];
#pragma unroll
        for (int i = 0; i < 4; ++i)
#pragma unroll
            for (int j = 0; j < 4; ++j) acc[i][j] = 0.f;
        for (int k0 = 0; k0 < g.K; k0 += 16) {
            { const int row = tid >> 2, kq = (tid & 3) * 4;
              const uint2 raw = *(const uint2*)(g.A + (size_t)(g.row0 + r0 + row) * g.lda + k0 + kq);
              As[(kq + 0) * 132 + row] = bf2f(raw.x & 0xffffu); As[(kq + 1) * 132 + row] = bf2f(raw.x >> 16);
              As[(kq + 2) * 132 + row] = bf2f(raw.y & 0xffffu); As[(kq + 3) * 132 + row] = bf2f(raw.y >> 16); }
            { const int k = tid >> 5, cc = (tid & 31) * 2;
              const float* wp = g.W + (size_t)(k0 + k) * g.ldw + g.col0 + c0 + cc;
              Bs[k * 68 + cc] = (c0 + cc < g.ncols) ? wp[0] : 0.f; Bs[k * 68 + cc + 1] = (c0 + cc + 1 < g.ncols) ? wp[1] : 0.f; }
            __syncthreads();
#pragma unroll
            for (int kk = 0; kk < 16; ++kk) {
                const f32x4 a = *(const f32x4*)&As[kk * 132 + ty * 4]; const f32x4 b = *(const f32x4*)&Bs[kk * 68 + tx * 4];
#pragma unroll
                for (int i = 0; i < 4; ++i)
#pragma unroll
                    for (int j = 0; j < 4; ++j) acc[i][j] += a[i] * b[j];
            }
            __syncthreads();
        }
#pragma unroll
        for (int i = 0; i < 4; ++i)
#pragma unroll
            for (int j = 0; j < 4; ++j) { const int cc = c0 + tx * 4 + j; if (cc < g.ncols) g.T[(size_t)(r0 + ty * 4 + i) * g.ldt + g.tcol0 + cc] = acc[i][j]; }
    }
}

enum { E_QKVA, E_Z, E_AB, E_ROPE, E_V, E_QI, E_KIWI, E_SG, E_YA, E_YB, E_WO, E_SWIGLU, E_DOWN };
struct EP { int kind; int nrows; int rowg0; int p0; int layer; bf16_t* dst; const float* base; };
__device__ __forceinline__ void epi_phase(const Ctx& c, const EP& e) {
    const float* T = (const float*)(c.R + R_TMP);
    const int gt = blockIdx.x * blockDim.x + otid(), nt = gridDim.x * blockDim.x;
    int W;
    switch (e.kind) { case E_QKVA: case E_Z: case E_V: case E_SG: case E_YA: case E_YB: case E_WO: case E_DOWN: W = 1024; break;
        case E_AB: W = 16; break; case E_ROPE: W = 512; break; case E_QI: W = 256; break; case E_KIWI: W = 40; break; default: W = 256; break; }
    const long total = (long)e.nrows * W;
    for (long idx = gt; idx < total; idx += nt) {
        const int r = (int)(idx / W), j = (int)(idx % W);
        const int rowg = e.rowg0 + r, rs = rowg % MS, pos = rowg % SEQ;
        const float* Tr = T + (size_t)r * 1024;
        switch (e.kind) {
        case E_QKVA: { const int col = e.p0 * 1024 + j; const bf16_t v = f2bf(Tr[j]); ((bf16_t*)(c.R + R_QKVA))[(size_t)rs * 3072 + col] = v;
                       if ((rs & 63) >= 61) ((bf16_t*)(c.R + R_HALO))[((size_t)(rs >> 6) * 3 + ((rs & 63) - 61)) * 3072 + col] = v; } break;
        case E_Z: ((bf16_t*)(c.R + R_ZS))[(size_t)rs * 1024 + j] = f2bf(siluf_(Tr[j])); break;
        case E_AB: { const int h = j & 7;
                     if (j < 8) ((float*)(c.R + R_GG))[rs * 8 + h] = -__expf(c.a_log[e.layer * 8 + h]) * softplusf_(Tr[j] + c.dt_bias[e.layer * 8 + h]);
                     else ((float*)(c.R + R_BETA))[rs * 8 + h] = sigmoidf_(Tr[j]); } break;
        case E_ROPE: { const int h = j >> 6, d = j & 63; const float x1 = Tr[h * 128 + d], x2 = Tr[h * 128 + 64 + d], cs = c.cosA[pos * 64 + d], sn = c.sinA[pos * 64 + d];
                       bf16_t* dst = e.dst + (size_t)rs * 1024 + h * 128 + d; dst[0] = f2bf(x1 * cs - x2 * sn); dst[64] = f2bf(x2 * cs + x1 * sn); } break;
        case E_V: e.dst[(size_t)rs * 1024 + j] = f2bf(Tr[j]); break;
        case E_QI: { const int h = j >> 5, d = j & 31; const float x1 = Tr[h * 64 + d], x2 = Tr[h * 64 + 32 + d], cs = c.cosI[pos * 32 + d], sn = c.sinI[pos * 32 + d];
                     bf16_t* dst = (bf16_t*)(c.R + R_QI) + (size_t)rs * 512 + h * 64 + d; dst[0] = f2bf(x1 * cs - x2 * sn); dst[32] = f2bf(x2 * cs + x1 * sn); } break;
        case E_KIWI: { if (j < 32) { const int d = j; const float x1 = Tr[d], x2 = Tr[32 + d], cs = c.cosI[pos * 32 + d], sn = c.sinI[pos * 32 + d];
                           bf16_t* dst = (bf16_t*)(c.R + R_KI) + (size_t)rs * 64 + d; dst[0] = f2bf((x1 * cs - x2 * sn) * 0.125f); dst[32] = f2bf((x2 * cs + x1 * sn) * 0.125f); }
                       else ((float*)(c.R + R_WI))[rs * 8 + (j - 32)] = Tr[64 + (j - 32)] * 0.35355339059327373f; } break;
        case E_SG: ((bf16_t*)(c.R + R_SG))[(size_t)rowg * 2048 + e.p0 * 1024 + j] = f2bf(sigmoidf_(Tr[j])); break;
        case E_YA: ((bf16_t*)(c.R + R_M1))[(size_t)rowg * 1024 + j] = f2bf(bf2f(((const bf16_t*)(c.R + R_SG))[(size_t)rowg * 2048 + j]) * Tr[j]); break;
        case E_YB: ((bf16_t*)(c.R + R_MG))[(size_t)rowg * 1024 + j] = f2bf(bf2f(((const bf16_t*)(c.R + R_M1))[(size_t)rowg * 1024 + j]) + bf2f(((const bf16_t*)(c.R + R_SG))[(size_t)rowg * 2048 + 1024 + j]) * Tr[j]); break;
        case E_WO: c.out[(size_t)rowg * 1024 + j] = e.base[(size_t)rowg * 1024 + j] + Tr[j]; break;
        case E_SWIGLU: ((bf16_t*)(c.R + R_ACT))[(size_t)rowg * FF + e.p0 * 256 + j] = f2bf(siluf_(Tr[j]) * Tr[256 + j]); break;
        case E_DOWN: c.out[(size_t)rowg * 1024 + j] += Tr[j]; break;
        }
    }
}

__device__ __forceinline__ void naive_conv(const Ctx& c, int layer) {
    bf16_t* Q = (bf16_t*)(c.R + R_QKVA); const bf16_t* H = (const bf16_t*)(c.R + R_HALO); const float* cw = c.conv_w + (size_t)layer * 4 * 3072;
    const int gt = blockIdx.x * blockDim.x + otid(), nt = gridDim.x * blockDim.x;
    for (int idx = gt; idx < (MS / 64) * 3072; idx += nt) {
        const int ch = idx % 3072, ck = idx / 3072;
        const float w0 = cw[ch], w1 = cw[3072 + ch], w2 = cw[2 * 3072 + ch], w3 = cw[3 * 3072 + ch];
        float x3 = 0.f, x2 = 0.f, x1 = 0.f;
        if ((ck * 64) % SEQ != 0) { const bf16_t* hp = H + (size_t)(ck - 1) * 3 * 3072 + ch; x3 = bf2f(hp[0]); x2 = bf2f(hp[3072]); x1 = bf2f(hp[2 * 3072]); }
        bf16_t* p = Q + (size_t)ck * 64 * 3072 + ch;
        for (int r = 0; r < 64; ++r) { const float xv = bf2f(p[(size_t)r * 3072]); const float y = w0 * x3 + w1 * x2 + w2 * x1 + w3 * xv; p[(size_t)r * 3072] = f2bf(siluf_(y)); x3 = x2; x2 = x1; x1 = xv; }
    }
}
__device__ __forceinline__ void naive_l2norm(const Ctx& c) {
    bf16_t* Q = (bf16_t*)(c.R + R_QKVA);
    const int lane = otid() & 63, gw = (blockIdx.x * blockDim.x + otid()) >> 6, nw = (gridDim.x * blockDim.x) >> 6;
    for (int t = gw; t < MS * 16; t += nw) {
        const int r = t >> 4, hh = t & 15;
        unsigned* p = (unsigned*)(Q + (size_t)r * 3072 + hh * 128) + lane; const unsigned raw = *p;
        const float a = bf2f(raw & 0xffffu), b = bf2f(raw >> 16); const float rs = rsqrtf(wave_sum(a * a + b * b) + EPS);
        *p = f2bf(a * rs) | ((unsigned)f2bf(b * rs) << 16);
    }
}
__device__ __forceinline__ void naive_scan(const Ctx& c, unsigned char* smem) {
    const bf16_t* Q = (const bf16_t*)(c.R + R_QKVA); const float* GG = (const float*)(c.R + R_GG); const float* BT = (const float*)(c.R + R_BETA); float* O = (float*)(c.R + R_TMP);
    const int lane = otid() & 63, wv = otid() >> 6, gw = blockIdx.x * 8 + wv, nw = gridDim.x * 8;
    float* kL = (float*)smem + wv * 4096; float* qL = kL + 2048;
    const int dq = lane >> 4, el = lane & 15;
    for (int task = gw; task < BPS * 8 * 8; task += nw) {
        const int eb = task & 7, h = (task >> 3) & 7, bl = task >> 6, e = eb * 16 + el;
        float S[32];
#pragma unroll
        for (int i = 0; i < 32; ++i) S[i] = 0.f;
        for (int t0 = 0; t0 < SEQ; t0 += 16) {
            for (int tk = 0; tk < 16; ++tk) { const size_t row = (size_t)bl * SEQ + t0 + tk;
                const unsigned qr = *((const unsigned*)(Q + row * 3072 + h * 128) + lane), kr = *((const unsigned*)(Q + row * 3072 + 1024 + h * 128) + lane);
                qL[tk * 128 + lane * 2] = bf2f(qr & 0xffffu); qL[tk * 128 + lane * 2 + 1] = bf2f(qr >> 16); kL[tk * 128 + lane * 2] = bf2f(kr & 0xffffu); kL[tk * 128 + lane * 2 + 1] = bf2f(kr >> 16); }
            __builtin_amdgcn_s_waitcnt(0); __builtin_amdgcn_wave_barrier();
            for (int tk = 0; tk < 16; ++tk) { const size_t row = (size_t)bl * SEQ + t0 + tk;
                const float eg = __expf(GG[row * 8 + h]), bt = BT[row * 8 + h], v = bf2f(Q[row * 3072 + 2048 + h * 128 + e]);
                const float* kp = kL + tk * 128 + dq * 32; const float* qp = qL + tk * 128 + dq * 32;
                float ks = 0.f;
#pragma unroll
                for (int i = 0; i < 32; ++i) ks += kp[i] * S[i];
                ks += __shfl_xor(ks, 16); ks += __shfl_xor(ks, 32);
                const float cc = bt * (v - eg * ks); float o = 0.f;
#pragma unroll
                for (int i = 0; i < 32; ++i) { S[i] = eg * S[i] + kp[i] * cc; o += qp[i] * S[i]; }
                o += __shfl_xor(o, 16); o += __shfl_xor(o, 32);
                if (dq == 0) O[row * 1024 + h * 128 + e] = o * 0.08838834764831845f;
            }
            __builtin_amdgcn_s_waitcnt(0); __builtin_amdgcn_wave_barrier();
        }
    }
}
__device__ __forceinline__ void naive_gate(const Ctx& c, int layer, int split) {
    const float* O = (const float*)(c.R + R_TMP); const bf16_t* Z = (const bf16_t*)(c.R + R_ZS); const float* gn = c.gdn_norm + layer * 128;
    const int lane = otid() & 63, gw = (blockIdx.x * blockDim.x + otid()) >> 6, nw = (gridDim.x * blockDim.x) >> 6;
    for (int t = gw; t < MS * 8; t += nw) {
        const int r = t >> 3, h = t & 7; const size_t off = (size_t)r * 1024 + h * 128 + lane * 2;
        const float a = O[off], b = O[off + 1]; const float rs = rsqrtf(wave_sum(a * a + b * b) * (1.f / 128.f) + EPS);
        const unsigned z = *(const unsigned*)(Z + off);
        *(unsigned*)(c.OA + (size_t)split * MS * 1024 + off) = f2bf(a * rs * gn[lane * 2] * bf2f(z & 0xffffu)) | ((unsigned)f2bf(b * rs * gn[lane * 2 + 1] * bf2f(z >> 16)) << 16);
    }
}

__device__ __forceinline__ void naive_dsa(const Ctx& c, int split, unsigned char* smem) {
    const bf16_t* QB = (const bf16_t*)(c.R + R_QB); const bf16_t* KB = (const bf16_t*)(c.R + R_KB); const bf16_t* VB = (const bf16_t*)(c.R + R_VB);
    const bf16_t* QI = (const bf16_t*)(c.R + R_QI); const bf16_t* KI = (const bf16_t*)(c.R + R_KI); const float* WI = (const float*)(c.R + R_WI);
    float* qi = (float*)smem; float* qf = qi + 512; float* sc = qf + 1024; float* scores = sc + 2048; unsigned* sel = (unsigned*)(scores + 4096); float* wi = (float*)(sel + 272); unsigned* cnt = (unsigned*)(wi + 8);
    const int tid = otid(), lane = tid & 63, wv = tid >> 6;
    for (int row = blockIdx.x; row < MS; row += gridDim.x) {
        const int t = row % SEQ, rb = row - t, n = t + 1;
        __syncthreads();
        qi[tid] = bf2f(QI[(size_t)row * 512 + tid]); qf[tid] = bf2f(QB[(size_t)row * 1024 + tid]); qf[tid + 512] = bf2f(QB[(size_t)row * 1024 + 512 + tid]);
        if (tid < 8) wi[tid] = WI[row * 8 + tid];
        if (tid == 0) { cnt[0] = 0; cnt[1] = 0; cnt[2] = 0; cnt[3] = 0; }
        __syncthreads();
        for (int s = tid; s < n; s += 512) {
            const uint4* kp = (const uint4*)(KI + (size_t)(rb + s) * 64);
            float acc = 0.f;
#pragma unroll 1
            for (int h = 0; h < 8; ++h) { float d = 0.f;
#pragma unroll 2
                for (int i = 0; i < 8; ++i) { const uint4 w = kp[i]; const float* qp = qi + h * 64 + i * 8;
                    d += qp[0] * bf2f(w.x & 0xffffu) + qp[1] * bf2f(w.x >> 16) + qp[2] * bf2f(w.y & 0xffffu) + qp[3] * bf2f(w.y >> 16)
                       + qp[4] * bf2f(w.z & 0xffffu) + qp[5] * bf2f(w.z >> 16) + qp[6] * bf2f(w.w & 0xffffu) + qp[7] * bf2f(w.w >> 16); }
                acc += wi[h] * fmaxf(d, 0.f); }
            scores[s] = acc + 0.f;
        }
        __syncthreads();
        int nsel;
        if (n <= TOPK) { for (int s = tid; s < n; s += 512) sel[s] = s; nsel = n; }
        else {
            unsigned T = 0;
            for (int bit = 31; bit >= 0; --bit) {
                const unsigned cand = T | (1u << bit); unsigned my = 0;
                for (int s = tid; s < n; s += 512) { unsigned u = __float_as_uint(scores[s]); u = (u & 0x80000000u) ? ~u : (u | 0x80000000u); my += (u >= cand) ? 1u : 0u; }
                my = (unsigned)wave_sum((float)my);
                if (lane == 0) atomicAdd(&cnt[1], my);
                __syncthreads();
                const unsigned tot = cnt[1];
                __syncthreads();
                if (tid == 0) cnt[1] = 0;
                if (tot >= (unsigned)TOPK) T = cand;
                __syncthreads();
            }
            unsigned mgt = 0, meq = 0;
            for (int s = tid; s < n; s += 512) { unsigned u = __float_as_uint(scores[s]); u = (u & 0x80000000u) ? ~u : (u | 0x80000000u); mgt += (u > T); meq += (u == T); }
            mgt = (unsigned)wave_sum((float)mgt); meq = (unsigned)wave_sum((float)meq);
            if (lane == 0) { atomicAdd(&cnt[2], mgt); atomicAdd(&cnt[3], meq); }
            __syncthreads();
            const unsigned cgt = cnt[2], ceq = cnt[3], need = TOPK - cgt;
            unsigned base = 0, eqbase = 0;
            for (int s0 = 0; s0 < n; s0 += 512) {
                const int s = s0 + tid; unsigned u = 0; if (s < n) { u = __float_as_uint(scores[s]); u = (u & 0x80000000u) ? ~u : (u | 0x80000000u); }
                const bool gt = (s < n) && (u > T), eq = (s < n) && (u == T);
                const unsigned long long bg = __ballot(gt), be = __ballot(eq), lm = (1ull << lane) - 1ull;
                if (lane == 0) { sel[256 + wv] = (unsigned)__popcll(bg); sel[264 + wv] = (unsigned)__popcll(be); }
                __syncthreads();
                unsigned pg = 0, pe = 0, tg = 0, te = 0;
                for (int w = 0; w < 8; ++w) { const unsigned a = sel[256 + w], e = sel[264 + w]; if (w < wv) { pg += a; pe += e; } tg += a; te += e; }
                const unsigned eqrank = eqbase + pe + (unsigned)__popcll(be & lm);
                const unsigned eqbefore = min(eqbase + pe + (unsigned)__popcll(be & lm), need);
                (void)eqbefore;
                const unsigned gtbefore = base + pg + (unsigned)__popcll(bg & lm);
                if (gt) sel[gtbefore + min(eqbase + pe + (unsigned)__popcll(be & lm), need)] = s;
                else if (eq && eqrank < need) sel[gtbefore + eqrank] = s;
                __syncthreads();
                base += tg; eqbase += te;
            }
            nsel = TOPK;
        }
        __syncthreads();
        for (int p = tid; p < 8 * TOPK; p += 512) { const int h = p >> 8, j = p & 255;
            if (j < nsel) { const uint4* kp = (const uint4*)(KB + (size_t)(rb + sel[j]) * 1024 + h * 128); const float* qp = qf + h * 128; float d = 0.f;
#pragma unroll 4
                for (int i = 0; i < 16; ++i) { const uint4 w = kp[i]; d += qp[i * 8] * bf2f(w.x & 0xffffu) + qp[i * 8 + 1] * bf2f(w.x >> 16) + qp[i * 8 + 2] * bf2f(w.y & 0xffffu) + qp[i * 8 + 3] * bf2f(w.y >> 16)
                        + qp[i * 8 + 4] * bf2f(w.z & 0xffffu) + qp[i * 8 + 5] * bf2f(w.z >> 16) + qp[i * 8 + 6] * bf2f(w.w & 0xffffu) + qp[i * 8 + 7] * bf2f(w.w >> 16); }
                sc[h * 256 + j] = d * 0.08838834764831845f; } }
        __syncthreads();
        { float* sp = sc + wv * 256; float mx = -3.0e38f; for (int j = lane; j < nsel; j += 64) mx = fmaxf(mx, sp[j]); mx = wave_max(mx);
          float sm = 0.f; for (int j = lane; j < nsel; j += 64) { const float pz = __expf(sp[j] - mx); sp[j] = pz; sm += pz; } sm = wave_sum(sm); const float inv = 1.f / sm;
          for (int j = lane; j < nsel; j += 64) sp[j] *= inv; }
        __syncthreads();
        { const int o = tid * 2, h = o >> 7; const float* sp = sc + h * 256; float a0 = 0.f, a1 = 0.f;
          for (int j = 0; j < nsel; ++j) { const unsigned w = *(const unsigned*)(VB + (size_t)(rb + sel[j]) * 1024 + o); const float pz = sp[j]; a0 += pz * bf2f(w & 0xffffu); a1 += pz * bf2f(w >> 16); }
          *(unsigned*)(c.AT + ((size_t)split * MS + row) * 1024 + o) = f2bf(a0) | ((unsigned)f2bf(a1) << 16); }
    }
}

namespace pg8 {
#define PG8_LAS __attribute__((address_space(3)))
typedef unsigned short bf16_t;
typedef short bf16x8 __attribute__((ext_vector_type(8)));
typedef float f32x4 __attribute__((ext_vector_type(4)));
typedef unsigned u32x4 __attribute__((ext_vector_type(4)));
constexpr int BM = 256, BK = 64, HALF = 128, HTB = HALF * BK * 2  , STAGE_BYTES = 8 * HTB, NXCD = 8, WGM = 8;

__host__ __device__ __forceinline__ int lds_byte(int r, int c) { const int st = (r >> 4) * 2 + (c >> 5), rr = r & 15, cc = c & 31, ob = rr * 64 + cc * 2; return st * 1024 + (ob ^ (((ob >> 9) & 1) << 5)); }
__host__ __device__ __forceinline__ void stage_rc(int b, int& R, int& C) { const int st = b / 1024, sb = b % 1024, swz = sb ^ (((sb >> 9) & 1) << 5); R = (st >> 1) * 16 + swz / 64; C = (st & 1) * 32 + (swz % 64) / 2; }
__host__ __device__ __forceinline__ int perm32(int rho) { const int n = rho >> 4, i = rho & 15; return 8 * (i >> 2) + 4 * n + (i & 3); }

struct Unit { int pm, pn; };
struct Gemm { const bf16_t* A; const bf16_t* Bt; int M, N, K; };

struct StaticOrder {
    int nM, nN, nwg, G, c;
    __host__ __device__ void init(int M, int N, int G_, int c_) { nM = M / BM; nN = N / BM; nwg = nM * nN; G = G_; c = c_; }
    __host__ __device__ bool next(int i, Unit& u) const {
        const long L = (long)i * G + c; if (L >= nwg) return false;
        int wgid = (int)L; { const int q = nwg / NXCD, r = nwg % NXCD, xcd = wgid % NXCD, off = wgid / NXCD; wgid = (xcd < r ? xcd * (q + 1) : r * (q + 1) + (xcd - r) * q) + off; }
        const int nig = WGM * nN, gid = wgid / nig, fm = gid * WGM, gsz = (nM - fm) < WGM ? (nM - fm) : WGM;
        u.pm = fm + ((wgid % nig) % gsz); u.pn = (wgid % nig) / gsz; return true;
    }
    __device__ __forceinline__ void a_ready(const Unit&) const {}
    __device__ __forceinline__ void done(const Unit&) const {}
};


__device__ __forceinline__ unsigned cvt_pk_bf16(float lo, float hi) { unsigned r; asm volatile("v_cvt_pk_bf16_f32 %0, %1, %2" : "=v"(r) : "v"(lo), "v"(hi)); return r; }

template <class Epi, class Sched, bool ALIGN_EPI = false, bool SP2 = false>
__device__ __forceinline__ void gemm_phase(PG8_LAS unsigned char* lds, const Gemm g, const Sched& S, const Epi& E) {
    const int tid = otid(), wid = __builtin_amdgcn_readfirstlane(tid >> 6), lane = tid & 63, wr = wid >> 2, wc = wid & 3, fr = lane & 15, fq = lane >> 4;
    const int K = g.K, nt = K / BK;
    unsigned voffA[2], voffB[2];
#pragma unroll
    for (int i = 0; i < 2; ++i) { int R, C; stage_rc(tid * 16 + i * 8192, R, C); const int Rb = Epi::PERM ? ((R & ~31) + perm32(R & 31)) : R;
        voffA[i] = (unsigned)(R * K + C) * 2u; voffB[i] = (unsigned)(Rb * K + C) * 2u; }
    const size_t kstep = (size_t)(BK * 2);
    const size_t hstep = (size_t)HALF * K * 2;
    const size_t tstep = 2 * hstep;
    const unsigned ldsw = (unsigned)wid * 1024u;
    const int aoff = lds_byte(wr * 64 + fr, fq * 8), boff = lds_byte(wc * 32 + fr, fq * 8);
#define PG8_SA(b, h) (((b) * 2 + (h)) * HTB)
#define PG8_SB(b, h) ((4 + (b) * 2 + (h)) * HTB)
#define PG8_STAGE(bufoff, gbase, voff) do { _Pragma("unroll") for (int _i = 0; _i < 2; ++_i) \
        __builtin_amdgcn_global_load_lds((const unsigned*)((const char*)(gbase) + (voff)[_i]), (PG8_LAS unsigned*)(lds + (bufoff) + ldsw + _i * 8192), 16, 0, 0); } while (0)
#define PG8_LDA(dst, b, h) do { _Pragma("unroll") for (int m = 0; m < 4; ++m) _Pragma("unroll") for (int k = 0; k < 2; ++k) dst[m][k] = *(const PG8_LAS bf16x8*)(lds + PG8_SA(b, h) + aoff + m * 2048 + k * 1024); } while (0)
#define PG8_LDB(dst, b, h) do { _Pragma("unroll") for (int n = 0; n < 2; ++n) _Pragma("unroll") for (int k = 0; k < 2; ++k) dst[n][k] = *(const PG8_LAS bf16x8*)(lds + PG8_SB(b, h) + boff + n * 2048 + k * 1024); } while (0)
#define PG8_MMA(ai, bj, At, Bt) do { __builtin_amdgcn_s_setprio(1); _Pragma("unroll") for (int m = 0; m < 4; ++m) _Pragma("unroll") for (int n = 0; n < 2; ++n) _Pragma("unroll") for (int k = 0; k < 2; ++k) \
        acc[ai][bj][m][n] = __builtin_amdgcn_mfma_f32_16x16x32_bf16(Bt[n][k], At[m][k], acc[ai][bj][m][n], 0, 0, 0); __builtin_amdgcn_s_setprio(0); } while (0)
#define PG8_WAIT_V(n) asm volatile("s_waitcnt vmcnt(" #n ")" ::: "memory")
#define PG8_WAIT_L(n) asm volatile("s_waitcnt lgkmcnt(" #n ")" ::: "memory")
#define PG8_BAR __builtin_amdgcn_s_barrier()
#define PG8_SCHED __builtin_amdgcn_sched_barrier(0)
    Unit cur, nxt; int ui = 0;
    if (!S.next(0, cur)) return;
    f32x4 acc[2][2][4][2];
#pragma unroll
    for (int a = 0; a < 2; ++a)
#pragma unroll
        for (int b = 0; b < 2; ++b)
#pragma unroll
            for (int m = 0; m < 4; ++m)
#pragma unroll
                for (int n = 0; n < 2; ++n) acc[a][b][m][n] = (f32x4){0.f, 0.f, 0.f, 0.f};
    bf16x8 At[4][2], B0[2][2], B1[2][2];
    const char* cA = (const char*)g.A + (size_t)cur.pm * tstep; const char* cB = (const char*)g.Bt + (size_t)cur.pn * tstep;
    S.a_ready(cur);
    if constexpr (SP2) {
        PG8_STAGE(PG8_SB(0, 0), cB, voffB); PG8_STAGE(PG8_SB(0, 1), cB + hstep, voffB); PG8_STAGE(PG8_SA(0, 0), cA, voffA); PG8_STAGE(PG8_SA(0, 1), cA + hstep, voffA);
        if (wr == 1) PG8_BAR;
        PG8_WAIT_V(2); PG8_BAR;
        PG8_STAGE(PG8_SB(1, 0), cB + kstep, voffB); PG8_STAGE(PG8_SA(1, 0), cA + kstep, voffA); PG8_STAGE(PG8_SB(1, 1), cB + hstep + kstep, voffB);
        PG8_WAIT_V(6); PG8_BAR;
    } else {
        PG8_STAGE(PG8_SB(0, 0), cB, voffB); PG8_STAGE(PG8_SA(0, 0), cA, voffA); PG8_STAGE(PG8_SB(0, 1), cB + hstep, voffB); PG8_STAGE(PG8_SA(0, 1), cA + hstep, voffA);
        if (wr == 1) PG8_BAR;
        PG8_WAIT_V(4); PG8_BAR;
        PG8_STAGE(PG8_SB(1, 0), cB + kstep, voffB); PG8_STAGE(PG8_SA(1, 0), cA + kstep, voffA); PG8_STAGE(PG8_SB(1, 1), cB + hstep + kstep, voffB);
        PG8_WAIT_V(6); PG8_BAR;
    }
    for (;;) {
        const bool has_next = S.next(ui + 1, nxt);
        const char* nA = has_next ? (const char*)g.A + (size_t)nxt.pm * tstep : cA; const char* nB = has_next ? (const char*)g.Bt + (size_t)nxt.pn * tstep : cB;
        for (int t = 0; t < nt; t += 2) {
            const bool last = (t == nt - 2);
            const char* a1 = cA + (size_t)(t + 1) * kstep;
            const char* a2 = last ? nA : cA + (size_t)(t + 2) * kstep; const char* b2 = last ? nB : cB + (size_t)(t + 2) * kstep;
            const char* a3 = a2 + kstep; const char* b3 = b2 + kstep;
            if (last && has_next) S.a_ready(nxt);
            if constexpr (SP2) {
            PG8_LDB(B0, 0, 0); PG8_LDB(B1, 0, 1); PG8_SCHED; PG8_LDA(At, 0, 0); PG8_STAGE(PG8_SA(1, 1), a1 + hstep, voffA);
            PG8_WAIT_V(8); PG8_WAIT_L(0); PG8_BAR; PG8_MMA(0, 0, At, B0); PG8_MMA(0, 1, At, B1); PG8_BAR; PG8_SCHED;
            PG8_LDA(At, 0, 1); PG8_STAGE(PG8_SB(0, 0), b2, voffB); PG8_STAGE(PG8_SB(0, 1), b2 + hstep, voffB); PG8_STAGE(PG8_SA(0, 0), a2, voffA);
            PG8_WAIT_V(8); PG8_WAIT_L(0); PG8_BAR; PG8_MMA(1, 0, At, B0); PG8_MMA(1, 1, At, B1); PG8_BAR; PG8_SCHED;
            PG8_LDB(B0, 1, 0); PG8_LDB(B1, 1, 1); PG8_SCHED; PG8_LDA(At, 1, 0); PG8_STAGE(PG8_SA(0, 1), a2 + hstep, voffA);
            PG8_WAIT_V(8); PG8_WAIT_L(0); PG8_BAR; PG8_MMA(0, 0, At, B0); PG8_MMA(0, 1, At, B1); PG8_BAR; PG8_SCHED;
            PG8_LDA(At, 1, 1); PG8_STAGE(PG8_SB(1, 0), b3, voffB); PG8_STAGE(PG8_SB(1, 1), b3 + hstep, voffB); PG8_STAGE(PG8_SA(1, 0), a3, voffA);
            PG8_WAIT_V(8); PG8_WAIT_L(0); PG8_BAR; PG8_MMA(1, 0, At, B0); PG8_MMA(1, 1, At, B1); PG8_BAR; PG8_SCHED;
            } else {
            PG8_LDB(B0, 0, 0); PG8_SCHED; PG8_LDA(At, 0, 0); PG8_STAGE(PG8_SA(1, 1), a1 + hstep, voffA);
            PG8_WAIT_L(8); PG8_BAR; PG8_WAIT_L(0); PG8_MMA(0, 0, At, B0); PG8_BAR; PG8_SCHED;
            PG8_LDB(B1, 0, 1); PG8_STAGE(PG8_SB(0, 0), b2, voffB);
            PG8_BAR; PG8_WAIT_L(0); PG8_MMA(0, 1, At, B1); PG8_BAR;
            PG8_LDA(At, 0, 1); PG8_STAGE(PG8_SA(0, 0), a2, voffA);
            PG8_BAR; PG8_WAIT_L(0); PG8_MMA(1, 0, At, B0); PG8_BAR; PG8_SCHED;
            PG8_STAGE(PG8_SB(0, 1), b2 + hstep, voffB);
            PG8_WAIT_V(6); PG8_BAR; PG8_MMA(1, 1, At, B1); PG8_BAR;
            PG8_LDB(B0, 1, 0); PG8_SCHED; PG8_LDA(At, 1, 0); PG8_STAGE(PG8_SA(0, 1), a2 + hstep, voffA);
            PG8_WAIT_L(8); PG8_BAR; PG8_WAIT_L(0); PG8_MMA(0, 0, At, B0); PG8_BAR; PG8_SCHED;
            PG8_LDB(B1, 1, 1); PG8_STAGE(PG8_SB(1, 0), b3, voffB);
            PG8_BAR; PG8_WAIT_L(0); PG8_MMA(0, 1, At, B1); PG8_BAR;
            PG8_LDA(At, 1, 1); PG8_STAGE(PG8_SA(1, 0), a3, voffA);
            PG8_BAR; PG8_WAIT_L(0); PG8_MMA(1, 0, At, B0); PG8_BAR; PG8_SCHED;
            PG8_STAGE(PG8_SB(1, 1), b3 + hstep, voffB);
            PG8_WAIT_V(6); PG8_BAR; PG8_MMA(1, 1, At, B1); PG8_BAR;
            }
        }
        if constexpr (ALIGN_EPI) { if (wr == 0) PG8_BAR; }
        if constexpr (!Epi::AFTER_DRAIN) { E(acc, cur, wr, wc, fr, fq); S.done(cur); }
        if (!has_next) break;
#pragma unroll
        for (int a = 0; a < 2; ++a)
#pragma unroll
            for (int b = 0; b < 2; ++b)
#pragma unroll
                for (int m = 0; m < 4; ++m)
#pragma unroll
                    for (int n = 0; n < 2; ++n) acc[a][b][m][n] = (f32x4){0.f, 0.f, 0.f, 0.f};
        cur = nxt; cA = nA; cB = nB; ++ui;
        if constexpr (ALIGN_EPI) { if (wr == 1) PG8_BAR; }
    }
    PG8_WAIT_V(0);
    if constexpr (!ALIGN_EPI) { if (wr == 0) PG8_BAR; }
    PG8_BAR;
    if constexpr (Epi::AFTER_DRAIN) { E.fused(acc, cur, wr, wc, fr, fq, lds, wid, lane); S.done(cur); }
#undef PG8_SA
#undef PG8_SB
#undef PG8_STAGE
#undef PG8_LDA
#undef PG8_LDB
#undef PG8_MMA
#undef PG8_WAIT_V
#undef PG8_WAIT_L
#undef PG8_BAR
#undef PG8_SCHED
}
}

#define STAGE_OPT_INPROJ 1
#define STAGE_OPT_GATES 1
#define STAGE_OPT_Y 1
#define STAGE_OPT_WO 1
#define STAGE_OPT_GU 1
#define STAGE_OPT_DN 1
constexpr bool ANY_OPT_GEMM = STAGE_OPT_INPROJ || STAGE_OPT_GATES || STAGE_OPT_Y || STAGE_OPT_WO || STAGE_OPT_GU || STAGE_OPT_DN;
constexpr int WIN_ROWS = 39 * 256;
constexpr size_t WT_IN = 0, WT_OG = WT_IN + (size_t)WIN_ROWS * 1024 * 2, WT_OD = WT_OG + 2 * MiB, WT_O = WT_OD + 2 * MiB, WT_GU = WT_O + 2 * MiB, WT_DN = WT_GU + (size_t)2 * FF * 1024 * 2, WT_END = WT_DN + (size_t)1024 * FF * 2;
static_assert(WT_END <= 42 * MiB, "weight region");
typedef unsigned u32x4 __attribute__((ext_vector_type(4)));
typedef unsigned u32x2 __attribute__((ext_vector_type(2)));
__device__ __forceinline__ unsigned pk2(float lo, float hi) { return pg8::cvt_pk_bf16(lo, hi); }
__device__ __forceinline__ u32x2 pk4(f32x4 v) { u32x2 w; w.x = pk2(v[0], v[1]); w.y = pk2(v[2], v[3]); return w; }
__device__ __forceinline__ u32x4 pk8(f32x4 a, f32x4 b) { u32x4 w; w.x = pk2(a[0], a[1]); w.y = pk2(a[2], a[3]); w.z = pk2(b[0], b[1]); w.w = pk2(b[2], b[3]); return w; }
__device__ __forceinline__ f32x4 unpk4lo(u32x4 w) { return (f32x4){bf2f(w.x & 0xffffu), bf2f(w.x >> 16), bf2f(w.y & 0xffffu), bf2f(w.y >> 16)}; }
__device__ __forceinline__ f32x4 unpk4hi(u32x4 w) { return (f32x4){bf2f(w.z & 0xffffu), bf2f(w.z >> 16), bf2f(w.w & 0xffffu), bf2f(w.w >> 16)}; }
__device__ __forceinline__ f32x4 sig4(f32x4 v) { return (f32x4){sigmoidf_(v[0]), sigmoidf_(v[1]), sigmoidf_(v[2]), sigmoidf_(v[3])}; }
__device__ __forceinline__ f32x4 silu4(f32x4 v) { return (f32x4){siluf_(v[0]), siluf_(v[1]), siluf_(v[2]), siluf_(v[3])}; }

__device__ __forceinline__ int rope_pos(int d, int half) { const int n = d / half, dl = d % half; return 32 * (dl >> 4) + 8 * ((dl >> 2) & 3) + 4 * n + (dl & 3); }
__device__ __forceinline__ int map_win(int n) {
    if (n < C_A) return n;
    if (n < C_B) return 30 * 256 + 72 + (n - C_A);
    if (n < C_QB) return 30 * 256 + 80 + (n - C_B);
    if (n < C_VB) { const int m = n - C_QB, hd = m >> 7, d = m & 127; return (16 + (hd >> 1)) * 256 + (hd & 1) * 128 + rope_pos(d, 64); }
    if (n < C_QI) return 24 * 256 + (n - C_VB);
    if (n < C_KI) { const int m = n - C_QI, hd = m >> 6, d = m & 63; return (28 + (hd >> 2)) * 256 + ((hd >> 1) & 1) * 128 + (hd & 1) * 64 + rope_pos(d, 32); }
    if (n < C_WI) return 30 * 256 + rope_pos(n - C_KI, 32);
    if (n < C_GA) return 30 * 256 + 64 + (n - C_WI);
    return 31 * 256 + (n - C_GA);
}
__device__ __forceinline__ int map_gu(int cidx) { const int nn = cidx >= FF ? 1 : 0, f = cidx - nn * FF; return 8 * (f >> 2) + 4 * nn + (f & 3); }
template <int MAPK> __device__ __forceinline__ void transpose_item(const float* W, int K, int N, bf16_t* WT, float* scr, int item, int lane) {
    const int nblk = (N + 31) / 32, kb = item / nblk, nb = item % nblk, k0 = 64 * kb, n0 = 32 * nb;
    const int nn = n0 + (lane & 31);
#pragma unroll 8
    for (int i = 0; i < 32; ++i) { const int kk = 2 * i + (lane >> 5); scr[kk * 33 + (lane & 31)] = nn < N ? W[(size_t)(k0 + kk) * N + nn] : 0.f; }
    asm volatile("s_waitcnt lgkmcnt(0)" ::: "memory");
    const int cch = lane & 7;
#pragma unroll
    for (int j = 0; j < 4; ++j) { const int n = (lane >> 3) + 8 * j;
        if (n0 + n < N) { const float* sp = scr + (8 * cch) * 33 + n; const int row = MAPK == 1 ? map_win(n0 + n) : (MAPK == 2 ? map_gu(n0 + n) : n0 + n);
            u32x4 o; o.x = pk2(sp[0], sp[33]); o.y = pk2(sp[2 * 33], sp[3 * 33]); o.z = pk2(sp[4 * 33], sp[5 * 33]); o.w = pk2(sp[6 * 33], sp[7 * 33]);
            *(u32x4*)(WT + (size_t)row * K + k0 + 8 * cch) = o; } }
    asm volatile("s_waitcnt lgkmcnt(0)" ::: "memory");
}
__device__ __forceinline__ void phase_convert_weights(const Ctx& c, int layer, unsigned char* smem) {
    const int lane = otid() & 63, wv = otid() >> 6, gw = blockIdx.x * 8 + wv, nw = gridDim.x * 8;
    float* scr = (float*)smem + wv * (64 * 33);
    unsigned char* wt = c.ws + WS_WT;
    constexpr int I_IN = 16 * ((INC + 31) / 32), I_SQ = 16 * 32, I_GU = 16 * (2 * FF / 32), I_DN = (FF / 64) * 32;
    for (int it = gw; it < I_IN + 3 * I_SQ + I_GU + I_DN; it += nw) {
        int r = it;
        if (r < I_IN) { transpose_item<1>(c.w_in + (size_t)layer * DM * INC, DM, INC, (bf16_t*)(wt + WT_IN), scr, r, lane); continue; } r -= I_IN;
        if (r < I_SQ) { transpose_item<0>(c.w_out_gdn + (size_t)layer * DM * DM, DM, DM, (bf16_t*)(wt + WT_OG), scr, r, lane); continue; } r -= I_SQ;
        if (r < I_SQ) { transpose_item<0>(c.w_out_dsa + (size_t)layer * DM * DM, DM, DM, (bf16_t*)(wt + WT_OD), scr, r, lane); continue; } r -= I_SQ;
        if (r < I_SQ) { transpose_item<0>(c.w_o + (size_t)layer * DM * DM, DM, DM, (bf16_t*)(wt + WT_O), scr, r, lane); continue; } r -= I_SQ;
        if (r < I_GU) { transpose_item<2>(c.w_gate_up + (size_t)layer * DM * 2 * FF, DM, 2 * FF, (bf16_t*)(wt + WT_GU), scr, r, lane); continue; } r -= I_GU;
        transpose_item<0>(c.w_down + (size_t)layer * FF * DM, FF, DM, (bf16_t*)(wt + WT_DN), scr, r, lane);
    }
}

#define EPI_ROWS(...) _Pragma("unroll") for (int ai = 0; ai < 2; ++ai) _Pragma("unroll") for (int m = 0; m < 4; ++m) { const int r = u.pm * 256 + ai * 128 + wr * 64 + m * 16 + fr; __VA_ARGS__ asm volatile("" ::: "memory"); }
struct EpiInProj {
    static constexpr bool PERM = true, AFTER_DRAIN = false;
    unsigned char* R; const float *cosA, *sinA, *cosI, *sinI, *a_log, *dt_bias;
    __device__ __forceinline__ void operator()(const f32x4 (&acc)[2][2][4][2], const pg8::Unit& u, int wr, int wc, int fr, int fq) const {
        asm volatile("" : "+v"(fr), "+v"(fq));
        const int pn = u.pn, cw = wc * 32 + 8 * fq;
        if (pn < 12) { bf16_t* Q = (bf16_t*)(R + R_QKVA); bf16_t* H = (bf16_t*)(R + R_HALO);
            EPI_ROWS(_Pragma("unroll") for (int bj = 0; bj < 2; ++bj) { const int col = pn * 256 + bj * 128 + cw; const u32x4 w = pk8(acc[ai][bj][m][0], acc[ai][bj][m][1]);
                *(u32x4*)(Q + (size_t)r * 3072 + col) = w; if (m == 3 && fr >= 13) *(u32x4*)(H + ((size_t)(r >> 6) * 3 + (fr - 13)) * 3072 + col) = w; }) }
        else if (pn < 16) { bf16_t* Z = (bf16_t*)(R + R_ZS);
            EPI_ROWS(_Pragma("unroll") for (int bj = 0; bj < 2; ++bj) { const int col = (pn - 12) * 256 + bj * 128 + cw; *(u32x4*)(Z + (size_t)r * 1024 + col) = pk8(silu4(acc[ai][bj][m][0]), silu4(acc[ai][bj][m][1])); }) }
        else if (pn < 24) { bf16_t* D = (bf16_t*)(R + ((pn - 16) >> 2 ? R_KB : R_QB)); const int dl = 16 * wc + 4 * fq;
            EPI_ROWS(const int pos = r % SEQ; const f32x4 cs = *(const f32x4*)(cosA + pos * 64 + dl), sn = *(const f32x4*)(sinA + pos * 64 + dl);
                _Pragma("unroll") for (int bj = 0; bj < 2; ++bj) { const int hd = ((pn - 16) & 3) * 2 + bj; const f32x4 x1 = acc[ai][bj][m][0], x2 = acc[ai][bj][m][1];
                    bf16_t* dp = D + (size_t)r * 1024 + hd * 128 + dl; *(u32x2*)dp = pk4(x1 * cs - x2 * sn); *(u32x2*)(dp + 64) = pk4(x2 * cs + x1 * sn); }) }
        else if (pn < 28) { bf16_t* V = (bf16_t*)(R + R_VB);
            EPI_ROWS(_Pragma("unroll") for (int bj = 0; bj < 2; ++bj) { const int col = (pn - 24) * 256 + bj * 128 + cw; *(u32x4*)(V + (size_t)r * 1024 + col) = pk8(acc[ai][bj][m][0], acc[ai][bj][m][1]); }) }
        else if (pn < 30) { bf16_t* QI = (bf16_t*)(R + R_QI); const int dl = 16 * (wc & 1) + 4 * fq;
            EPI_ROWS(const int pos = r % SEQ; const f32x4 cs = *(const f32x4*)(cosI + pos * 32 + dl), sn = *(const f32x4*)(sinI + pos * 32 + dl);
                _Pragma("unroll") for (int bj = 0; bj < 2; ++bj) { const int hd = (pn - 28) * 4 + bj * 2 + (wc >> 1); const f32x4 x1 = acc[ai][bj][m][0], x2 = acc[ai][bj][m][1];
                    bf16_t* dp = QI + (size_t)r * 512 + hd * 64 + dl; *(u32x2*)dp = pk4(x1 * cs - x2 * sn); *(u32x2*)(dp + 32) = pk4(x2 * cs + x1 * sn); }) }
        else {
            if (wc < 2) { bf16_t* KI = (bf16_t*)(R + R_KI); const int dl = 16 * wc + 4 * fq;
                EPI_ROWS(const int pos = r % SEQ; const f32x4 cs = *(const f32x4*)(cosI + pos * 32 + dl), sn = *(const f32x4*)(sinI + pos * 32 + dl);
                    const f32x4 x1 = acc[ai][0][m][0], x2 = acc[ai][0][m][1]; bf16_t* dp = KI + (size_t)r * 64 + dl;
                    *(u32x2*)dp = pk4((x1 * cs - x2 * sn) * 0.125f); *(u32x2*)(dp + 32) = pk4((x2 * cs + x1 * sn) * 0.125f);) }
            else if (wc == 2) {
                if (fq == 0) { float* WI = (float*)(R + R_WI); EPI_ROWS(*(f32x4*)(WI + r * 8) = acc[ai][0][m][0] * 0.35355339059327373f; *(f32x4*)(WI + r * 8 + 4) = acc[ai][0][m][1] * 0.35355339059327373f;) }
                else if (fq == 1) { float* GG = (float*)(R + R_GG);
                    EPI_ROWS(_Pragma("unroll") for (int n = 0; n < 2; ++n) { f32x4 o; _Pragma("unroll") for (int j = 0; j < 4; ++j) o[j] = -__expf(a_log[n * 4 + j]) * softplusf_(acc[ai][0][m][n][j] + dt_bias[n * 4 + j]); *(f32x4*)(GG + r * 8 + n * 4) = o; }) }
                else if (fq == 2) { float* BT = (float*)(R + R_BETA); EPI_ROWS(*(f32x4*)(BT + r * 8) = sig4(acc[ai][0][m][0]); *(f32x4*)(BT + r * 8 + 4) = sig4(acc[ai][0][m][1]);) }
            }
        }
    }
};
struct EpiGates {
    static constexpr bool PERM = true, AFTER_DRAIN = false; bf16_t* SG;
    __device__ __forceinline__ void operator()(const f32x4 (&acc)[2][2][4][2], const pg8::Unit& u, int wr, int wc, int fr, int fq) const {
        EPI_ROWS(_Pragma("unroll") for (int bj = 0; bj < 2; ++bj) { const int col = u.pn * 256 + bj * 128 + wc * 32 + 8 * fq; *(u32x4*)(SG + (size_t)r * 2048 + col) = pk8(sig4(acc[ai][bj][m][0]), sig4(acc[ai][bj][m][1])); })
    }
};
template <int WHICH> struct EpiY {
    static constexpr bool PERM = true, AFTER_DRAIN = false; const bf16_t* SG; bf16_t* MG;
    __device__ __forceinline__ void operator()(const f32x4 (&acc)[2][2][4][2], const pg8::Unit& u, int wr, int wc, int fr, int fq) const {
        EPI_ROWS(_Pragma("unroll") for (int bj = 0; bj < 2; ++bj) { const int col = u.pn * 256 + bj * 128 + wc * 32 + 8 * fq;
            const u32x4 g = *(const u32x4*)(SG + (size_t)r * 2048 + WHICH * 1024 + col); f32x4 lo = unpk4lo(g) * acc[ai][bj][m][0], hi = unpk4hi(g) * acc[ai][bj][m][1];
            if (WHICH == 1) { const u32x4 p = *(const u32x4*)(MG + (size_t)r * 1024 + col); lo += unpk4lo(p); hi += unpk4hi(p); }
            *(u32x4*)(MG + (size_t)r * 1024 + col) = pk8(lo, hi); })
    }
};
struct EpiResid {
    static constexpr bool PERM = true, AFTER_DRAIN = false; const float* base; float* out;
    __device__ __forceinline__ void operator()(const f32x4 (&acc)[2][2][4][2], const pg8::Unit& u, int wr, int wc, int fr, int fq) const {
        EPI_ROWS(_Pragma("unroll") for (int bj = 0; bj < 2; ++bj) { const size_t off = (size_t)r * 1024 + u.pn * 256 + bj * 128 + wc * 32 + 8 * fq;
            const f32x4 b0 = *(const f32x4*)(base + off), b1 = *(const f32x4*)(base + off + 4); *(f32x4*)(out + off) = b0 + acc[ai][bj][m][0]; *(f32x4*)(out + off + 4) = b1 + acc[ai][bj][m][1]; })
    }
};
struct EpiSwiglu {
    static constexpr bool PERM = true, AFTER_DRAIN = false; bf16_t* ACT;
    __device__ __forceinline__ void operator()(const f32x4 (&acc)[2][2][4][2], const pg8::Unit& u, int wr, int wc, int fr, int fq) const {
        EPI_ROWS(_Pragma("unroll") for (int bj = 0; bj < 2; ++bj) { const int f0 = u.pn * 128 + bj * 64 + wc * 16 + 4 * fq; *(u32x2*)(ACT + (size_t)r * FF + f0) = pk4(silu4(acc[ai][bj][m][0]) * acc[ai][bj][m][1]); })
    }
};

#define STAGE_OPT_GDN 1
typedef short bf16x8 __attribute__((ext_vector_type(8)));
typedef float f32x16 __attribute__((ext_vector_type(16)));
typedef float f32x2_t __attribute__((ext_vector_type(2)));
typedef __bf16 bf16x2_t __attribute__((ext_vector_type(2)));
__device__ __forceinline__ unsigned cvtpk_s(float lo, float hi) { f32x2_t v = {lo, hi}; bf16x2_t b = __builtin_convertvector(v, bf16x2_t); return __builtin_bit_cast(unsigned, b); }
__device__ __forceinline__ int crow(int r, int hi) { return (r & 3) + 8 * (r >> 2) + 4 * hi; }
#define MFMA32(a, b, c) __builtin_amdgcn_mfma_f32_32x32x16_bf16((a), (b), (c), 0, 0, 0)
__device__ __forceinline__ bf16x8 pack_step(const f32x16& x, int s) {
    u32x4 p; p.x = cvtpk_s(x[8 * s], x[8 * s + 1]); p.y = cvtpk_s(x[8 * s + 2], x[8 * s + 3]); p.z = cvtpk_s(x[8 * s + 4], x[8 * s + 5]); p.w = cvtpk_s(x[8 * s + 6], x[8 * s + 7]);
    return __builtin_bit_cast(bf16x8, p);
}
constexpr int BLOB_WF = 0, BLOB_QDF = 16384, BLOB_KDF = 32768, BLOB_A_BYTES = 49152, BLOB_QKF = 0, BLOB_UF = 8192, BLOB_B_BYTES = 24576;
constexpr size_t P2_BLOBB = 0, P2_GLAST = 24 * MiB, P2_MASK = 25 * MiB;
__device__ __forceinline__ unsigned char* vaddrA(unsigned char* qkva, int ck, int h, int v) { const int i = (v >> 8) & 63, part = v >> 14; return qkva + ((size_t)(ck * 64 + i) * 3072 + part * 1024 + h * 128) * 2 + (v & 255); }
__device__ __forceinline__ u32x4 frag_from_rows(const bf16_t* T, int ld, int it, int ks, int lane) {
    const int r = lane & 31, hh = lane >> 5; const bf16_t* p = T + (size_t)(32 * it + r) * ld + 32 * (ks >> 1) + 16 * (ks & 1) + 4 * hh;
    const u32x2 a = *(const u32x2*)p, b = *(const u32x2*)(p + 8); return (u32x4){a.x, a.y, b.x, b.y};
}

__device__ __forceinline__ void gdn_prep_unit(const Ctx& c, int layer, int unit, unsigned char* smem) {
    const int tid = otid(), lane = tid & 63, wv = tid >> 6;
    const int h = unit & 7, ck = unit >> 3;
    bf16_t* Q = (bf16_t*)(c.R + R_QKVA); const bf16_t* HL = (const bf16_t*)(c.R + R_HALO);
    const float* cw = c.conv_w + (size_t)layer * 4 * 3072;
    float* X = (float*)smem;
    float* rq = X + 64 * 388; float* rk = rq + 64; float* gam = rk + 64; float* eg = gam + 64; float* egl = eg + 64; float* bet = egl + 64; float* gg = bet + 64;
    bf16_t* KNb = (bf16_t*)(gg + 64); bf16_t* QNb = KNb + 64 * 136;
    float* AM = (float*)(QNb + 64 * 136);
    const int row0 = ck * 64;
    __syncthreads();
    for (int q = tid; q < 4 * 384; q += 512) {
        const int g = q / 384, ch = q - g * 384, part = ch >> 7, col = part * 1024 + h * 128 + (ch & 127);
        const float w0 = cw[col], w1 = cw[3072 + col], w2 = cw[2 * 3072 + col], w3 = cw[3 * 3072 + col];
        float x3, x2, x1;
        if (g == 0) { if ((row0 % SEQ) == 0) { x3 = 0.f; x2 = 0.f; x1 = 0.f; } else { const bf16_t* hp = HL + (size_t)(ck - 1) * 3 * 3072 + col; x3 = bf2f(hp[0]); x2 = bf2f(hp[3072]); x1 = bf2f(hp[2 * 3072]); } }
        else { const bf16_t* hp = Q + (size_t)(row0 + 16 * g - 3) * 3072 + col; x3 = bf2f(hp[0]); x2 = bf2f(hp[3072]); x1 = bf2f(hp[2 * 3072]); }
        const bf16_t* p = Q + (size_t)(row0 + 16 * g) * 3072 + col;
#pragma unroll 4
        for (int r = 0; r < 16; ++r) { const float xv = bf2f(p[(size_t)r * 3072]); X[(16 * g + r) * 388 + ch] = siluf_(w0 * x3 + w1 * x2 + w2 * x1 + w3 * xv); x3 = x2; x2 = x1; x1 = xv; }
    }
    if (tid < 64) { gg[tid] = ((const float*)(c.R + R_GG))[(row0 + tid) * 8 + h]; bet[tid] = ((const float*)(c.R + R_BETA))[(row0 + tid) * 8 + h]; }
    __syncthreads();
    for (int p = wv * 16; p < wv * 16 + 16; ++p) { const int which = p & 1, i = p >> 1; const f32x2_t v = *(const f32x2_t*)(X + i * 388 + which * 128 + lane * 2);
        const float rs = rsqrtf(wave_sum(v.x * v.x + v.y * v.y) + EPS); if (lane == 0) { if (which) rk[i] = rs; else rq[i] = rs; } }
    if (wv == 7) { float v = gg[lane];
#pragma unroll
        for (int o = 1; o < 64; o <<= 1) { const float t = __shfl_up(v, o); if (lane >= o) v += t; }
        const float gl = __shfl(v, 63); gam[lane] = v; eg[lane] = __expf(v); egl[lane] = __expf(gl - v);
        if (lane == 0) ((float*)(c.R + R_P2 + P2_GLAST))[ck * 8 + h] = __expf(gl); }
    __syncthreads();
    for (int q = tid; q < 64 * 64; q += 512) { const int i = q >> 6, d = (q & 63) * 2; const f32x2_t a = *(const f32x2_t*)(X + i * 388 + d), b = *(const f32x2_t*)(X + i * 388 + 128 + d);
        const float sq = rq[i] * 0.08838834764831845f, sk = rk[i];
        *(unsigned*)(QNb + i * 136 + d) = cvtpk_s(a.x * sq, a.y * sq); *(unsigned*)(KNb + i * 136 + d) = cvtpk_s(b.x * sk, b.y * sk); }
    __syncthreads();
    { const int prod = wv >> 2, ti = (wv >> 1) & 1, tj = wv & 1, r = lane & 31, hh = lane >> 5;
      const bf16_t* Ab = (prod ? QNb : KNb) + (32 * ti + r) * 136 + 8 * hh; const bf16_t* Bb = KNb + (32 * tj + r) * 136 + 8 * hh;
      f32x16 acc = {};
#pragma unroll
      for (int ks = 0; ks < 8; ++ks) acc = MFMA32(*(const bf16x8*)(Ab + 16 * ks), *(const bf16x8*)(Bb + 16 * ks), acc);
      const int jj = 32 * tj + r; const float gj = gam[jj];
#pragma unroll
      for (int rr = 0; rr < 16; ++rr) { const int i = 32 * ti + crow(rr, hh); const float dec = __expf(gam[i] - gj);
          if (prod == 0) AM[i * 68 + jj] = (jj < i) ? bet[i] * acc[rr] * dec : 0.f;
          else ((bf16_t*)((unsigned char*)(X + i * 388) + 528))[jj] = f2bf((jj <= i) ? acc[rr] * dec : 0.f); } }
    __syncthreads();
    unsigned char* Qb = (unsigned char*)Q; unsigned char* PB = c.R + R_P2 + P2_BLOBB + (size_t)(ck * 8 + h) * BLOB_B_BYTES;
    int zl = 0; asm volatile("" : "+v"(zl));
    if (wv < 4) {
        float xs[64];
        if (tid < 128) {
#pragma unroll
            for (int i = 0; i < 64; ++i) xs[i] = X[i * 388 + 256 + tid] * bet[i + zl]; }
        else {
#pragma unroll
            for (int i = 0; i < 64; ++i) xs[i] = bf2f(KNb[i * 136 + (tid - 128)]) * (bet[i + zl] * eg[i + zl]); }
#pragma unroll
        for (int i = 1; i < 64; ++i) { float a = xs[i];
#pragma unroll
            for (int j4 = 0; j4 < i; j4 += 4) { const f32x4 am = *(const f32x4*)(AM + i * 68 + j4 + zl);
                a -= am[0] * xs[j4]; if (j4 + 1 < i) a -= am[1] * xs[j4 + 1]; if (j4 + 2 < i) a -= am[2] * xs[j4 + 2]; if (j4 + 3 < i) a -= am[3] * xs[j4 + 3]; }
            xs[i] = a; }
#pragma unroll
        for (int i = 0; i < 64; ++i) ((bf16_t*)(X + i * 388))[tid] = f2bf(xs[i]);
    } else {
        const int t4 = tid - 256;
        for (int f = t4; f < 1024; f += 256) {
            const int ln = f & 63, ks = (f >> 6) & 7, it = f >> 9; const u32x4 w = frag_from_rows(QNb, 136, it, ks, ln); const float sc = eg[32 * it + (ln & 31)];
            const f32x4 lo = unpk4lo(w) * sc, hi = unpk4hi(w) * sc; *(u32x4*)vaddrA(Qb, ck, h, BLOB_QDF + f * 16) = pk8(lo, hi); }
        for (int f = t4; f < 1024; f += 256) {
            const int ln = f & 63, ks = (f >> 6) & 3, dt = f >> 8, r = ln & 31, hh = ln >> 5, d = 32 * dt + r, ib = 32 * (ks >> 1) + 16 * (ks & 1) + 4 * hh; float v[8];
#pragma unroll
            for (int j = 0; j < 8; ++j) { const int i = ib + 8 * (j >> 2) + (j & 3); v[j] = bf2f(KNb[i * 136 + d]) * egl[i]; }
            *(u32x4*)vaddrA(Qb, ck, h, BLOB_KDF + f * 16) = pk8((f32x4){v[0], v[1], v[2], v[3]}, (f32x4){v[4], v[5], v[6], v[7]}); }
        for (int f = t4; f < 512; f += 256) {
            const int ln = f & 63, ks = (f >> 6) & 3, it = f >> 8; *(u32x4*)(PB + BLOB_QKF + f * 16) = frag_from_rows((const bf16_t*)((const unsigned char*)X + 528), 776, it, ks, ln); }
    }
    __syncthreads();
    for (int f = tid; f < 1024; f += 512) { const int ln = f & 63, ks = (f >> 6) & 7, it = f >> 9; *(u32x4*)vaddrA(Qb, ck, h, BLOB_WF + f * 16) = frag_from_rows((const bf16_t*)X + 128, 776, it, ks, ln); }
    { const int ln = tid & 63, it = (tid >> 6) & 1, eb = tid >> 7, cc = ln & 31, hi = ln >> 5; unsigned wds[8];
#pragma unroll
      for (int rp = 0; rp < 8; ++rp) { const int i0 = 32 * it + crow(2 * rp, hi), i1 = 32 * it + crow(2 * rp + 1, hi);
          wds[rp] = (unsigned)((const bf16_t*)(X + i0 * 388))[32 * eb + cc] | ((unsigned)((const bf16_t*)(X + i1 * 388))[32 * eb + cc] << 16); }
      u32x4* dst = (u32x4*)(PB + BLOB_UF + ((eb * 2 + it) * 64 + ln) * 32); dst[0] = (u32x4){wds[0], wds[1], wds[2], wds[3]}; dst[1] = (u32x4){wds[4], wds[5], wds[6], wds[7]}; }
}

constexpr int SC_BUF = 57344, SC_OBUF = 2 * SC_BUF, SC_OLD = 136;
__device__ __forceinline__ void gdn_scan_unit(const Ctx& c, int layer, int split, int su, unsigned char* smem) {
    const int tid = otid(), lane = tid & 63, wv = __builtin_amdgcn_readfirstlane(tid >> 6);
    const int bl = su >> 3, h = su & 7, ck0 = bl * (SEQ / 64);
    unsigned char* Qb = c.R + R_QKVA; const unsigned char* PB0 = c.R + R_P2 + P2_BLOBB; const float* GL = (const float*)(c.R + R_P2 + P2_GLAST);
    const bf16_t* ZS = (const bf16_t*)(c.R + R_ZS); const float* gn = c.gdn_norm + layer * 128;
    __syncthreads();
#pragma unroll
    for (int q = 0; q < 7; ++q) { const int v = (q * 512 + tid) * 16; const unsigned char* src = q < 6 ? vaddrA(Qb, ck0, h, v) : PB0 + (size_t)(ck0 * 8 + h) * BLOB_B_BYTES + BLOB_QKF + (v - BLOB_A_BYTES);
        *(u32x4*)(smem + v) = *(const u32x4*)src; }
    f32x16 S[4] = {};
    u32x4 un[4];
    if (wv < 4) { const u32x4* up = (const u32x4*)(PB0 + (size_t)(ck0 * 8 + h) * BLOB_B_BYTES + BLOB_UF + (wv * 2 * 64 + lane) * 32); un[0] = up[0]; un[1] = up[1]; un[2] = up[128]; un[3] = up[129]; }
    __syncthreads();
    constexpr int NCH = SEQ / 64;
#pragma unroll 1
    for (int n = 0; n <= NCH; ++n) {
        const int ck = ck0 + n; unsigned char* buf = smem + (n & 1) * SC_BUF; bf16_t* ob = (bf16_t*)(smem + SC_OBUF) + (n & 1) * 64 * SC_OLD;
        if (wv < 4) {
          if (n < NCH) {
            int lane = tid & 63; asm volatile("" : "+v"(lane));
            const float gl = GL[ck * 8 + h];
            bf16x8 Sb[8];
#pragma unroll
            for (int t = 0; t < 4; ++t) { Sb[2 * t] = pack_step(S[t], 0); Sb[2 * t + 1] = pack_step(S[t], 1); }
            f32x16 vn[2], o[2];
#pragma unroll
            for (int it = 0; it < 2; ++it) { f32x16 a = {};
#pragma unroll
                for (int ks = 0; ks < 8; ++ks) a = MFMA32(*(const bf16x8*)(buf + BLOB_WF + ((it * 8 + ks) * 64 + lane) * 16), Sb[ks], a);
                const u32x4 u0 = un[2 * it], u1 = un[2 * it + 1];
                const unsigned uw[8] = {u0.x, u0.y, u0.z, u0.w, u1.x, u1.y, u1.z, u1.w};
#pragma unroll
                for (int r = 0; r < 16; ++r) vn[it][r] = bf2f((r & 1) ? (uw[r >> 1] >> 16) : (uw[r >> 1] & 0xffffu)) - a[r];
                __builtin_amdgcn_sched_barrier(0); }
            if (n + 1 < NCH) { const u32x4* up = (const u32x4*)(PB0 + (size_t)((ck + 1) * 8 + h) * BLOB_B_BYTES + BLOB_UF + (wv * 2 * 64 + lane) * 32); un[0] = up[0]; un[1] = up[1]; un[2] = up[128]; un[3] = up[129]; }
#pragma unroll
            for (int it = 0; it < 2; ++it) { f32x16 b = {};
#pragma unroll
                for (int ks = 0; ks < 8; ++ks) b = MFMA32(*(const bf16x8*)(buf + BLOB_QDF + ((it * 8 + ks) * 64 + lane) * 16), Sb[ks], b);
                o[it] = b; __builtin_amdgcn_sched_barrier(0); }
            bf16x8 vb[4];
#pragma unroll
            for (int it = 0; it < 2; ++it) { vb[2 * it] = pack_step(vn[it], 0); vb[2 * it + 1] = pack_step(vn[it], 1); }
#pragma unroll
            for (int it = 0; it < 2; ++it)
#pragma unroll
                for (int ks = 0; ks < 4; ++ks) o[it] = MFMA32(*(const bf16x8*)(buf + BLOB_A_BYTES + BLOB_QKF + ((it * 4 + ks) * 64 + lane) * 16), vb[ks], o[it]);
            __builtin_amdgcn_sched_barrier(0);
#pragma unroll
            for (int t = 0; t < 4; ++t) { S[t] = S[t] * gl;
#pragma unroll
                for (int ks = 0; ks < 4; ++ks) S[t] = MFMA32(*(const bf16x8*)(buf + BLOB_KDF + ((t * 4 + ks) * 64 + lane) * 16), vb[ks], S[t]);
                __builtin_amdgcn_sched_barrier(0); }
            { const int cc = lane & 31, hi = lane >> 5;
#pragma unroll
              for (int it = 0; it < 2; ++it)
#pragma unroll
                  for (int r = 0; r < 16; ++r) ob[(32 * it + crow(r, hi)) * SC_OLD + 32 * wv + cc] = f2bf(o[it][r]); }
          }
        } else {
            int t4 = tid - 256; asm volatile("" : "+v"(t4));
            if (n + 1 < NCH) {
                const unsigned char* pa = Qb + ((size_t)((ck + 1) * 64 + (t4 >> 4)) * 3072 + h * 128) * 2 + (t4 & 15) * 16;
                const unsigned char* pb = PB0 + (size_t)((ck + 1) * 8 + h) * BLOB_B_BYTES + BLOB_QKF + t4 * 16;
                PG8_LAS unsigned char* nb = (PG8_LAS unsigned char*)smem + ((n + 1) & 1) * SC_BUF + (wv - 4) * 1024;
#pragma unroll
                for (int q = 0; q < 12; ++q) __builtin_amdgcn_global_load_lds((const unsigned*)(pa + (size_t)(q & 3) * 16 * 6144 + (q >> 2) * 2048), (PG8_LAS unsigned*)(nb + q * 4096), 16, 0, 0);
                __builtin_amdgcn_global_load_lds((const unsigned*)pb, (PG8_LAS unsigned*)(nb + 12 * 4096), 16, 0, 0);
                __builtin_amdgcn_global_load_lds((const unsigned*)(pb + 4096), (PG8_LAS unsigned*)(nb + 13 * 4096), 16, 0, 0); }
            if (n > 0) {
                const bf16_t* po = (const bf16_t*)(smem + SC_OBUF) + ((n - 1) & 1) * 64 * SC_OLD; const int i = t4 >> 2, qc = (t4 & 3) * 32;
                const size_t rowl = (size_t)(ck - 1) * 64 + i; float ss = 0.f;
#pragma unroll
                for (int q = 0; q < 4; ++q) { const u32x4 w = *(const u32x4*)(po + i * SC_OLD + qc + 8 * q); const f32x4 a = unpk4lo(w), b = unpk4hi(w);
#pragma unroll
                    for (int j = 0; j < 4; ++j) ss += a[j] * a[j] + b[j] * b[j]; }
                ss += __shfl_xor(ss, 1); ss += __shfl_xor(ss, 2); const float rs = rsqrtf(ss * (1.f / 128.f) + EPS);
#pragma unroll
                for (int q = 0; q < 4; ++q) { const u32x4 w = *(const u32x4*)(po + i * SC_OLD + qc + 8 * q); const u32x4 z = *(const u32x4*)(ZS + rowl * 1024 + h * 128 + qc + 8 * q);
                    const f32x4 ga = *(const f32x4*)(gn + qc + 8 * q), gb = *(const f32x4*)(gn + qc + 8 * q + 4);
                    const f32x4 oa = unpk4lo(w) * rs * ga * unpk4lo(z), obv = unpk4hi(w) * rs * gb * unpk4hi(z);
                    *(u32x4*)(c.OA + ((size_t)split * MS + rowl) * 1024 + h * 128 + qc + 8 * q) = pk8(oa, obv); asm volatile("" ::: "memory"); } }
            asm volatile("s_waitcnt vmcnt(0)" ::: "memory");
        }
        __syncthreads();
    }
}
__device__ __forceinline__ void phase_gdn_prep(const Ctx& c, int layer, unsigned char* smem) { for (int u = blockIdx.x; u < (MS / 64) * 8; u += gridDim.x) gdn_prep_unit(c, layer, u, smem); }
__device__ __forceinline__ void phase_gdn_scan(const Ctx& c, int layer, int split, unsigned char* smem) { for (int u = blockIdx.x; u < BPS * 8; u += gridDim.x) gdn_scan_unit(c, layer, split, u, smem); }

#define STAGE_OPT_DSA 1
__device__ __forceinline__ unsigned fkey(float x) { const unsigned u = __float_as_uint(x); return (u & 0x80000000u) ? ~u : (u | 0x80000000u); }
__device__ __forceinline__ float fkey_inv(unsigned k) { return __uint_as_float((k & 0x80000000u) ? (k & 0x7fffffffu) : ~k); }
constexpr int SL_QIF = 0, SL_WIL = 16384, SL_ST = 16896, SL_HIST = 18432, SL_MWG = 34816, SL_MWE = 43008, SL_CAND = 51200;
__device__ __forceinline__ void dsa_select_unit(const Ctx& c, int unit, unsigned char* smem) {
    const int tid = otid(), lane = tid & 63, wv = __builtin_amdgcn_readfirstlane(tid >> 6), cc = lane & 31, hi = lane >> 5;
    const int bl = unit & (BPS - 1), qg = (SEQ / 16 - 1) - unit / BPS, t0 = 16 * qg, rb = bl * SEQ, row0 = rb + t0, nkt = (t0 + 47) >> 5;
    const bf16_t* QI = (const bf16_t*)(c.R + R_QI); const bf16_t* KI = (const bf16_t*)(c.R + R_KI); const float* WI = (const float*)(c.R + R_WI);
    float* WIL = (float*)(smem + SL_WIL); unsigned* ST = (unsigned*)(smem + SL_ST); float* STf = (float*)ST; unsigned* HIST = (unsigned*)(smem + SL_HIST);
    unsigned* MWG = (unsigned*)(smem + SL_MWG); unsigned* MWE = (unsigned*)(smem + SL_MWE); float* CAND = (float*)(smem + SL_CAND);
    const float NINF = -__builtin_inff();
    __syncthreads();
    for (int p = tid; p < 1024; p += 512) { const int f = p >> 6, ln = p & 63, rt = f >> 2, s = f & 3, r = ln & 31, hh = ln >> 5;
        *(u32x4*)(smem + SL_QIF + p * 16) = *(const u32x4*)(QI + (size_t)(row0 + 4 * rt + (r >> 3)) * 512 + (r & 7) * 64 + 16 * s + 8 * hh); }
    if (tid < 128) WIL[tid] = WI[(row0 + (tid >> 3)) * 8 + (tid & 7)];
    for (int p = tid; p < 4096; p += 512) MWG[p] = 0u;
    if (tid < 192) ST[tid] = (tid < 16) ? 0xffffffffu : 0u;
    __syncthreads();
    float sc[16][4][2];
#pragma unroll
    for (int ktl = 0; ktl < 16; ++ktl) {
        const int kt = wv + 8 * ktl;
        if (kt < nkt) {
            const bf16_t* kp = KI + (size_t)(rb + 32 * kt + cc) * 64 + 8 * hi;
            bf16x8 b[4];
#pragma unroll
            for (int s = 0; s < 4; ++s) b[s] = *(const bf16x8*)(kp + 16 * s);
            const int key = 32 * kt + cc;
#pragma unroll
            for (int rt = 0; rt < 4; ++rt) {
                f32x16 acc = {};
#pragma unroll
                for (int s = 0; s < 4; ++s) acc = MFMA32(*(const bf16x8*)(smem + SL_QIF + ((rt * 4 + s) * 64 + lane) * 16), b[s], acc);
                float p[4];
#pragma unroll
                for (int qq = 0; qq < 4; ++qq) { const f32x4 w4 = *(const f32x4*)(WIL + (4 * rt + qq) * 8 + 4 * hi);
                    p[qq] = w4[0] * fmaxf(acc[4 * qq], 0.f) + w4[1] * fmaxf(acc[4 * qq + 1], 0.f) + w4[2] * fmaxf(acc[4 * qq + 2], 0.f) + w4[3] * fmaxf(acc[4 * qq + 3], 0.f); }
                const auto r01 = __builtin_amdgcn_permlane32_swap(__float_as_uint(p[0]), __float_as_uint(p[1]), false, false);
                const auto r23 = __builtin_amdgcn_permlane32_swap(__float_as_uint(p[2]), __float_as_uint(p[3]), false, false);
                float s0 = __uint_as_float(r01[0]) + __uint_as_float(r01[1]) + 0.f, s1 = __uint_as_float(r23[0]) + __uint_as_float(r23[1]) + 0.f;
                if (key > t0 + 4 * rt + hi) s0 = NINF;
                if (key > t0 + 4 * rt + 2 + hi) s1 = NINF;
                sc[ktl][rt][0] = s0; sc[ktl][rt][1] = s1;
            }
        } else {
#pragma unroll
            for (int rt = 0; rt < 4; ++rt) { sc[ktl][rt][0] = NINF; sc[ktl][rt][1] = NINF; }
        }
    }
    if (t0 >= TOPK) {
        {
#pragma unroll
          for (int rt = 0; rt < 4; ++rt)
#pragma unroll
              for (int i = 0; i < 2; ++i) { float mn = __builtin_inff(), mx = NINF;
#pragma unroll
                  for (int ktl = 0; ktl < 16; ++ktl) { const float x = sc[ktl][rt][i]; mx = fmaxf(mx, x); mn = (x > NINF) ? fminf(mn, x) : mn; }
#pragma unroll
                  for (int o = 1; o < 32; o <<= 1) { mn = fminf(mn, __shfl_xor(mn, o)); mx = fmaxf(mx, __shfl_xor(mx, o)); }
                  if (cc == 0 && mx > NINF) { const int q = 4 * rt + 2 * i + hi; atomicMin(&ST[q], fkey(mn)); atomicMax(&ST[16 + q], fkey(mx)); } } }
        __syncthreads();
        if (tid < 16) { STf[32 + tid] = fkey_inv(ST[tid]); STf[48 + tid] = fkey_inv(ST[16 + tid]); ST[64 + tid] = TOPK; ST[96 + tid] = 0u; }
        __syncthreads();
#pragma unroll 1
        for (int level = 0; level < 12; ++level) {
            if (tid < 16 && ST[96 + tid] == 0u && STf[32 + tid] == STf[48 + tid]) { STf[80 + tid] = STf[32 + tid]; ST[96 + tid] = 1u; }
            for (int p = tid; p < 4096; p += 512) HIST[p] = 0u;
            if (tid == 0) ST[176] = 0u;
            if (tid < 16) { ST[144 + tid] = 0u; ST[tid] = 0xffffffffu; ST[16 + tid] = 0u; }
            __syncthreads();
#pragma unroll
            for (int rt = 0; rt < 4; ++rt)
#pragma unroll
                for (int i = 0; i < 2; ++i) { const int q = 4 * rt + 2 * i + hi;
                    if (ST[96 + q] == 0u) { const float lo = STf[32 + q], hv = STf[48 + q], scale = 256.f / (hv - lo);
#pragma unroll
                        for (int ktl = 0; ktl < 16; ++ktl) { float x = sc[ktl][rt][i]; asm volatile("" : "+v"(x));
                            if (x >= lo && x <= hv) { const int b = min(255, (int)((x - lo) * scale)); atomicAdd(&HIST[q * 256 + b], 1u); } } } }
            __syncthreads();
            { const int q = 2 * wv + hi;
              if (ST[96 + q] == 0u) { const unsigned krem = ST[64 + q]; unsigned loc[8]; unsigned lsum = 0;
#pragma unroll
                  for (int j = 0; j < 8; ++j) { loc[j] = HIST[q * 256 + 255 - 8 * cc - j]; lsum += loc[j]; }
                  unsigned incl = lsum;
#pragma unroll
                  for (int o = 1; o < 32; o <<= 1) { const unsigned t = __shfl_up(incl, o, 32); if (cc >= o) incl += t; }
                  const unsigned excl = incl - lsum;
                  if (excl < krem && krem <= incl) { unsigned cum = excl; int bs = 0; unsigned cn = 0; bool found = false;
#pragma unroll
                      for (int j = 0; j < 8; ++j) { if (!found) { if (cum + loc[j] >= krem) { bs = 255 - 8 * cc - j; cn = loc[j]; found = true; } else cum += loc[j]; } }
                      ST[112 + q] = (unsigned)bs; ST[64 + q] = krem - cum; ST[128 + q] = cn; } } }
            __syncthreads();
#pragma unroll
            for (int rt = 0; rt < 4; ++rt)
#pragma unroll
                for (int i = 0; i < 2; ++i) { const int q = 4 * rt + 2 * i + hi;
                    if (ST[96 + q] == 0u) { const float lo = STf[32 + q], hv = STf[48 + q], scale = 256.f / (hv - lo); const int bs = (int)ST[112 + q]; const bool small = ST[128 + q] <= 256u;
#pragma unroll
                        for (int ktl = 0; ktl < 16; ++ktl) { float x = sc[ktl][rt][i]; asm volatile("" : "+v"(x));
                            if (x >= lo && x <= hv && min(255, (int)((x - lo) * scale)) == bs) {
                                if (small) { const unsigned pos = atomicAdd(&ST[144 + q], 1u); CAND[q * 256 + pos] = x; }
                                else { atomicMin(&ST[q], fkey(x)); atomicMax(&ST[16 + q], fkey(x)); } } } } }
            __syncthreads();
            { const int q = 2 * wv + hi;
              if (ST[96 + q] == 0u) {
                  if (ST[128 + q] <= 256u) { const int cn = (int)ST[128 + q]; const unsigned want = ST[64 + q] - 1u;
                      for (int e = cc; e < cn; e += 32) { const float v = CAND[q * 256 + e]; unsigned rank = 0;
                          for (int j = 0; j < cn; ++j) { const float o = CAND[q * 256 + j]; rank += (o > v || (o == v && j < e)) ? 1u : 0u; }
                          if (rank == want) { STf[80 + q] = v; ST[96 + q] = 1u; } } }
                  else if (cc == 0) { STf[32 + q] = fkey_inv(ST[q]); STf[48 + q] = fkey_inv(ST[16 + q]); ST[176] = 1u; } } }
            __syncthreads();
            const unsigned act = ST[176];
            __syncthreads();
            if (act == 0u) break;
        }
    } else { if (tid < 16) STf[80 + tid] = NINF; }
    __syncthreads();
#pragma unroll
    for (int rt = 0; rt < 4; ++rt)
#pragma unroll
        for (int i = 0; i < 2; ++i) { const int q = 4 * rt + 2 * i + hi; const float T = STf[80 + q]; unsigned cg = 0;
#pragma unroll
            for (int ktl = 0; ktl < 16; ++ktl) { const float x = sc[ktl][rt][i]; const int kt = wv + 8 * ktl;
                const unsigned long long bg = __ballot(x > T), be = __ballot(x == T && T > NINF);
                if (kt < nkt && cc == 0) { const unsigned g = hi ? (unsigned)(bg >> 32) : (unsigned)bg, e = hi ? (unsigned)(be >> 32) : (unsigned)be; MWG[q * 128 + kt] = g; MWE[q * 128 + kt] = e; cg += __popc(g); } }
            if (cc == 0) atomicAdd(&ST[160 + q], cg); }
    __syncthreads();
    { const int q = 2 * wv + hi; const int need = TOPK - (int)ST[160 + q];
      u32x4 g = *(const u32x4*)(MWG + q * 128 + 4 * cc), e = *(const u32x4*)(MWE + q * 128 + 4 * cc);
      unsigned ew[4] = {e.x, e.y, e.z, e.w}; unsigned lsum = __popc(ew[0]) + __popc(ew[1]) + __popc(ew[2]) + __popc(ew[3]); unsigned incl = lsum;
#pragma unroll
      for (int o = 1; o < 32; o <<= 1) { const unsigned t = __shfl_up(incl, o, 32); if (cc >= o) incl += t; }
      int before = (int)(incl - lsum);
#pragma unroll
      for (int j = 0; j < 4; ++j) { const int pc = __popc(ew[j]); int allowed = need - before; allowed = allowed < 0 ? 0 : (allowed > pc ? pc : allowed);
          unsigned w = ew[j]; while (__popc(w) > allowed) w &= ~(0x80000000u >> __clz(w));
          ew[j] = w; before += pc; }
      *(u32x4*)((unsigned*)(c.R + R_P2 + P2_MASK) + (size_t)(row0 + q) * 128 + 4 * cc) = (u32x4){g.x | ew[0], g.y | ew[1], g.z | ew[2], g.w | ew[3]}; }
}
__device__ __forceinline__ void phase_dsa_select(const Ctx& c, unsigned char* smem) { for (int u = blockIdx.x; u < MS / 16; u += gridDim.x) dsa_select_unit(c, u, smem); }

typedef short s16x4 __attribute__((ext_vector_type(4)));
constexpr int AT_TILE = 16384, AT_K = 0, AT_V = 4 * AT_TILE, AT_WS = 8 * AT_TILE, AT_LDS = AT_WS + 8 * 64 * 4 * 2;
#define KSWZ(row, colB) ((row) * 256 + ((colB) ^ (((row) & 7) << 4)))
__device__ __forceinline__ int v_st(int k, int cidx) { const int kk = (k & ~0xC) | ((k & 4) << 1) | ((k & 8) >> 1); return ((kk >> 3) * 4 + (cidx >> 5)) * 512 + ((kk & 7) * 32 + (cidx & 31)) * 2; }
__device__ __forceinline__ int v_rd_base(int lane) { return ((lane & 3) << 3) | (((lane >> 2) & 3) << 6) | (((lane >> 4) & 1) << 5) | (((lane >> 5) & 1) << 8); }
constexpr int v_rd_off(int d0, int ks, int half) { return d0 * 512 + ks * 4096 + half * 2048; }
constexpr float AT_SCALE = 0.08838834764831845f, AT_THR = 8.f;
__device__ __forceinline__ unsigned cvtpk_a(float lo, float hi) { unsigned r; asm volatile("v_cvt_pk_bf16_f32 %0, %1, %2" : "=v"(r) : "v"(lo), "v"(hi)); return r; }
__device__ __forceinline__ void at_partialSM(f32x16& p0, f32x16& p1, float& m_reg, float& alpha) {
    float pmax = p0[0];
#pragma unroll
    for (int r = 1; r < 16; ++r) pmax = fmaxf(pmax, p0[r]);
#pragma unroll
    for (int r = 0; r < 16; ++r) pmax = fmaxf(pmax, p1[r]);
    { auto rr = __builtin_amdgcn_permlane32_swap(__float_as_uint(pmax), __float_as_uint(pmax), false, false); pmax = fmaxf(__uint_as_float(rr[0]), __uint_as_float(rr[1])); }
    constexpr float C2 = 1.4426950408889634f * AT_SCALE; float mn;
    if (__builtin_expect(__all((pmax - m_reg) * AT_SCALE <= AT_THR), 1)) { mn = m_reg; alpha = 1.f; }
    else { mn = fmaxf(m_reg, pmax); alpha = __builtin_amdgcn_exp2f((m_reg - mn) * C2); m_reg = mn; }
    const float mnL = -mn * C2;
#pragma unroll
    for (int r = 0; r < 16; ++r) { p0[r] = __builtin_amdgcn_exp2f(fmaf(p0[r], C2, mnL)); p1[r] = __builtin_amdgcn_exp2f(fmaf(p1[r], C2, mnL)); }
}
__device__ __forceinline__ void at_finishSM(const f32x16& p0, const f32x16& p1, float alpha, float& l_reg, bf16x8& pa0, bf16x8& pa1, bf16x8& pa2, bf16x8& pa3) {
    float ps = 0;
#pragma unroll
    for (int r = 0; r < 16; ++r) ps += p0[r];
#pragma unroll
    for (int r = 0; r < 16; ++r) ps += p1[r];
    { auto rr = __builtin_amdgcn_permlane32_swap(__float_as_uint(ps), __float_as_uint(ps), false, false); ps = __uint_as_float(rr[0]) + __uint_as_float(rr[1]); }
    l_reg = l_reg * alpha + ps;
#define AT_PK4(P, B_, OUT) do { unsigned a0 = cvtpk_a(P[B_+0], P[B_+1]), a1 = cvtpk_a(P[B_+2], P[B_+3]); unsigned b0 = cvtpk_a(P[B_+4], P[B_+5]), b1 = cvtpk_a(P[B_+6], P[B_+7]); \
        auto r0 = __builtin_amdgcn_permlane32_swap(a0, b0, false, false); auto r1 = __builtin_amdgcn_permlane32_swap(a1, b1, false, false); \
        u32x4 w = {r0[0], r1[0], r0[1], r1[1]}; OUT = __builtin_bit_cast(bf16x8, w); } while (0)
    AT_PK4(p0, 0, pa0); AT_PK4(p0, 8, pa1); AT_PK4(p1, 0, pa2); AT_PK4(p1, 8, pa3);
#undef AT_PK4
}
__device__ __forceinline__ void at_qkt(f32x16& p0, f32x16& p1, const unsigned char* Kt, int r32, int hi, const bf16x8* qr) {
    p0 = f32x16{}; p1 = f32x16{};
    const unsigned char* kb[4];
#pragma unroll
    for (int dd = 0; dd < 4; ++dd) kb[dd] = Kt + KSWZ(r32, (dd * 16 + hi * 8) * 2);
#pragma unroll
    for (int d0 = 0; d0 < 8; ++d0) { const unsigned char* a = kb[d0 & 3] + (d0 >> 2) * 128;
        const bf16x8 b0 = *reinterpret_cast<const bf16x8*>(a), b1 = *reinterpret_cast<const bf16x8*>(a + 32 * 256);
        p0 = MFMA32(b0, qr[d0], p0); p1 = MFMA32(b1, qr[d0], p1); }
}
template <int VOFF> __device__ __forceinline__ void at_pv(f32x16* o, int vb0, bf16x8 pa0, bf16x8 pa1, bf16x8 pa2, bf16x8 pa3) {
#define TRRD(dst, off) asm volatile("ds_read_b64_tr_b16 %0, %1 offset:%2" : "=&v"(dst) : "v"(vb0), "i"(off) : "memory")
#define PV_D0(d0) do { s16x4 l0, l1, l2, l3, h0, h1, h2, h3; constexpr int b_ = VOFF + v_rd_off(d0, 0, 0); \
        TRRD(l0, b_); TRRD(h0, b_ + 2048); TRRD(l1, b_ + 4096); TRRD(h1, b_ + 6144); TRRD(l2, b_ + 8192); TRRD(h2, b_ + 10240); TRRD(l3, b_ + 12288); TRRD(h3, b_ + 14336); \
        asm volatile("s_waitcnt lgkmcnt(0)" ::: "memory"); __builtin_amdgcn_sched_barrier(0); \
        o[d0] = MFMA32(pa0, ((bf16x8){l0[0], l0[1], l0[2], l0[3], h0[0], h0[1], h0[2], h0[3]}), o[d0]); \
        o[d0] = MFMA32(pa1, ((bf16x8){l1[0], l1[1], l1[2], l1[3], h1[0], h1[1], h1[2], h1[3]}), o[d0]); \
        o[d0] = MFMA32(pa2, ((bf16x8){l2[0], l2[1], l2[2], l2[3], h2[0], h2[1], h2[2], h2[3]}), o[d0]); \
        o[d0] = MFMA32(pa3, ((bf16x8){l3[0], l3[1], l3[2], l3[3], h3[0], h3[1], h3[2], h3[3]}), o[d0]); } while (0)
    PV_D0(0); PV_D0(1); PV_D0(2); PV_D0(3);
#undef PV_D0
#undef TRRD
}
__device__ __forceinline__ void dsa_attn_unit(const Ctx& c, int split, int unit, unsigned char* smem) {
    const int tid = otid(), lane = tid & 63, wv = __builtin_amdgcn_readfirstlane(tid >> 6), r32 = lane & 31, hi = lane >> 5, rg = wv & 3, kp = wv >> 2;
    const int bh = unit & (BPS * 8 - 1), qb = (SEQ / 128 - 1) - unit / (BPS * 8), bl = bh >> 3, h = bh & 7, rb = bl * SEQ, q0 = 128 * qb, nstep = qb + 1;
    const bf16_t* QB = (const bf16_t*)(c.R + R_QB); const bf16_t* KB = (const bf16_t*)(c.R + R_KB) + (size_t)rb * 1024 + h * 128; const bf16_t* VB = (const bf16_t*)(c.R + R_VB) + (size_t)rb * 1024 + h * 128;
    const unsigned* MK = (const unsigned*)(c.R + R_P2 + P2_MASK) + (size_t)(rb + q0 + 32 * rg + r32) * 128;
    float* ws = (float*)(smem + AT_WS) + wv * 128; float* li_l = ws; float* al_l = ws + 32;
    const int sr = tid >> 4, scol = (tid & 15) * 8, vst0 = v_st(sr, scol), vst1 = v_st(32 + sr, scol), kws = KSWZ(sr, scol * 2);
    const int vb0 = (int)(uintptr_t)(smem + AT_V) + kp * AT_TILE + v_rd_base(lane);
    bf16x8 qr[8];
    { const bf16_t* qp = QB + (size_t)(rb + q0 + 32 * rg + r32) * 1024 + h * 128 + hi * 8;
#pragma unroll
      for (int d0 = 0; d0 < 8; ++d0) qr[d0] = *(const bf16x8*)(qp + d0 * 16); }
    bf16x8 sk[4], sv[4];
#define AT_LOAD(j) do { const size_t o0 = (size_t)(128 * (j) + sr) * 1024 + scol; sk[0] = *(const bf16x8*)(KB + o0); sk[1] = *(const bf16x8*)(KB + o0 + 32 * 1024); sk[2] = *(const bf16x8*)(KB + o0 + 64 * 1024); sk[3] = *(const bf16x8*)(KB + o0 + 96 * 1024); \
        sv[0] = *(const bf16x8*)(VB + o0); sv[1] = *(const bf16x8*)(VB + o0 + 32 * 1024); sv[2] = *(const bf16x8*)(VB + o0 + 64 * 1024); sv[3] = *(const bf16x8*)(VB + o0 + 96 * 1024); } while (0)
#define AT_WRITE(bf) do { unsigned char* Kd = smem + AT_K + (bf) * 2 * AT_TILE; unsigned char* Vd = smem + AT_V + (bf) * 2 * AT_TILE; \
        *(bf16x8*)(Kd + kws) = sk[0]; *(bf16x8*)(Kd + kws + 32 * 256) = sk[1]; *(bf16x8*)(Kd + AT_TILE + kws) = sk[2]; *(bf16x8*)(Kd + AT_TILE + kws + 32 * 256) = sk[3]; \
        *(bf16x8*)(Vd + vst0) = sv[0]; *(bf16x8*)(Vd + vst1) = sv[1]; *(bf16x8*)(Vd + AT_TILE + vst0) = sv[2]; *(bf16x8*)(Vd + AT_TILE + vst1) = sv[3]; } while (0)
    __syncthreads();
    AT_LOAD(0); AT_WRITE(0);
    float m_reg = -1e30f, l_reg = 0.f; f32x16 o[4] = {};
    __syncthreads();
    const int lastrow = q0 + 32 * rg + 31; const float NINF = -__builtin_inff();
#define AT_STEP(j, BUF) do { \
        const int tt = 2 * (j) + kp; const bool act = 64 * tt <= lastrow; \
        uint2 mw = make_uint2(0u, 0u); if (act) mw = *(const uint2*)(MK + 2 * tt); \
        if ((j) + 1 < nstep) AT_LOAD((j) + 1); \
        if (act) { \
            const unsigned m0 = mw.x >> (4 * hi), m1 = mw.y >> (4 * hi); \
            f32x16 p0, p1; at_qkt(p0, p1, smem + AT_K + ((BUF) * 2 + kp) * AT_TILE, r32, hi, qr); \
            _Pragma("unroll") for (int r = 0; r < 16; ++r) { const unsigned bit = 1u << ((r & 3) + 8 * (r >> 2)); if (!(m0 & bit)) p0[r] = NINF; if (!(m1 & bit)) p1[r] = NINF; } \
            float alpha; at_partialSM(p0, p1, m_reg, alpha); \
            bf16x8 pa0, pa1, pa2, pa3; at_finishSM(p0, p1, alpha, l_reg, pa0, pa1, pa2, pa3); \
            if (__any(alpha < 1.f)) { if (hi == 0) al_l[r32] = alpha; asm volatile("s_waitcnt lgkmcnt(0)" ::: "memory"); \
                _Pragma("unroll") for (int d_ = 0; d_ < 4; ++d_) _Pragma("unroll") for (int r = 0; r < 16; ++r) o[d_][r] *= al_l[crow(r, hi)]; } \
            __builtin_amdgcn_sched_barrier(0); \
            at_pv<(BUF) * 2 * AT_TILE>(o, vb0, pa0, pa1, pa2, pa3); } \
        if ((j) + 1 < nstep) { asm volatile("s_waitcnt vmcnt(0)" ::: "memory"); AT_WRITE(1 - (BUF)); } \
        __syncthreads(); } while (0)
#pragma unroll 1
    for (int j = 0; j < nstep; j += 2) { AT_STEP(j, 0); if (j + 1 < nstep) AT_STEP(j + 1, 1); }
#undef AT_STEP
#undef AT_LOAD
#undef AT_WRITE
    float* mg = (float*)smem + (size_t)rg * (66 * 64);
    if (kp == 1) {
#pragma unroll
        for (int d0 = 0; d0 < 4; ++d0)
#pragma unroll
            for (int r = 0; r < 16; ++r) mg[(d0 * 16 + r) * 64 + lane] = o[d0][r];
        mg[64 * 64 + lane] = m_reg; mg[65 * 64 + lane] = l_reg; }
    __syncthreads();
    if (kp == 0) {
        constexpr float C2 = 1.4426950408889634f * AT_SCALE;
        const float m2 = mg[64 * 64 + lane], l2 = mg[65 * 64 + lane], mm = fmaxf(m_reg, m2);
        const float a1 = __builtin_amdgcn_exp2f((m_reg - mm) * C2), a2 = __builtin_amdgcn_exp2f((m2 - mm) * C2), lt = l_reg * a1 + l2 * a2;
        if (hi == 0) { li_l[r32] = __builtin_amdgcn_rcpf(lt); al_l[r32] = a1; al_l[32 + r32] = a2; }
        asm volatile("s_waitcnt lgkmcnt(0)" ::: "memory");
        bf16_t* Ow = c.AT + ((size_t)split * MS + rb + q0 + 32 * rg) * 1024 + h * 128;
#pragma unroll
        for (int r = 0; r < 16; ++r) { const int orow = crow(r, hi); const float f1 = al_l[orow] * li_l[orow], f2 = al_l[32 + orow] * li_l[orow];
#pragma unroll
            for (int d0 = 0; d0 < 4; ++d0) { const float v = o[d0][r] * f1 + mg[(d0 * 16 + r) * 64 + lane] * f2; const float vn = __shfl_xor(v, 1);
                if ((r32 & 1) == 0) *(unsigned*)(Ow + (size_t)orow * 1024 + d0 * 32 + r32) = cvtpk_s(v, vn); } } }
}

constexpr int LDS_QSLOT = LDS_BYTES - 16;
__device__ __forceinline__ int queue_next(unsigned* ctr, unsigned char* smem) {
    __syncthreads(); if (otid() == 0) *(volatile int*)(smem + LDS_QSLOT) = (int)atomicAdd(ctr, 1u); __syncthreads(); return *(volatile int*)(smem + LDS_QSLOT);
}
__device__ __forceinline__ void phase_prep_select(const Ctx& c, int layer, int split, unsigned char* smem) {
    unsigned* ctr = (unsigned*)(c.ws + WS_CTL) + 1024 + ((layer * NSPLIT + split) * 2 + 0) * 64;
    constexpr int NSEL = MS / 16, NPREP = (MS / 64) * 8;
    for (;;) { const int u = queue_next(ctr, smem); if (u >= NSEL + NPREP) break; if (u < NSEL) dsa_select_unit(c, u, smem); else gdn_prep_unit(c, layer, u - NSEL, smem); }
}
__device__ __forceinline__ void phase_scan_attn(const Ctx& c, int layer, int split, unsigned char* smem) {
    unsigned* ctr = (unsigned*)(c.ws + WS_CTL) + 1024 + ((layer * NSPLIT + split) * 2 + 1) * 64;
    constexpr int NSCAN = BPS * 8, NATT = BPS * 8 * (SEQ / 128);
    for (;;) { const int u = queue_next(ctr, smem); if (u >= NSCAN + NATT) break; if (u < NSCAN) gdn_scan_unit(c, layer, split, u, smem); else dsa_attn_unit(c, split, u - NSCAN, smem); }
}
typedef const __attribute__((address_space(4))) Args* KArgsP;
__device__ __forceinline__ Ctx make_ctx() {
    KArgsP a = (KArgsP)__builtin_amdgcn_kernarg_segment_ptr(); asm volatile("" : "+s"(a));
    Ctx c;
    c.x = a->in[0]; c.norm_mix = a->in[1]; c.w_in = a->in[2]; c.conv_w = a->in[3]; c.a_log = a->in[4]; c.dt_bias = a->in[5]; c.gdn_norm = a->in[6];
    c.w_out_gdn = a->in[7]; c.w_out_dsa = a->in[8]; c.w_o = a->in[9]; c.norm_ffn = a->in[10]; c.w_gate_up = a->in[11]; c.w_down = a->in[12]; c.norm_final = a->in[13];
    c.out = a->out; c.ws = a->ws; c.R = c.ws + WS_R;
    c.cosA = (float*)(c.ws + WS_TAB); c.sinA = c.cosA + SEQ * 64; c.cosI = c.sinA + SEQ * 64; c.sinI = c.cosI + SEQ * 32;
    c.XN = (bf16_t*)(c.ws + WS_XN); c.OA = (bf16_t*)(c.ws + WS_OA); c.AT = (bf16_t*)(c.ws + WS_AT);
    return c;
}
__global__ void __launch_bounds__(512, 2) fwd_kernel(Args a) {
    extern __shared__ __attribute__((aligned(16))) unsigned char smem[];
    cg::grid_group grid = cg::this_grid();
    PG8_LAS unsigned char* lds = (PG8_LAS unsigned char*)smem;
#define SYNC() grid.sync()
    { const Ctx c = make_ctx(); phase_tables(c); }
    if (ANY_OPT_GEMM) { const Ctx c = make_ctx(); phase_convert_weights(c, 0, smem); }
    { const Ctx c = make_ctx(); phase_rmsnorm(c.x, c.norm_mix, c.XN, nullptr); }
    SYNC();
#pragma unroll 1
    for (int layer = 0; layer < DEPTH; ++layer) {
#pragma unroll 1
        for (int pc = 0; pc < 19; ++pc) {
            int st, split = 0;
            if (pc < 12) { split = pc / 6; st = pc % 6; } else st = pc - 6;
            int k0 = 0, k1 = 0;
            if (st == 0) { if (STAGE_OPT_INPROJ) { const Ctx c = make_ctx(); unsigned char* wt = c.ws + WS_WT; pg8::Gemm g{c.XN + (size_t)split * MS * DM, (const bf16_t*)(wt + WT_IN), MS, 31 * 256, DM}; pg8::StaticOrder S; S.init(MS, 31 * 256, gridDim.x, blockIdx.x);
                    EpiInProj E{c.R, c.cosA, c.sinA, c.cosI, c.sinI, c.a_log + layer * 8, c.dt_bias + layer * 8}; pg8::gemm_phase<EpiInProj, pg8::StaticOrder, true, true>(lds, g, S, E); }
                else { k0 = split * 10; k1 = k0 + 10; } }
            else if (st == 1) { const Ctx c = make_ctx(); if (STAGE_OPT_GDN && STAGE_OPT_DSA) phase_prep_select(c, layer, split, smem); else if (STAGE_OPT_GDN) phase_gdn_prep(c, layer, smem); else naive_conv(c, layer); }
            else if (st == 2) { if (!STAGE_OPT_GDN) { const Ctx c = make_ctx(); naive_l2norm(c); } }
            else if (st == 3) { const Ctx c = make_ctx(); if (STAGE_OPT_GDN && STAGE_OPT_DSA) phase_scan_attn(c, layer, split, smem); else if (STAGE_OPT_GDN) phase_gdn_scan(c, layer, split, smem); else naive_scan(c, smem); }
            else if (st == 4) { if (!STAGE_OPT_GDN) { const Ctx c = make_ctx(); naive_gate(c, layer, split); } }
            else if (st == 5) { if (!(STAGE_OPT_GDN && STAGE_OPT_DSA)) { const Ctx c = make_ctx(); naive_dsa(c, split, smem); } }
            else if (st == 6) { if (STAGE_OPT_GATES) { const Ctx c = make_ctx(); unsigned char* wt = c.ws + WS_WT; pg8::Gemm g{c.XN, (const bf16_t*)(wt + WT_IN) + (size_t)31 * 256 * DM, M, 2048, DM}; pg8::StaticOrder S; S.init(M, 2048, gridDim.x, blockIdx.x);
                    EpiGates E{(bf16_t*)(c.R + R_SG)}; pg8::gemm_phase<EpiGates, pg8::StaticOrder, true, true>(lds, g, S, E); }
                else { k0 = 20; k1 = 24; } }
            else if (st == 7) { if (STAGE_OPT_Y) { const Ctx c = make_ctx(); unsigned char* wt = c.ws + WS_WT; pg8::StaticOrder S; S.init(M, DM, gridDim.x, blockIdx.x);
                    { pg8::Gemm g{c.OA, (const bf16_t*)(wt + WT_OG), M, DM, DM}; EpiY<0> E{(const bf16_t*)(c.R + R_SG), (bf16_t*)(c.R + R_MG)}; pg8::gemm_phase<EpiY<0>, pg8::StaticOrder, false, true>(lds, g, S, E); }
                    { pg8::Gemm g{c.AT, (const bf16_t*)(wt + WT_OD), M, DM, DM}; EpiY<1> E{(const bf16_t*)(c.R + R_SG), (bf16_t*)(c.R + R_MG)}; pg8::gemm_phase<EpiY<1>, pg8::StaticOrder, false, true>(lds, g, S, E); } }
                else { k0 = 24; k1 = 28; } }
            else if (st == 8) { if (STAGE_OPT_WO) { const Ctx c = make_ctx(); unsigned char* wt = c.ws + WS_WT; pg8::Gemm g{(const bf16_t*)(c.R + R_MG), (const bf16_t*)(wt + WT_O), M, DM, DM}; pg8::StaticOrder S; S.init(M, DM, gridDim.x, blockIdx.x);
                    EpiResid E{layer == 0 ? c.x : c.out, c.out}; pg8::gemm_phase<EpiResid, pg8::StaticOrder, false, true>(lds, g, S, E); }
                else { k0 = 28; k1 = 30; } }
            else if (st == 9) { const Ctx c = make_ctx(); phase_rmsnorm(c.out, c.norm_ffn + layer * DM, c.XN, nullptr); }
            else if (st == 10) { if (STAGE_OPT_GU) { const Ctx c = make_ctx(); unsigned char* wt = c.ws + WS_WT; pg8::Gemm g{c.XN, (const bf16_t*)(wt + WT_GU), M, 2 * FF, DM}; pg8::StaticOrder S; S.init(M, 2 * FF, gridDim.x, blockIdx.x);
                    EpiSwiglu E{(bf16_t*)(c.R + R_ACT)}; pg8::gemm_phase<EpiSwiglu, pg8::StaticOrder, true, true>(lds, g, S, E); }
                else { k0 = 30; k1 = 52; } }
            else if (st == 11) { if (STAGE_OPT_DN) { const Ctx c = make_ctx(); unsigned char* wt = c.ws + WS_WT; pg8::Gemm g{(const bf16_t*)(c.R + R_ACT), (const bf16_t*)(wt + WT_DN), M, DM, FF}; pg8::StaticOrder S; S.init(M, DM, gridDim.x, blockIdx.x);
                    EpiResid E{c.out, c.out}; pg8::gemm_phase<EpiResid, pg8::StaticOrder, false, true>(lds, g, S, E); }
                else { k0 = 52; k1 = 54; } }
            else { const Ctx c = make_ctx(); if (layer + 1 < DEPTH) { phase_rmsnorm(c.out, c.norm_mix + (layer + 1) * DM, c.XN, nullptr); if (ANY_OPT_GEMM) phase_convert_weights(c, layer + 1, smem); }
                   else phase_rmsnorm(c.out, c.norm_final, nullptr, c.out); }
#pragma unroll 1
            for (int k = k0; k < k1; ++k) {
                const Ctx c = make_ctx(); const float* w_in = c.w_in + (size_t)layer * DM * INC; float* TMP = (float*)(c.R + R_TMP);
                NG g; EP e; int ng = 1;
                g.A = c.XN; g.lda = DM; g.W = w_in; g.ldw = INC; g.col0 = 0; g.ncols = 1024; g.row0 = 0; g.nrows = MS; g.K = DM; g.T = TMP; g.ldt = 1024; g.tcol0 = 0;
                e.kind = E_V; e.nrows = MS; e.rowg0 = 0; e.p0 = 0; e.layer = layer; e.dst = nullptr; e.base = nullptr;
                if (k < 20) { const int sp = k / 10, j = k % 10; g.row0 = sp * MS; e.rowg0 = sp * MS;
                    if (j < 3) { g.col0 = C_QKVA + j * 1024; e.kind = E_QKVA; e.p0 = j; }
                    else if (j == 3) { g.col0 = C_Z; e.kind = E_Z; }
                    else if (j == 4) { g.col0 = C_A; g.ncols = 16; e.kind = E_AB; }
                    else if (j == 5) { g.col0 = C_QB; e.kind = E_ROPE; e.dst = (bf16_t*)(c.R + R_QB); }
                    else if (j == 6) { g.col0 = C_KB; e.kind = E_ROPE; e.dst = (bf16_t*)(c.R + R_KB); }
                    else if (j == 7) { g.col0 = C_VB; e.kind = E_V; e.dst = (bf16_t*)(c.R + R_VB); }
                    else if (j == 8) { g.col0 = C_QI; g.ncols = 512; e.kind = E_QI; }
                    else { g.col0 = C_KI; g.ncols = 72; e.kind = E_KIWI; } }
                else if (k < 24) { const int hf = (k - 20) >> 1, gg = (k - 20) & 1; g.row0 = hf * MS; e.rowg0 = hf * MS; g.col0 = C_GA + gg * 1024; e.kind = E_SG; e.p0 = gg; }
                else if (k < 28) { const int hf = (k - 24) >> 1, wh = (k - 24) & 1; g.row0 = hf * MS; e.rowg0 = hf * MS; g.A = wh ? c.AT : c.OA;
                    g.W = (wh ? c.w_out_dsa : c.w_out_gdn) + (size_t)layer * DM * DM; g.ldw = DM; e.kind = wh ? E_YB : E_YA; }
                else if (k < 30) { const int hf = k - 28; g.row0 = hf * MS; e.rowg0 = hf * MS; g.A = (const bf16_t*)(c.R + R_MG); g.W = c.w_o + (size_t)layer * DM * DM; g.ldw = DM; e.kind = E_WO; e.base = layer == 0 ? c.x : c.out; }
                else if (k < 52) { const int hf = (k - 30) / 11, fg = (k - 30) % 11; g.row0 = hf * MS; e.rowg0 = hf * MS; g.W = c.w_gate_up + (size_t)layer * DM * 2 * FF; g.ldw = 2 * FF; g.col0 = fg * 256; g.ncols = 256;
                    ng = 2; e.kind = E_SWIGLU; e.p0 = fg; }
                else { const int hf = k - 52; g.row0 = hf * MS; e.rowg0 = hf * MS; g.A = (const bf16_t*)(c.R + R_ACT); g.lda = FF; g.K = FF; g.W = c.w_down + (size_t)layer * FF * DM; g.ldw = DM; e.kind = E_DOWN; }
#pragma unroll 1
                for (int q = 0; q < ng; ++q) { if (q == 1) { g.col0 += FF; g.tcol0 = 256; } naive_gemm(g, smem); }
                SYNC();
                epi_phase(c, e);
                if (k + 1 < k1) SYNC();
            }
            SYNC();
        }
    }
}

extern "C" void kernel_launch(void* const* d_in, const int* in_sizes, int n_in, void* d_out, int out_size, void* d_ws, size_t ws_size, hipStream_t stream) {
    static int grid = 0;
    if (grid == 0) {
        if (n_in != 14 || out_size != M * DM || ws_size < WS_END) { fprintf(stderr, "kernel_launch: unexpected problem (n_in %d out %d ws %zu need %zu)\n", n_in, out_size, ws_size, (size_t)WS_END); grid = -1; return; }
        int dev = 0, cus = 0, per_cu = 0;
        hipGetDevice(&dev); hipDeviceGetAttribute(&cus, hipDeviceAttributeMultiprocessorCount, dev);
        hipFuncSetAttribute((const void*)fwd_kernel, hipFuncAttributeMaxDynamicSharedMemorySize, LDS_BYTES);
        hipOccupancyMaxActiveBlocksPerMultiprocessor(&per_cu, (const void*)fwd_kernel, 512, LDS_BYTES);
        if (per_cu < 1) { fprintf(stderr, "kernel_launch: occupancy query says %d blocks/CU\n", per_cu); grid = -1; return; }
        grid = cus;
        (void)hipGetLastError();
    }
    if (grid < 0) return;
    hipMemsetAsync((char*)d_ws + WS_CTL, 0, 1 * MiB, stream);
    Args a{};
    for (int i = 0; i < 14; ++i) a.in[i] = (const float*)d_in[i];
    a.out = (float*)d_out; a.ws = (unsigned char*)d_ws;
    void* args[] = {&a};
    hipError_t e = hipLaunchCooperativeKernel((const void*)fwd_kernel, dim3(grid), dim3(512), args, LDS_BYTES, stream);
    if (e != hipSuccess) fprintf(stderr, "cooperative launch failed: %s (grid %d)\n", hipGetErrorString(e), grid);
}
```

```cpp
#include <hip/hip_runtime.h>
#include <hip/hip_cooperative_groups.h>
#include <cstdio>
#include <cstdint>
namespace cg = cooperative_groups;

typedef unsigned short bf16_t;
typedef float f32x4 __attribute__((ext_vector_type(4)));

constexpr int BATCH = 4, SEQ = 4096, DM = 1024, M = BATCH * SEQ, DEPTH = 2;
constexpr int GH = 8, GD = 128, CONVK = 4, CH = 64;
constexpr int AH = 8, AD = 128, IH = 8, ID = 64, TOPK = 256;
constexpr int FF = 2816, INC = 9816;
constexpr int NSPLIT = 2, MS = M / NSPLIT, BPS = BATCH / NSPLIT;
constexpr float EPS = 1e-6f;
constexpr int C_QKVA = 0, C_Z = 3072, C_A = 4096, C_B = 4104, C_QB = 4112, C_KB = 5136, C_VB = 6160, C_QI = 7184, C_KI = 7696, C_WI = 7760, C_GA = 7768, C_GB = 8792;

constexpr size_t MiB = 1u << 20;
constexpr size_t WS_CTL = 0;
constexpr size_t WS_WT = 1 * MiB;
constexpr size_t WS_TAB = 43 * MiB;
constexpr size_t WS_XN = 46 * MiB;
constexpr size_t WS_OA = 78 * MiB;
constexpr size_t WS_AT = 110 * MiB;
constexpr size_t WS_R = 142 * MiB;
constexpr size_t R_QKVA = 0, R_ZS = 48 * MiB, R_QB = 64 * MiB, R_KB = 80 * MiB, R_VB = 96 * MiB, R_QI = 112 * MiB, R_KI = 120 * MiB;
constexpr size_t R_WI = 121 * MiB, R_GG = R_WI + 256 * 1024, R_BETA = R_GG + 256 * 1024, R_HALO = 122 * MiB;
constexpr size_t R_P2 = 124 * MiB + 256 * 1024;
constexpr size_t R_TMP = R_P2;
constexpr size_t R_SG = 0, R_M1 = 64 * MiB, R_MG = R_M1;
constexpr size_t R_ACT = 0;
constexpr size_t WS_END = WS_R + R_P2 + 32 * MiB;
static_assert(WS_END <= 321650688ull, "workspace map exceeds the guaranteed d_ws size");
constexpr int LDS_BYTES = 163840;

struct Args { const float* in[14]; float* out; unsigned char* ws; };

__device__ __forceinline__ int otid() { int t = threadIdx.x; asm volatile("" : "+v"(t)); return t; }
__device__ __forceinline__ float bf2f(unsigned v) { return __uint_as_float(v << 16); }
__device__ __forceinline__ bf16_t f2bf(float f) { unsigned u = __float_as_uint(f); u += 0x7fffu + ((u >> 16) & 1u); return (bf16_t)(u >> 16); }
__device__ __forceinline__ float sigmoidf_(float x) { return 1.f / (1.f + __expf(-x)); }
__device__ __forceinline__ float siluf_(float x) { return x / (1.f + __expf(-x)); }
__device__ __forceinline__ float softplusf_(float x) { return fmaxf(x, 0.f) + log1pf(__expf(-fabsf(x))); }
__device__ __forceinline__ float wave_sum(float v) {
#pragma unroll
    for (int o = 1; o < 64; o <<= 1) v += __shfl_xor(v, o);
    return v;
}
__device__ __forceinline__ float wave_max(float v) {
#pragma unroll
    for (int o = 1; o < 64; o <<= 1) v = fmaxf(v, __shfl_xor(v, o));
    return v;
}

struct Ctx {
    const float* x; const float* norm_mix; const float* w_in; const float* conv_w; const float* a_log; const float* dt_bias; const float* gdn_norm;
    const float* w_out_gdn; const float* w_out_dsa; const float* w_o; const float* norm_ffn; const float* w_gate_up; const float* w_down; const float* norm_final;
    float* out; unsigned char* ws; unsigned char* R;
    float *cosA, *sinA, *cosI, *sinI;
    bf16_t *XN, *OA, *AT;
};

__device__ const double ROPE_INVF[64] = {1.0, 0.8659643233600653, 0.7498942093324559, 0.6493816315762113, 0.5623413251903491, 0.4869675251658631, 0.4216965034285822, 0.3651741272548377, 0.31622776601683794, 0.27384196342643613, 0.23713737056616552, 0.2053525026457146, 0.1778279410038923, 0.1539926526059492, 0.1333521432163324, 0.11547819846894582, 0.1, 0.08659643233600653, 0.07498942093324558, 0.06493816315762113, 0.05623413251903491, 0.04869675251658631, 0.042169650342858224, 0.03651741272548377, 0.03162277660168379, 0.027384196342643614, 0.023713737056616554, 0.02053525026457146, 0.01778279410038923, 0.01539926526059492, 0.01333521432163324, 0.011547819846894581, 0.01, 0.008659643233600654, 0.007498942093324558, 0.006493816315762113, 0.005623413251903491, 0.004869675251658631, 0.004216965034285823, 0.003651741272548377, 0.0031622776601683794, 0.0027384196342643613, 0.0023713737056616554, 0.002053525026457146, 0.0017782794100389228, 0.001539926526059492, 0.001333521432163324, 0.0011547819846894581, 0.001, 0.0008659643233600654, 0.0007498942093324559, 0.0006493816315762113, 0.0005623413251903491, 0.0004869675251658631, 0.00042169650342858224, 0.0003651741272548377, 0.00031622776601683794, 0.0002738419634264361, 0.00023713737056616554, 0.0002053525026457146, 0.00017782794100389227, 0.0001539926526059492, 0.0001333521432163324, 0.00011547819846894582};
__device__ __forceinline__ void rope_cs(int t, double invf, float& cs, float& sn) {
    const double ang = (double)t * invf; const double k = rint(ang * 0.15915494309189535); const float r = (float)(ang - k * 6.283185307179586);
    cs = cosf(r); sn = sinf(r);
}
__device__ __forceinline__ void phase_tables(const Ctx& c) {
    const int gt = blockIdx.x * blockDim.x + otid(), nt = gridDim.x * blockDim.x;
    for (int i = gt; i < SEQ * 64; i += nt) { const int t = i >> 6, d = i & 63; float cs, sn; rope_cs(t, ROPE_INVF[d], cs, sn); c.cosA[i] = cs; c.sinA[i] = sn; }
    for (int i = gt; i < SEQ * 32; i += nt) { const int t = i >> 5, d = i & 31; float cs, sn; rope_cs(t, ROPE_INVF[2 * d], cs, sn); c.cosI[i] = cs; c.sinI[i] = sn; }
}

__device__ __forceinline__ void phase_rmsnorm(const float* src, const float* gain, bf16_t* dst_bf, float* dst_f) {
    const int lane = otid() & 63, gw = (blockIdx.x * blockDim.x + otid()) >> 6, nw = (gridDim.x * blockDim.x) >> 6;
    for (int r = gw; r < M; r += nw) {
        const f32x4* xr = (const f32x4*)(src + (size_t)r * DM) + lane;
        f32x4 v[4]; float s = 0.f;
#pragma unroll
        for (int j = 0; j < 4; ++j) { v[j] = xr[64 * j]; s += v[j].x * v[j].x + v[j].y * v[j].y + v[j].z * v[j].z + v[j].w * v[j].w; }
        const float rs = rsqrtf(wave_sum(s) * (1.f / DM) + EPS);
#pragma unroll
        for (int j = 0; j < 4; ++j) {
            const f32x4 g = ((const f32x4*)gain)[lane + 64 * j]; const f32x4 o = v[j] * rs * g;
            if (dst_bf) { uint2 w; w.x = f2bf(o.x) | ((unsigned)f2bf(o.y) << 16); w.y = f2bf(o.z) | ((unsigned)f2bf(o.w) << 16); ((uint2*)(dst_bf + (size_t)r * DM))[lane + 64 * j] = w; }
            else ((f32x4*)(dst_f + (size_t)r * DM))[lane + 64 * j] = o;
        }
    }
}

struct NG { const bf16_t* A; int lda; const float* W; int ldw; int col0; int ncols; int row0; int nrows; int K; float* T; int ldt; int tcol0; };
__device__ __forceinline__ void naive_gemm(const NG& g, unsigned char* smem) {
    float* As = (float*)smem; float* Bs = As + 16 * 132;
    const int tid = otid(), ty = tid >> 4, tx = tid & 15;
    const int ntr = g.nrows / 128, ntc = (g.ncols + 63) / 64;
    for (int u = blockIdx.x; u < ntr * ntc; u += gridDim.x) {
        const int tr = u % ntr, tc = u / ntr, r0 = tr * 128, c0 = tc * 64;
        float acc[4][4];
#pragma unroll
        for (int i = 0; i < 4; ++i)
#pragma unroll
            for (int j = 0; j < 4; ++j) acc[i][j] = 0.f;
        for (int k0 = 0; k0 < g.K; k0 += 16) {
            { const int row = tid >> 2, kq = (tid & 3) * 4;
              const uint2 raw = *(const uint2*)(g.A + (size_t)(g.row0 + r0 + row) * g.lda + k0 + kq);
              As[(kq + 0) * 132 + row] = bf2f(raw.x & 0xffffu); As[(kq + 1) * 132 + row] = bf2f(raw.x >> 16);
              As[(kq + 2) * 132 + row] = bf2f(raw.y & 0xffffu); As[(kq + 3) * 132 + row] = bf2f(raw.y >> 16); }
            { const int k = tid >> 5, cc = (tid & 31) * 2;
              const float* wp = g.W + (size_t)(k0 + k) * g.ldw + g.col0 + c0 + cc;
              Bs[k * 68 + cc] = (c0 + cc < g.ncols) ? wp[0] : 0.f; Bs[k * 68 + cc + 1] = (c0 + cc + 1 < g.ncols) ? wp[1] : 0.f; }
            __syncthreads();
#pragma unroll
            for (int kk = 0; kk < 16; ++kk) {
                const f32x4 a = *(const f32x4*)&As[kk * 132 + ty * 4]; const f32x4 b = *(const f32x4*)&Bs[kk * 68 + tx * 4];
#pragma unroll
                for (int i = 0; i < 4; ++i)
#pragma unroll
                    for (int j = 0; j < 4; ++j) acc[i][j] += a[i] * b[j];
            }
            __syncthreads();
        }
#pragma unroll
        for (int i = 0; i < 4; ++i)
#pragma unroll
            for (int j = 0; j < 4; ++j) { const int cc = c0 + tx * 4 + j; if (cc < g.ncols) g.T[(size_t)(r0 + ty * 4 + i) * g.ldt + g.tcol0 + cc] = acc[i][j]; }
    }
}

enum { E_QKVA, E_Z, E_AB, E_ROPE, E_V, E_QI, E_KIWI, E_SG, E_YA, E_YB, E_WO, E_SWIGLU, E_DOWN };
struct EP { int kind; int nrows; int rowg0; int p0; int layer; bf16_t* dst; const float* base; };
__device__ __forceinline__ void epi_phase(const Ctx& c, const EP& e) {
    const float* T = (const float*)(c.R + R_TMP);
    const int gt = blockIdx.x * blockDim.x + otid(), nt = gridDim.x * blockDim.x;
    int W;
    switch (e.kind) { case E_QKVA: case E_Z: case E_V: case E_SG: case E_YA: case E_YB: case E_WO: case E_DOWN: W = 1024; break;
        case E_AB: W = 16; break; case E_ROPE: W = 512; break; case E_QI: W = 256; break; case E_KIWI: W = 40; break; default: W = 256; break; }
    const long total = (long)e.nrows * W;
    for (long idx = gt; idx < total; idx += nt) {
        const int r = (int)(idx / W), j = (int)(idx % W);
        const int rowg = e.rowg0 + r, rs = rowg % MS, pos = rowg % SEQ;
        const float* Tr = T + (size_t)r * 1024;
        switch (e.kind) {
        case E_QKVA: { const int col = e.p0 * 1024 + j; const bf16_t v = f2bf(Tr[j]); ((bf16_t*)(c.R + R_QKVA))[(size_t)rs * 3072 + col] = v;
                       if ((rs & 63) >= 61) ((bf16_t*)(c.R + R_HALO))[((size_t)(rs >> 6) * 3 + ((rs & 63) - 61)) * 3072 + col] = v; } break;
        case E_Z: ((bf16_t*)(c.R + R_ZS))[(size_t)rs * 1024 + j] = f2bf(siluf_(Tr[j])); break;
        case E_AB: { const int h = j & 7;
                     if (j < 8) ((float*)(c.R + R_GG))[rs * 8 + h] = -__expf(c.a_log[e.layer * 8 + h]) * softplusf_(Tr[j] + c.dt_bias[e.layer * 8 + h]);
                     else ((float*)(c.R + R_BETA))[rs * 8 + h] = sigmoidf_(Tr[j]); } break;
        case E_ROPE: { const int h = j >> 6, d = j & 63; const float x1 = Tr[h * 128 + d], x2 = Tr[h * 128 + 64 + d], cs = c.cosA[pos * 64 + d], sn = c.sinA[pos * 64 + d];
                       bf16_t* dst = e.dst + (size_t)rs * 1024 + h * 128 + d; dst[0] = f2bf(x1 * cs - x2 * sn); dst[64] = f2bf(x2 * cs + x1 * sn); } break;
        case E_V: e.dst[(size_t)rs * 1024 + j] = f2bf(Tr[j]); break;
        case E_QI: { const int h = j >> 5, d = j & 31; const float x1 = Tr[h * 64 + d], x2 = Tr[h * 64 + 32 + d], cs = c.cosI[pos * 32 + d], sn = c.sinI[pos * 32 + d];
                     bf16_t* dst = (bf16_t*)(c.R + R_QI) + (size_t)rs * 512 + h * 64 + d; dst[0] = f2bf(x1 * cs - x2 * sn); dst[32] = f2bf(x2 * cs + x1 * sn); } break;
        case E_KIWI: { if (j < 32) { const int d = j; const float x1 = Tr[d], x2 = Tr[32 + d], cs = c.cosI[pos * 32 + d], sn = c.sinI[pos * 32 + d];
                           bf16_t* dst = (bf16_t*)(c.R + R_KI) + (size_t)rs * 64 + d; dst[0] = f2bf((x1 * cs - x2 * sn) * 0.125f); dst[32] = f2bf((x2 * cs + x1 * sn) * 0.125f); }
                       else ((float*)(c.R + R_WI))[rs * 8 + (j - 32)] = Tr[64 + (j - 32)] * 0.35355339059327373f; } break;
        case E_SG: ((bf16_t*)(c.R + R_SG))[(size_t)rowg * 2048 + e.p0 * 1024 + j] = f2bf(sigmoidf_(Tr[j])); break;
        case E_YA: ((bf16_t*)(c.R + R_M1))[(size_t)rowg * 1024 + j] = f2bf(bf2f(((const bf16_t*)(c.R + R_SG))[(size_t)rowg * 2048 + j]) * Tr[j]); break;
        case E_YB: ((bf16_t*)(c.R + R_MG))[(size_t)rowg * 1024 + j] = f2bf(bf2f(((const bf16_t*)(c.R + R_M1))[(size_t)rowg * 1024 + j]) + bf2f(((const bf16_t*)(c.R + R_SG))[(size_t)rowg * 2048 + 1024 + j]) * Tr[j]); break;
        case E_WO: c.out[(size_t)rowg * 1024 + j] = e.base[(size_t)rowg * 1024 + j] + Tr[j]; break;
        case E_SWIGLU: ((bf16_t*)(c.R + R_ACT))[(size_t)rowg * FF + e.p0 * 256 + j] = f2bf(siluf_(Tr[j]) * Tr[256 + j]); break;
        case E_DOWN: c.out[(size_t)rowg * 1024 + j] += Tr[j]; break;
        }
    }
}

__device__ __forceinline__ void naive_conv(const Ctx& c, int layer) {
    bf16_t* Q = (bf16_t*)(c.R + R_QKVA); const bf16_t* H = (const bf16_t*)(c.R + R_HALO); const float* cw = c.conv_w + (size_t)layer * 4 * 3072;
    const int gt = blockIdx.x * blockDim.x + otid(), nt = gridDim.x * blockDim.x;
    for (int idx = gt; idx < (MS / 64) * 3072; idx += nt) {
        const int ch = idx % 3072, ck = idx / 3072;
        const float w0 = cw[ch], w1 = cw[3072 + ch], w2 = cw[2 * 3072 + ch], w3 = cw[3 * 3072 + ch];
        float x3 = 0.f, x2 = 0.f, x1 = 0.f;
        if ((ck * 64) % SEQ != 0) { const bf16_t* hp = H + (size_t)(ck - 1) * 3 * 3072 + ch; x3 = bf2f(hp[0]); x2 = bf2f(hp[3072]); x1 = bf2f(hp[2 * 3072]); }
        bf16_t* p = Q + (size_t)ck * 64 * 3072 + ch;
        for (int r = 0; r < 64; ++r) { const float xv = bf2f(p[(size_t)r * 3072]); const float y = w0 * x3 + w1 * x2 + w2 * x1 + w3 * xv; p[(size_t)r * 3072] = f2bf(siluf_(y)); x3 = x2; x2 = x1; x1 = xv; }
    }
}
__device__ __forceinline__ void naive_l2norm(const Ctx& c) {
    bf16_t* Q = (bf16_t*)(c.R + R_QKVA);
    const int lane = otid() & 63, gw = (blockIdx.x * blockDim.x + otid()) >> 6, nw = (gridDim.x * blockDim.x) >> 6;
    for (int t = gw; t < MS * 16; t += nw) {
        const int r = t >> 4, hh = t & 15;
        unsigned* p = (unsigned*)(Q + (size_t)r * 3072 + hh * 128) + lane; const unsigned raw = *p;
        const float a = bf2f(raw & 0xffffu), b = bf2f(raw >> 16); const float rs = rsqrtf(wave_sum(a * a + b * b) + EPS);
        *p = f2bf(a * rs) | ((unsigned)f2bf(b * rs) << 16);
    }
}
__device__ __forceinline__ void naive_scan(const Ctx& c, unsigned char* smem) {
    const bf16_t* Q = (const bf16_t*)(c.R + R_QKVA); const float* GG = (const float*)(c.R + R_GG); const float* BT = (const float*)(c.R + R_BETA); float* O = (float*)(c.R + R_TMP);
    const int lane = otid() & 63, wv = otid() >> 6, gw = blockIdx.x * 8 + wv, nw = gridDim.x * 8;
    float* kL = (float*)smem + wv * 4096; float* qL = kL + 2048;
    const int dq = lane >> 4, el = lane & 15;
    for (int task = gw; task < BPS * 8 * 8; task += nw) {
        const int eb = task & 7, h = (task >> 3) & 7, bl = task >> 6, e = eb * 16 + el;
        float S[32];
#pragma unroll
        for (int i = 0; i < 32; ++i) S[i] = 0.f;
        for (int t0 = 0; t0 < SEQ; t0 += 16) {
            for (int tk = 0; tk < 16; ++tk) { const size_t row = (size_t)bl * SEQ + t0 + tk;
                const unsigned qr = *((const unsigned*)(Q + row * 3072 + h * 128) + lane), kr = *((const unsigned*)(Q + row * 3072 + 1024 + h * 128) + lane);
                qL[tk * 128 + lane * 2] = bf2f(qr & 0xffffu); qL[tk * 128 + lane * 2 + 1] = bf2f(qr >> 16); kL[tk * 128 + lane * 2] = bf2f(kr & 0xffffu); kL[tk * 128 + lane * 2 + 1] = bf2f(kr >> 16); }
            __builtin_amdgcn_s_waitcnt(0); __builtin_amdgcn_wave_barrier();
            for (int tk = 0; tk < 16; ++tk) { const size_t row = (size_t)bl * SEQ + t0 + tk;
                const float eg = __expf(GG[row * 8 + h]), bt = BT[row * 8 + h], v = bf2f(Q[row * 3072 + 2048 + h * 128 + e]);
                const float* kp = kL + tk * 128 + dq * 32; const float* qp = qL + tk * 128 + dq * 32;
                float ks = 0.f;
#pragma unroll
                for (int i = 0; i < 32; ++i) ks += kp[i] * S[i];
                ks += __shfl_xor(ks, 16); ks += __shfl_xor(ks, 32);
                const float cc = bt * (v - eg * ks); float o = 0.f;
#pragma unroll
                for (int i = 0; i < 32; ++i) { S[i] = eg * S[i] + kp[i] * cc; o += qp[i] * S[i]; }
                o += __shfl_xor(o, 16); o += __shfl_xor(o, 32);
                if (dq == 0) O[row * 1024 + h * 128 + e] = o * 0.08838834764831845f;
            }
            __builtin_amdgcn_s_waitcnt(0); __builtin_amdgcn_wave_barrier();
        }
    }
}
__device__ __forceinline__ void naive_gate(const Ctx& c, int layer, int split) {
    const float* O = (const float*)(c.R + R_TMP); const bf16_t* Z = (const bf16_t*)(c.R + R_ZS); const float* gn = c.gdn_norm + layer * 128;
    const int lane = otid() & 63, gw = (blockIdx.x * blockDim.x + otid()) >> 6, nw = (gridDim.x * blockDim.x) >> 6;
    for (int t = gw; t < MS * 8; t += nw) {
        const int r = t >> 3, h = t & 7; const size_t off = (size_t)r * 1024 + h * 128 + lane * 2;
        const float a = O[off], b = O[off + 1]; const float rs = rsqrtf(wave_sum(a * a + b * b) * (1.f / 128.f) + EPS);
        const unsigned z = *(const unsigned*)(Z + off);
        *(unsigned*)(c.OA + (size_t)split * MS * 1024 + off) = f2bf(a * rs * gn[lane * 2] * bf2f(z & 0xffffu)) | ((unsigned)f2bf(b * rs * gn[lane * 2 + 1] * bf2f(z >> 16)) << 16);
    }
}

__device__ __forceinline__ void naive_dsa(const Ctx& c, int split, unsigned char* smem) {
    const bf16_t* QB = (const bf16_t*)(c.R + R_QB); const bf16_t* KB = (const bf16_t*)(c.R + R_KB); const bf16_t* VB = (const bf16_t*)(c.R + R_VB);
    const bf16_t* QI = (const bf16_t*)(c.R + R_QI); const bf16_t* KI = (const bf16_t*)(c.R + R_KI); const float* WI = (const float*)(c.R + R_WI);
    float* qi = (float*)smem; float* qf = qi + 512; float* sc = qf + 1024; float* scores = sc + 2048; unsigned* sel = (unsigned*)(scores + 4096); float* wi = (float*)(sel + 272); unsigned* cnt = (unsigned*)(wi + 8);
    const int tid = otid(), lane = tid & 63, wv = tid >> 6;
    for (int row = blockIdx.x; row < MS; row += gridDim.x) {
        const int t = row % SEQ, rb = row - t, n = t + 1;
        __syncthreads();
        qi[tid] = bf2f(QI[(size_t)row * 512 + tid]); qf[tid] = bf2f(QB[(size_t)row * 1024 + tid]); qf[tid + 512] = bf2f(QB[(size_t)row * 1024 + 512 + tid]);
        if (tid < 8) wi[tid] = WI[row * 8 + tid];
        if (tid == 0) { cnt[0] = 0; cnt[1] = 0; cnt[2] = 0; cnt[3] = 0; }
        __syncthreads();
        for (int s = tid; s < n; s += 512) {
            const uint4* kp = (const uint4*)(KI + (size_t)(rb + s) * 64);
            float acc = 0.f;
#pragma unroll 1
            for (int h = 0; h < 8; ++h) { float d = 0.f;
#pragma unroll 2
                for (int i = 0; i < 8; ++i) { const uint4 w = kp[i]; const float* qp = qi + h * 64 + i * 8;
                    d += qp[0] * bf2f(w.x & 0xffffu) + qp[1] * bf2f(w.x >> 16) + qp[2] * bf2f(w.y & 0xffffu) + qp[3] * bf2f(w.y >> 16)
                       + qp[4] * bf2f(w.z & 0xffffu) + qp[5] * bf2f(w.z >> 16) + qp[6] * bf2f(w.w & 0xffffu) + qp[7] * bf2f(w.w >> 16); }
                acc += wi[h] * fmaxf(d, 0.f); }
            scores[s] = acc + 0.f;
        }
        __syncthreads();
        int nsel;
        if (n <= TOPK) { for (int s = tid; s < n; s += 512) sel[s] = s; nsel = n; }
        else {
            unsigned T = 0;
            for (int bit = 31; bit >= 0; --bit) {
                const unsigned cand = T | (1u << bit); unsigned my = 0;
                for (int s = tid; s < n; s += 512) { unsigned u = __float_as_uint(scores[s]); u = (u & 0x80000000u) ? ~u : (u | 0x80000000u); my += (u >= cand) ? 1u : 0u; }
                my = (unsigned)wave_sum((float)my);
                if (lane == 0) atomicAdd(&cnt[1], my);
                __syncthreads();
                const unsigned tot = cnt[1];
                __syncthreads();
                if (tid == 0) cnt[1] = 0;
                if (tot >= (unsigned)TOPK) T = cand;
                __syncthreads();
            }
            unsigned mgt = 0, meq = 0;
            for (int s = tid; s < n; s += 512) { unsigned u = __float_as_uint(scores[s]); u = (u & 0x80000000u) ? ~u : (u | 0x80000000u); mgt += (u > T); meq += (u == T); }
            mgt = (unsigned)wave_sum((float)mgt); meq = (unsigned)wave_sum((float)meq);
            if (lane == 0) { atomicAdd(&cnt[2], mgt); atomicAdd(&cnt[3], meq); }
            __syncthreads();
            const unsigned cgt = cnt[2], ceq = cnt[3], need = TOPK - cgt;
            unsigned base = 0, eqbase = 0;
            for (int s0 = 0; s0 < n; s0 += 512) {
                const int s = s0 + tid; unsigned u = 0; if (s < n) { u = __float_as_uint(scores[s]); u = (u & 0x80000000u) ? ~u : (u | 0x80000000u); }
                const bool gt = (s < n) && (u > T), eq = (s < n) && (u == T);
                const unsigned long long bg = __ballot(gt), be = __ballot(eq), lm = (1ull << lane) - 1ull;
                if (lane == 0) { sel[256 + wv] = (unsigned)__popcll(bg); sel[264 + wv] = (unsigned)__popcll(be); }
                __syncthreads();
                unsigned pg = 0, pe = 0, tg = 0, te = 0;
                for (int w = 0; w < 8; ++w) { const unsigned a = sel[256 + w], e = sel[264 + w]; if (w < wv) { pg += a; pe += e; } tg += a; te += e; }
                const unsigned eqrank = eqbase + pe + (unsigned)__popcll(be & lm);
                const unsigned eqbefore = min(eqbase + pe + (unsigned)__popcll(be & lm), need);
                (void)eqbefore;
                const unsigned gtbefore = base + pg + (unsigned)__popcll(bg & lm);
                if (gt) sel[gtbefore + min(eqbase + pe + (unsigned)__popcll(be & lm), need)] = s;
                else if (eq && eqrank < need) sel[gtbefore + eqrank] = s;
                __syncthreads();
                base += tg; eqbase += te;
            }
            nsel = TOPK;
        }
        __syncthreads();
        for (int p = tid; p < 8 * TOPK; p += 512) { const int h = p >> 8, j = p & 255;
            if (j < nsel) { const uint4* kp = (const uint4*)(KB + (size_t)(rb + sel[j]) * 1024 + h * 128); const float* qp = qf + h * 128; float d = 0.f;
#pragma unroll 4
                for (int i = 0; i < 16; ++i) { const uint4 w = kp[i]; d += qp[i * 8] * bf2f(w.x & 0xffffu) + qp[i * 8 + 1] * bf2f(w.x >> 16) + qp[i * 8 + 2] * bf2f(w.y & 0xffffu) + qp[i * 8 + 3] * bf2f(w.y >> 16)
                        + qp[i * 8 + 4] * bf2f(w.z & 0xffffu) + qp[i * 8 + 5] * bf2f(w.z >> 16) + qp[i * 8 + 6] * bf2f(w.w & 0xffffu) + qp[i * 8 + 7] * bf2f(w.w >> 16); }
                sc[h * 256 + j] = d * 0.08838834764831845f; } }
        __syncthreads();
        { float* sp = sc + wv * 256; float mx = -3.0e38f; for (int j = lane; j < nsel; j += 64) mx = fmaxf(mx, sp[j]); mx = wave_max(mx);
          float sm = 0.f; for (int j = lane; j < nsel; j += 64) { const float pz = __expf(sp[j] - mx); sp[j] = pz; sm += pz; } sm = wave_sum(sm); const float inv = 1.f / sm;
          for (int j = lane; j < nsel; j += 64) sp[j] *= inv; }
        __syncthreads();
        { const int o = tid * 2, h = o >> 7; const float* sp = sc + h * 256; float a0 = 0.f, a1 = 0.f;
          for (int j = 0; j < nsel; ++j) { const unsigned w = *(const unsigned*)(VB + (size_t)(rb + sel[j]) * 1024 + o); const float pz = sp[j]; a0 += pz * bf2f(w & 0xffffu); a1 += pz * bf2f(w >> 16); }
          *(unsigned*)(c.AT + ((size_t)split * MS + row) * 1024 + o) = f2bf(a0) | ((unsigned)f2bf(a1) << 16); }
    }
}

namespace pg8 {
#define PG8_LAS __attribute__((address_space(3)))
typedef unsigned short bf16_t;
typedef short bf16x8 __attribute__((ext_vector_type(8)));
typedef float f32x4 __attribute__((ext_vector_type(4)));
typedef unsigned u32x4 __attribute__((ext_vector_type(4)));
constexpr int BM = 256, BK = 64, HALF = 128, HTB = HALF * BK * 2  , STAGE_BYTES = 8 * HTB, NXCD = 8, WGM = 8;

__host__ __device__ __forceinline__ int lds_byte(int r, int c) { const int st = (r >> 4) * 2 + (c >> 5), rr = r & 15, cc = c & 31, ob = rr * 64 + cc * 2; return st * 1024 + (ob ^ (((ob >> 9) & 1) << 5)); }
__host__ __device__ __forceinline__ void stage_rc(int b, int& R, int& C) { const int st = b / 1024, sb = b % 1024, swz = sb ^ (((sb >> 9) & 1) << 5); R = (st >> 1) * 16 + swz / 64; C = (st & 1) * 32 + (swz % 64) / 2; }
__host__ __device__ __forceinline__ int perm32(int rho) { const int n = rho >> 4, i = rho & 15; return 8 * (i >> 2) + 4 * n + (i & 3); }

struct Unit { int pm, pn; };
struct Gemm { const bf16_t* A; const bf16_t* Bt; int M, N, K; };

struct StaticOrder {
    int nM, nN, nwg, G, c;
    __host__ __device__ void init(int M, int N, int G_, int c_) { nM = M / BM; nN = N / BM; nwg = nM * nN; G = G_; c = c_; }
    __host__ __device__ bool next(int i, Unit& u) const {
        const long L = (long)i * G + c; if (L >= nwg) return false;
        int wgid = (int)L; { const int q = nwg / NXCD, r = nwg % NXCD, xcd = wgid % NXCD, off = wgid / NXCD; wgid = (xcd < r ? xcd * (q + 1) : r * (q + 1) + (xcd - r) * q) + off; }
        const int nig = WGM * nN, gid = wgid / nig, fm = gid * WGM, gsz = (nM - fm) < WGM ? (nM - fm) : WGM;
        u.pm = fm + ((wgid % nig) % gsz); u.pn = (wgid % nig) / gsz; return true;
    }
    __device__ __forceinline__ void a_ready(const Unit&) const {}
    __device__ __forceinline__ void done(const Unit&) const {}
};


__device__ __forceinline__ unsigned cvt_pk_bf16(float lo, float hi) { unsigned r; asm volatile("v_cvt_pk_bf16_f32 %0, %1, %2" : "=v"(r) : "v"(lo), "v"(hi)); return r; }

template <class Epi, class Sched, bool ALIGN_EPI = false, bool SP2 = false>
__device__ __forceinline__ void gemm_phase(PG8_LAS unsigned char* lds, const Gemm g, const Sched& S, const Epi& E) {
    const int tid = otid(), wid = __builtin_amdgcn_readfirstlane(tid >> 6), lane = tid & 63, wr = wid >> 2, wc = wid & 3, fr = lane & 15, fq = lane >> 4;
    const int K = g.K, nt = K / BK;
    unsigned voffA[2], voffB[2];
#pragma unroll
    for (int i = 0; i < 2; ++i) { int R, C; stage_rc(tid * 16 + i * 8192, R, C); const int Rb = Epi::PERM ? ((R & ~31) + perm32(R & 31)) : R;
        voffA[i] = (unsigned)(R * K + C) * 2u; voffB[i] = (unsigned)(Rb * K + C) * 2u; }
    const size_t kstep = (size_t)(BK * 2);
    const size_t hstep = (size_t)HALF * K * 2;
    const size_t tstep = 2 * hstep;
    const unsigned ldsw = (unsigned)wid * 1024u;
    const int aoff = lds_byte(wr * 64 + fr, fq * 8), boff = lds_byte(wc * 32 + fr, fq * 8);
#define PG8_SA(b, h) (((b) * 2 + (h)) * HTB)
#define PG8_SB(b, h) ((4 + (b) * 2 + (h)) * HTB)
#define PG8_STAGE(bufoff, gbase, voff) do { _Pragma("unroll") for (int _i = 0; _i < 2; ++_i) \
        __builtin_amdgcn_global_load_lds((const unsigned*)((const char*)(gbase) + (voff)[_i]), (PG8_LAS unsigned*)(lds + (bufoff) + ldsw + _i * 8192), 16, 0, 0); } while (0)
#define PG8_LDA(dst, b, h) do { _Pragma("unroll") for (int m = 0; m < 4; ++m) _Pragma("unroll") for (int k = 0; k < 2; ++k) dst[m][k] = *(const PG8_LAS bf16x8*)(lds + PG8_SA(b, h) + aoff + m * 2048 + k * 1024); } while (0)
#define PG8_LDB(dst, b, h) do { _Pragma("unroll") for (int n = 0; n < 2; ++n) _Pragma("unroll") for (int k = 0; k < 2; ++k) dst[n][k] = *(const PG8_LAS bf16x8*)(lds + PG8_SB(b, h) + boff + n * 2048 + k * 1024); } while (0)
#define PG8_MMA(ai, bj, At, Bt) do { __builtin_amdgcn_s_setprio(1); _Pragma("unroll") for (int m = 0; m < 4; ++m) _Pragma("unroll") for (int n = 0; n < 2; ++n) _Pragma("unroll") for (int k = 0; k < 2; ++k) \
        acc[ai][bj][m][n] = __builtin_amdgcn_mfma_f32_16x16x32_bf16(Bt[n][k], At[m][k], acc[ai][bj][m][n], 0, 0, 0); __builtin_amdgcn_s_setprio(0); } while (0)
#define PG8_WAIT_V(n) asm volatile("s_waitcnt vmcnt(" #n ")" ::: "memory")
#define PG8_WAIT_L(n) asm volatile("s_waitcnt lgkmcnt(" #n ")" ::: "memory")
#define PG8_BAR __builtin_amdgcn_s_barrier()
#define PG8_SCHED __builtin_amdgcn_sched_barrier(0)
    Unit cur, nxt; int ui = 0;
    if (!S.next(0, cur)) return;
    f32x4 acc[2][2][4][2];
#pragma unroll
    for (int a = 0; a < 2; ++a)
#pragma unroll
        for (int b = 0; b < 2; ++b)
#pragma unroll
            for (int m = 0; m < 4; ++m)
#pragma unroll
                for (int n = 0; n < 2; ++n) acc[a][b][m][n] = (f32x4){0.f, 0.f, 0.f, 0.f};
    bf16x8 At[4][2], B0[2][2], B1[2][2];
    const char* cA = (const char*)g.A + (size_t)cur.pm * tstep; const char* cB = (const char*)g.Bt + (size_t)cur.pn * tstep;
    S.a_ready(cur);
    if constexpr (SP2) {
        PG8_STAGE(PG8_SB(0, 0), cB, voffB); PG8_STAGE(PG8_SB(0, 1), cB + hstep, voffB); PG8_STAGE(PG8_SA(0, 0), cA, voffA); PG8_STAGE(PG8_SA(0, 1), cA + hstep, voffA);
        if (wr == 1) PG8_BAR;
        PG8_WAIT_V(2); PG8_BAR;
        PG8_STAGE(PG8_SB(1, 0), cB + kstep, voffB); PG8_STAGE(PG8_SA(1, 0), cA + kstep, voffA); PG8_STAGE(PG8_SB(1, 1), cB + hstep + kstep, voffB);
        PG8_WAIT_V(6); PG8_BAR;
    } else {
        PG8_STAGE(PG8_SB(0, 0), cB, voffB); PG8_STAGE(PG8_SA(0, 0), cA, voffA); PG8_STAGE(PG8_SB(0, 1), cB + hstep, voffB); PG8_STAGE(PG8_SA(0, 1), cA + hstep, voffA);
        if (wr == 1) PG8_BAR;
        PG8_WAIT_V(4); PG8_BAR;
        PG8_STAGE(PG8_SB(1, 0), cB + kstep, voffB); PG8_STAGE(PG8_SA(1, 0), cA + kstep, voffA); PG8_STAGE(PG8_SB(1, 1), cB + hstep + kstep, voffB);
        PG8_WAIT_V(6); PG8_BAR;
    }
    for (;;) {
        const bool has_next = S.next(ui + 1, nxt);
        const char* nA = has_next ? (const char*)g.A + (size_t)nxt.pm * tstep : cA; const char* nB = has_next ? (const char*)g.Bt + (size_t)nxt.pn * tstep : cB;
        for (int t = 0; t < nt; t += 2) {
            const bool last = (t == nt - 2);
            const char* a1 = cA + (size_t)(t + 1) * kstep;
            const char* a2 = last ? nA : cA + (size_t)(t + 2) * kstep; const char* b2 = last ? nB : cB + (size_t)(t + 2) * kstep;
            const char* a3 = a2 + kstep; const char* b3 = b2 + kstep;
            if (last && has_next) S.a_ready(nxt);
            if constexpr (SP2) {
            PG8_LDB(B0, 0, 0); PG8_LDB(B1, 0, 1); PG8_SCHED; PG8_LDA(At, 0, 0); PG8_STAGE(PG8_SA(1, 1), a1 + hstep, voffA);
            PG8_WAIT_V(8); PG8_WAIT_L(0); PG8_BAR; PG8_MMA(0, 0, At, B0); PG8_MMA(0, 1, At, B1); PG8_BAR; PG8_SCHED;
            PG8_LDA(At, 0, 1); PG8_STAGE(PG8_SB(0, 0), b2, voffB); PG8_STAGE(PG8_SB(0, 1), b2 + hstep, voffB); PG8_STAGE(PG8_SA(0, 0), a2, voffA);
            PG8_WAIT_V(8); PG8_WAIT_L(0); PG8_BAR; PG8_MMA(1, 0, At, B0); PG8_MMA(1, 1, At, B1); PG8_BAR; PG8_SCHED;
            PG8_LDB(B0, 1, 0); PG8_LDB(B1, 1, 1); PG8_SCHED; PG8_LDA(At, 1, 0); PG8_STAGE(PG8_SA(0, 1), a2 + hstep, voffA);
            PG8_WAIT_V(8); PG8_WAIT_L(0); PG8_BAR; PG8_MMA(0, 0, At, B0); PG8_MMA(0, 1, At, B1); PG8_BAR; PG8_SCHED;
            PG8_LDA(At, 1, 1); PG8_STAGE(PG8_SB(1, 0), b3, voffB); PG8_STAGE(PG8_SB(1, 1), b3 + hstep, voffB); PG8_STAGE(PG8_SA(1, 0), a3, voffA);
            PG8_WAIT_V(8); PG8_WAIT_L(0); PG8_BAR; PG8_MMA(1, 0, At, B0); PG8_MMA(1, 1, At, B1); PG8_BAR; PG8_SCHED;
            } else {
            PG8_LDB(B0, 0, 0); PG8_SCHED; PG8_LDA(At, 0, 0); PG8_STAGE(PG8_SA(1, 1), a1 + hstep, voffA);
            PG8_WAIT_L(8); PG8_BAR; PG8_WAIT_L(0); PG8_MMA(0, 0, At, B0); PG8_BAR; PG8_SCHED;
            PG8_LDB(B1, 0, 1); PG8_STAGE(PG8_SB(0, 0), b2, voffB);
            PG8_BAR; PG8_WAIT_L(0); PG8_MMA(0, 1, At, B1); PG8_BAR;
            PG8_LDA(At, 0, 1); PG8_STAGE(PG8_SA(0, 0), a2, voffA);
            PG8_BAR; PG8_WAIT_L(0); PG8_MMA(1, 0, At, B0); PG8_BAR; PG8_SCHED;
            PG8_STAGE(PG8_SB(0, 1), b2 + hstep, voffB);
            PG8_WAIT_V(6); PG8_BAR; PG8_MMA(1, 1, At, B1); PG8_BAR;
            PG8_LDB(B0, 1, 0); PG8_SCHED; PG8_LDA(At, 1, 0); PG8_STAGE(PG8_SA(0, 1), a2 + hstep, voffA);
            PG8_WAIT_L(8); PG8_BAR; PG8_WAIT_L(0); PG8_MMA(0, 0, At, B0); PG8_BAR; PG8_SCHED;
            PG8_LDB(B1, 1, 1); PG8_STAGE(PG8_SB(1, 0), b3, voffB);
            PG8_BAR; PG8_WAIT_L(0); PG8_MMA(0, 1, At, B1); PG8_BAR;
            PG8_LDA(At, 1, 1); PG8_STAGE(PG8_SA(1, 0), a3, voffA);
            PG8_BAR; PG8_WAIT_L(0); PG8_MMA(1, 0, At, B0); PG8_BAR; PG8_SCHED;
            PG8_STAGE(PG8_SB(1, 1), b3 + hstep, voffB);
            PG8_WAIT_V(6); PG8_BAR; PG8_MMA(1, 1, At, B1); PG8_BAR;
            }
        }
        if constexpr (ALIGN_EPI) { if (wr == 0) PG8_BAR; }
        if constexpr (!Epi::AFTER_DRAIN) { E(acc, cur, wr, wc, fr, fq); S.done(cur); }
        if (!has_next) break;
#pragma unroll
        for (int a = 0; a < 2; ++a)
#pragma unroll
            for (int b = 0; b < 2; ++b)
#pragma unroll
                for (int m = 0; m < 4; ++m)
#pragma unroll
                    for (int n = 0; n < 2; ++n) acc[a][b][m][n] = (f32x4){0.f, 0.f, 0.f, 0.f};
        cur = nxt; cA = nA; cB = nB; ++ui;
        if constexpr (ALIGN_EPI) { if (wr == 1) PG8_BAR; }
    }
    PG8_WAIT_V(0);
    if constexpr (!ALIGN_EPI) { if (wr == 0) PG8_BAR; }
    PG8_BAR;
    if constexpr (Epi::AFTER_DRAIN) { E.fused(acc, cur, wr, wc, fr, fq, lds, wid, lane); S.done(cur); }
#undef PG8_SA
#undef PG8_SB
#undef PG8_STAGE
#undef PG8_LDA
#undef PG8_LDB
#undef PG8_MMA
#undef PG8_WAIT_V
#undef PG8_WAIT_L
#undef PG8_BAR
#undef PG8_SCHED
}
}

#define STAGE_OPT_INPROJ 1
#define STAGE_OPT_GATES 1
#define STAGE_OPT_Y 1
#define STAGE_OPT_WO 1
#define STAGE_OPT_GU 1
#define STAGE_OPT_DN 1
constexpr bool ANY_OPT_GEMM = STAGE_OPT_INPROJ || STAGE_OPT_GATES || STAGE_OPT_Y || STAGE_OPT_WO || STAGE_OPT_GU || STAGE_OPT_DN;
constexpr int WIN_ROWS = 39 * 256;
constexpr size_t WT_IN = 0, WT_OG = WT_IN + (size_t)WIN_ROWS * 1024 * 2, WT_OD = WT_OG + 2 * MiB, WT_O = WT_OD + 2 * MiB, WT_GU = WT_O + 2 * MiB, WT_DN = WT_GU + (size_t)2 * FF * 1024 * 2, WT_END = WT_DN + (size_t)1024 * FF * 2;
static_assert(WT_END <= 42 * MiB, "weight region");
typedef unsigned u32x4 __attribute__((ext_vector_type(4)));
typedef unsigned u32x2 __attribute__((ext_vector_type(2)));
__device__ __forceinline__ unsigned pk2(float lo, float hi) { return pg8::cvt_pk_bf16(lo, hi); }
__device__ __forceinline__ u32x2 pk4(f32x4 v) { u32x2 w; w.x = pk2(v[0], v[1]); w.y = pk2(v[2], v[3]); return w; }
__device__ __forceinline__ u32x4 pk8(f32x4 a, f32x4 b) { u32x4 w; w.x = pk2(a[0], a[1]); w.y = pk2(a[2], a[3]); w.z = pk2(b[0], b[1]); w.w = pk2(b[2], b[3]); return w; }
__device__ __forceinline__ f32x4 unpk4lo(u32x4 w) { return (f32x4){bf2f(w.x & 0xffffu), bf2f(w.x >> 16), bf2f(w.y & 0xffffu), bf2f(w.y >> 16)}; }
__device__ __forceinline__ f32x4 unpk4hi(u32x4 w) { return (f32x4){bf2f(w.z & 0xffffu), bf2f(w.z >> 16), bf2f(w.w & 0xffffu), bf2f(w.w >> 16)}; }
__device__ __forceinline__ f32x4 sig4(f32x4 v) { return (f32x4){sigmoidf_(v[0]), sigmoidf_(v[1]), sigmoidf_(v[2]), sigmoidf_(v[3])}; }
__device__ __forceinline__ f32x4 silu4(f32x4 v) { return (f32x4){siluf_(v[0]), siluf_(v[1]), siluf_(v[2]), siluf_(v[3])}; }

__device__ __forceinline__ int rope_pos(int d, int half) { const int n = d / half, dl = d % half; return 32 * (dl >> 4) + 8 * ((dl >> 2) & 3) + 4 * n + (dl & 3); }
__device__ __forceinline__ int map_win(int n) {
    if (n < C_A) return n;
    if (n < C_B) return 30 * 256 + 72 + (n - C_A);
    if (n < C_QB) return 30 * 256 + 80 + (n - C_B);
    if (n < C_VB) { const int m = n - C_QB, hd = m >> 7, d = m & 127; return (16 + (hd >> 1)) * 256 + (hd & 1) * 128 + rope_pos(d, 64); }
    if (n < C_QI) return 24 * 256 + (n - C_VB);
    if (n < C_KI) { const int m = n - C_QI, hd = m >> 6, d = m & 63; return (28 + (hd >> 2)) * 256 + ((hd >> 1) & 1) * 128 + (hd & 1) * 64 + rope_pos(d, 32); }
    if (n < C_WI) return 30 * 256 + rope_pos(n - C_KI, 32);
    if (n < C_GA) return 30 * 256 + 64 + (n - C_WI);
    return 31 * 256 + (n - C_GA);
}
__device__ __forceinline__ int map_gu(int cidx) { const int nn = cidx >= FF ? 1 : 0, f = cidx - nn * FF; return 8 * (f >> 2) + 4 * nn + (f & 3); }
template <int MAPK> __device__ __forceinline__ void transpose_item(const float* W, int K, int N, bf16_t* WT, float* scr, int item, int lane) {
    const int nblk = (N + 31) / 32, kb = item / nblk, nb = item % nblk, k0 = 64 * kb, n0 = 32 * nb;
    const int nn = n0 + (lane & 31);
#pragma unroll 8
    for (int i = 0; i < 32; ++i) { const int kk = 2 * i + (lane >> 5); scr[kk * 33 + (lane & 31)] = nn < N ? W[(size_t)(k0 + kk) * N + nn] : 0.f; }
    asm volatile("s_waitcnt lgkmcnt(0)" ::: "memory");
    const int cch = lane & 7;
#pragma unroll
    for (int j = 0; j < 4; ++j) { const int n = (lane >> 3) + 8 * j;
        if (n0 + n < N) { const float* sp = scr + (8 * cch) * 33 + n; const int row = MAPK == 1 ? map_win(n0 + n) : (MAPK == 2 ? map_gu(n0 + n) : n0 + n);
            u32x4 o; o.x = pk2(sp[0], sp[33]); o.y = pk2(sp[2 * 33], sp[3 * 33]); o.z = pk2(sp[4 * 33], sp[5 * 33]); o.w = pk2(sp[6 * 33], sp[7 * 33]);
            *(u32x4*)(WT + (size_t)row * K + k0 + 8 * cch) = o; } }
    asm volatile("s_waitcnt lgkmcnt(0)" ::: "memory");
}
__device__ __forceinline__ void phase_convert_weights(const Ctx& c, int layer, unsigned char* smem) {
    const int lane = otid() & 63, wv = otid() >> 6, gw = blockIdx.x * 8 + wv, nw = gridDim.x * 8;
    float* scr = (float*)smem + wv * (64 * 33);
    unsigned char* wt = c.ws + WS_WT;
    constexpr int I_IN = 16 * ((INC + 31) / 32), I_SQ = 16 * 32, I_GU = 16 * (2 * FF / 32), I_DN = (FF / 64) * 32;
    for (int it = gw; it < I_IN + 3 * I_SQ + I_GU + I_DN; it += nw) {
        int r = it;
        if (r < I_IN) { transpose_item<1>(c.w_in + (size_t)layer * DM * INC, DM, INC, (bf16_t*)(wt + WT_IN), scr, r, lane); continue; } r -= I_IN;
        if (r < I_SQ) { transpose_item<0>(c.w_out_gdn + (size_t)layer * DM * DM, DM, DM, (bf16_t*)(wt + WT_OG), scr, r, lane); continue; } r -= I_SQ;
        if (r < I_SQ) { transpose_item<0>(c.w_out_dsa + (size_t)layer * DM * DM, DM, DM, (bf16_t*)(wt + WT_OD), scr, r, lane); continue; } r -= I_SQ;
        if (r < I_SQ) { transpose_item<0>(c.w_o + (size_t)layer * DM * DM, DM, DM, (bf16_t*)(wt + WT_O), scr, r, lane); continue; } r -= I_SQ;
        if (r < I_GU) { transpose_item<2>(c.w_gate_up + (size_t)layer * DM * 2 * FF, DM, 2 * FF, (bf16_t*)(wt + WT_GU), scr, r, lane); continue; } r -= I_GU;
        transpose_item<0>(c.w_down + (size_t)layer * FF * DM, FF, DM, (bf16_t*)(wt + WT_DN), scr, r, lane);
    }
}

#define EPI_ROWS(...) _Pragma("unroll") for (int ai = 0; ai < 2; ++ai) _Pragma("unroll") for (int m = 0; m < 4; ++m) { const int r = u.pm * 256 + ai * 128 + wr * 64 + m * 16 + fr; __VA_ARGS__ asm volatile("" ::: "memory"); }
struct EpiInProj {
    static constexpr bool PERM = true, AFTER_DRAIN = false;
    unsigned char* R; const float *cosA, *sinA, *cosI, *sinI, *a_log, *dt_bias;
    __device__ __forceinline__ void operator()(const f32x4 (&acc)[2][2][4][2], const pg8::Unit& u, int wr, int wc, int fr, int fq) const {
        asm volatile("" : "+v"(fr), "+v"(fq));
        const int pn = u.pn, cw = wc * 32 + 8 * fq;
        if (pn < 12) { bf16_t* Q = (bf16_t*)(R + R_QKVA); bf16_t* H = (bf16_t*)(R + R_HALO);
            EPI_ROWS(_Pragma("unroll") for (int bj = 0; bj < 2; ++bj) { const int col = pn * 256 + bj * 128 + cw; const u32x4 w = pk8(acc[ai][bj][m][0], acc[ai][bj][m][1]);
                *(u32x4*)(Q + (size_t)r * 3072 + col) = w; if (m == 3 && fr >= 13) *(u32x4*)(H + ((size_t)(r >> 6) * 3 + (fr - 13)) * 3072 + col) = w; }) }
        else if (pn < 16) { bf16_t* Z = (bf16_t*)(R + R_ZS);
            EPI_ROWS(_Pragma("unroll") for (int bj = 0; bj < 2; ++bj) { const int col = (pn - 12) * 256 + bj * 128 + cw; *(u32x4*)(Z + (size_t)r * 1024 + col) = pk8(silu4(acc[ai][bj][m][0]), silu4(acc[ai][bj][m][1])); }) }
        else if (pn < 24) { bf16_t* D = (bf16_t*)(R + ((pn - 16) >> 2 ? R_KB : R_QB)); const int dl = 16 * wc + 4 * fq;
            EPI_ROWS(const int pos = r % SEQ; const f32x4 cs = *(const f32x4*)(cosA + pos * 64 + dl), sn = *(const f32x4*)(sinA + pos * 64 + dl);
                _Pragma("unroll") for (int bj = 0; bj < 2; ++bj) { const int hd = ((pn - 16) & 3) * 2 + bj; const f32x4 x1 = acc[ai][bj][m][0], x2 = acc[ai][bj][m][1];
                    bf16_t* dp = D + (size_t)r * 1024 + hd * 128 + dl; *(u32x2*)dp = pk4(x1 * cs - x2 * sn); *(u32x2*)(dp + 64) = pk4(x2 * cs + x1 * sn); }) }
        else if (pn < 28) { bf16_t* V = (bf16_t*)(R + R_VB);
            EPI_ROWS(_Pragma("unroll") for (int bj = 0; bj < 2; ++bj) { const int col = (pn - 24) * 256 + bj * 128 + cw; *(u32x4*)(V + (size_t)r * 1024 + col) = pk8(acc[ai][bj][m][0], acc[ai][bj][m][1]); }) }
        else if (pn < 30) { bf16_t* QI = (bf16_t*)(R + R_QI); const int dl = 16 * (wc & 1) + 4 * fq;
            EPI_ROWS(const int pos = r % SEQ; const f32x4 cs = *(const f32x4*)(cosI + pos * 32 + dl), sn = *(const f32x4*)(sinI + pos * 32 + dl);
                _Pragma("unroll") for (int bj = 0; bj < 2; ++bj) { const int hd = (pn - 28) * 4 + bj * 2 + (wc >> 1); const f32x4 x1 = acc[ai][bj][m][0], x2 = acc[ai][bj][m][1];
                    bf16_t* dp = QI + (size_t)r * 512 + hd * 64 + dl; *(u32x2*)dp = pk4(x1 * cs - x2 * sn); *(u32x2*)(dp + 32) = pk4(x2 * cs + x1 * sn); }) }
        else {
            if (wc < 2) { bf16_t* KI = (bf16_t*)(R + R_KI); const int dl = 16 * wc + 4 * fq;
                EPI_ROWS(const int pos = r % SEQ; const f32x4 cs = *(const f32x4*)(cosI + pos * 32 + dl), sn = *(const f32x4*)(sinI + pos * 32 + dl);
                    const f32x4 x1 = acc[ai][0][m][0], x2 = acc[ai][0][m][1]; bf16_t* dp = KI + (size_t)r * 64 + dl;
                    *(u32x2*)dp = pk4((x1 * cs - x2 * sn) * 0.125f); *(u32x2*)(dp + 32) = pk4((x2 * cs + x1 * sn) * 0.125f);) }
            else if (wc == 2) {
                if (fq == 0) { float* WI = (float*)(R + R_WI); EPI_ROWS(*(f32x4*)(WI + r * 8) = acc[ai][0][m][0] * 0.35355339059327373f; *(f32x4*)(WI + r * 8 + 4) = acc[ai][0][m][1] * 0.35355339059327373f;) }
                else if (fq == 1) { float* GG = (float*)(R + R_GG);
                    EPI_ROWS(_Pragma("unroll") for (int n = 0; n < 2; ++n) { f32x4 o; _Pragma("unroll") for (int j = 0; j < 4; ++j) o[j] = -__expf(a_log[n * 4 + j]) * softplusf_(acc[ai][0][m][n][j] + dt_bias[n * 4 + j]); *(f32x4*)(GG + r * 8 + n * 4) = o; }) }
                else if (fq == 2) { float* BT = (float*)(R + R_BETA); EPI_ROWS(*(f32x4*)(BT + r * 8) = sig4(acc[ai][0][m][0]); *(f32x4*)(BT + r * 8 + 4) = sig4(acc[ai][0][m][1]);) }
            }
        }
    }
};
struct EpiGates {
    static constexpr bool PERM = true, AFTER_DRAIN = false; bf16_t* SG;
    __device__ __forceinline__ void operator()(const f32x4 (&acc)[2][2][4][2], const pg8::Unit& u, int wr, int wc, int fr, int fq) const {
        EPI_ROWS(_Pragma("unroll") for (int bj = 0; bj < 2; ++bj) { const int col = u.pn * 256 + bj * 128 + wc * 32 + 8 * fq; *(u32x4*)(SG + (size_t)r * 2048 + col) = pk8(sig4(acc[ai][bj][m][0]), sig4(acc[ai][bj][m][1])); })
    }
};
template <int WHICH> struct EpiY {
    static constexpr bool PERM = true, AFTER_DRAIN = false; const bf16_t* SG; bf16_t* MG;
    __device__ __forceinline__ void operator()(const f32x4 (&acc)[2][2][4][2], const pg8::Unit& u, int wr, int wc, int fr, int fq) const {
        EPI_ROWS(_Pragma("unroll") for (int bj = 0; bj < 2; ++bj) { const int col = u.pn * 256 + bj * 128 + wc * 32 + 8 * fq;
            const u32x4 g = *(const u32x4*)(SG + (size_t)r * 2048 + WHICH * 1024 + col); f32x4 lo = unpk4lo(g) * acc[ai][bj][m][0], hi = unpk4hi(g) * acc[ai][bj][m][1];
            if (WHICH == 1) { const u32x4 p = *(const u32x4*)(MG + (size_t)r * 1024 + col); lo += unpk4lo(p); hi += unpk4hi(p); }
            *(u32x4*)(MG + (size_t)r * 1024 + col) = pk8(lo, hi); })
    }
};
struct EpiResid {
    static constexpr bool PERM = true, AFTER_DRAIN = false; const float* base; float* out;
    __device__ __forceinline__ void operator()(const f32x4 (&acc)[2][2][4][2], const pg8::Unit& u, int wr, int wc, int fr, int fq) const {
        EPI_ROWS(_Pragma("unroll") for (int bj = 0; bj < 2; ++bj) { const size_t off = (size_t)r * 1024 + u.pn * 256 + bj * 128 + wc * 32 + 8 * fq;
            const f32x4 b0 = *(const f32x4*)(base + off), b1 = *(const f32x4*)(base + off + 4); *(f32x4*)(out + off) = b0 + acc[ai][bj][m][0]; *(f32x4*)(out + off + 4) = b1 + acc[ai][bj][m][1]; })
    }
};
struct EpiSwiglu {
    static constexpr bool PERM = true, AFTER_DRAIN = false; bf16_t* ACT;
    __device__ __forceinline__ void operator()(const f32x4 (&acc)[2][2][4][2], const pg8::Unit& u, int wr, int wc, int fr, int fq) const {
        EPI_ROWS(_Pragma("unroll") for (int bj = 0; bj < 2; ++bj) { const int f0 = u.pn * 128 + bj * 64 + wc * 16 + 4 * fq; *(u32x2*)(ACT + (size_t)r * FF + f0) = pk4(silu4(acc[ai][bj][m][0]) * acc[ai][bj][m][1]); })
    }
};

#define STAGE_OPT_GDN 1
typedef short bf16x8 __attribute__((ext_vector_type(8)));
typedef float f32x16 __attribute__((ext_vector_type(16)));
typedef float f32x2_t __attribute__((ext_vector_type(2)));
typedef __bf16 bf16x2_t __attribute__((ext_vector_type(2)));
__device__ __forceinline__ unsigned cvtpk_s(float lo, float hi) { f32x2_t v = {lo, hi}; bf16x2_t b = __builtin_convertvector(v, bf16x2_t); return __builtin_bit_cast(unsigned, b); }
__device__ __forceinline__ int crow(int r, int hi) { return (r & 3) + 8 * (r >> 2) + 4 * hi; }
#define MFMA32(a, b, c) __builtin_amdgcn_mfma_f32_32x32x16_bf16((a), (b), (c), 0, 0, 0)
__device__ __forceinline__ bf16x8 pack_step(const f32x16& x, int s) {
    u32x4 p; p.x = cvtpk_s(x[8 * s], x[8 * s + 1]); p.y = cvtpk_s(x[8 * s + 2], x[8 * s + 3]); p.z = cvtpk_s(x[8 * s + 4], x[8 * s + 5]); p.w = cvtpk_s(x[8 * s + 6], x[8 * s + 7]);
    return __builtin_bit_cast(bf16x8, p);
}
constexpr int BLOB_WF = 0, BLOB_QDF = 16384, BLOB_KDF = 32768, BLOB_A_BYTES = 49152, BLOB_QKF = 0, BLOB_UF = 8192, BLOB_B_BYTES = 24576;
constexpr size_t P2_BLOBB = 0, P2_GLAST = 24 * MiB, P2_MASK = 25 * MiB;
__device__ __forceinline__ unsigned char* vaddrA(unsigned char* qkva, int ck, int h, int v) { const int i = (v >> 8) & 63, part = v >> 14; return qkva + ((size_t)(ck * 64 + i) * 3072 + part * 1024 + h * 128) * 2 + (v & 255); }
__device__ __forceinline__ u32x4 frag_from_rows(const bf16_t* T, int ld, int it, int ks, int lane) {
    const int r = lane & 31, hh = lane >> 5; const bf16_t* p = T + (size_t)(32 * it + r) * ld + 32 * (ks >> 1) + 16 * (ks & 1) + 4 * hh;
    const u32x2 a = *(const u32x2*)p, b = *(const u32x2*)(p + 8); return (u32x4){a.x, a.y, b.x, b.y};
}

__device__ __forceinline__ void gdn_prep_unit(const Ctx& c, int layer, int unit, unsigned char* smem) {
    const int tid = otid(), lane = tid & 63, wv = tid >> 6;
    const int h = unit & 7, ck = unit >> 3;
    bf16_t* Q = (bf16_t*)(c.R + R_QKVA); const bf16_t* HL = (const bf16_t*)(c.R + R_HALO);
    const float* cw = c.conv_w + (size_t)layer * 4 * 3072;
    float* X = (float*)smem;
    float* rq = X + 64 * 388; float* rk = rq + 64; float* gam = rk + 64; float* eg = gam + 64; float* egl = eg + 64; float* bet = egl + 64; float* gg = bet + 64;
    bf16_t* KNb = (bf16_t*)(gg + 64); bf16_t* QNb = KNb + 64 * 136;
    float* AM = (float*)(QNb + 64 * 136);
    const int row0 = ck * 64;
    __syncthreads();
    for (int q = tid; q < 4 * 384; q += 512) {
        const int g = q / 384, ch = q - g * 384, part = ch >> 7, col = part * 1024 + h * 128 + (ch & 127);
        const float w0 = cw[col], w1 = cw[3072 + col], w2 = cw[2 * 3072 + col], w3 = cw[3 * 3072 + col];
        float x3, x2, x1;
        if (g == 0) { if ((row0 % SEQ) == 0) { x3 = 0.f; x2 = 0.f; x1 = 0.f; } else { const bf16_t* hp = HL + (size_t)(ck - 1) * 3 * 3072 + col; x3 = bf2f(hp[0]); x2 = bf2f(hp[3072]); x1 = bf2f(hp[2 * 3072]); } }
        else { const bf16_t* hp = Q + (size_t)(row0 + 16 * g - 3) * 3072 + col; x3 = bf2f(hp[0]); x2 = bf2f(hp[3072]); x1 = bf2f(hp[2 * 3072]); }
        const bf16_t* p = Q + (size_t)(row0 + 16 * g) * 3072 + col;
#pragma unroll 4
        for (int r = 0; r < 16; ++r) { const float xv = bf2f(p[(size_t)r * 3072]); X[(16 * g + r) * 388 + ch] = siluf_(w0 * x3 + w1 * x2 + w2 * x1 + w3 * xv); x3 = x2; x2 = x1; x1 = xv; }
    }
    if (tid < 64) { gg[tid] = ((const float*)(c.R + R_GG))[(row0 + tid) * 8 + h]; bet[tid] = ((const float*)(c.R + R_BETA))[(row0 + tid) * 8 + h]; }
    __syncthreads();
    for (int p = wv * 16; p < wv * 16 + 16; ++p) { const int which = p & 1, i = p >> 1; const f32x2_t v = *(const f32x2_t*)(X + i * 388 + which * 128 + lane * 2);
        const float rs = rsqrtf(wave_sum(v.x * v.x + v.y * v.y) + EPS); if (lane == 0) { if (which) rk[i] = rs; else rq[i] = rs; } }
    if (wv == 7) { float v = gg[lane];
#pragma unroll
        for (int o = 1; o < 64; o <<= 1) { const float t = __shfl_up(v, o); if (lane >= o) v += t; }
        const float gl = __shfl(v, 63); gam[lane] = v; eg[lane] = __expf(v); egl[lane] = __expf(gl - v);
        if (lane == 0) ((float*)(c.R + R_P2 + P2_GLAST))[ck * 8 + h] = __expf(gl); }
    __syncthreads();
    for (int q = tid; q < 64 * 64; q += 512) { const int i = q >> 6, d = (q & 63) * 2; const f32x2_t a = *(const f32x2_t*)(X + i * 388 + d), b = *(const f32x2_t*)(X + i * 388 + 128 + d);
        const float sq = rq[i] * 0.08838834764831845f, sk = rk[i];
        *(unsigned*)(QNb + i * 136 + d) = cvtpk_s(a.x * sq, a.y * sq); *(unsigned*)(KNb + i * 136 + d) = cvtpk_s(b.x * sk, b.y * sk); }
    __syncthreads();
    { const int prod = wv >> 2, ti = (wv >> 1) & 1, tj = wv & 1, r = lane & 31, hh = lane >> 5;
      const bf16_t* Ab = (prod ? QNb : KNb) + (32 * ti + r) * 136 + 8 * hh; const bf16_t* Bb = KNb + (32 * tj + r) * 136 + 8 * hh;
      f32x16 acc = {};
#pragma unroll
      for (int ks = 0; ks < 8; ++ks) acc = MFMA32(*(const bf16x8*)(Ab + 16 * ks), *(const bf16x8*)(Bb + 16 * ks), acc);
      const int jj = 32 * tj + r; const float gj = gam[jj];
#pragma unroll
      for (int rr = 0; rr < 16; ++rr) { const int i = 32 * ti + crow(rr, hh); const float dec = __expf(gam[i] - gj);
          if (prod == 0) AM[i * 68 + jj] = (jj < i) ? bet[i] * acc[rr] * dec : 0.f;
          else ((bf16_t*)((unsigned char*)(X + i * 388) + 528))[jj] = f2bf((jj <= i) ? acc[rr] * dec : 0.f); } }
    __syncthreads();
    unsigned char* Qb = (unsigned char*)Q; unsigned char* PB = c.R + R_P2 + P2_BLOBB + (size_t)(ck * 8 + h) * BLOB_B_BYTES;
    int zl = 0; asm volatile("" : "+v"(zl));
    if (wv < 4) {
        float xs[64];
        if (tid < 128) {
#pragma unroll
            for (int i = 0; i < 64; ++i) xs[i] = X[i * 388 + 256 + tid] * bet[i + zl]; }
        else {
#pragma unroll
            for (int i = 0; i < 64; ++i) xs[i] = bf2f(KNb[i * 136 + (tid - 128)]) * (bet[i + zl] * eg[i + zl]); }
#pragma unroll
        for (int i = 1; i < 64; ++i) { float a = xs[i];
#pragma unroll
            for (int j4 = 0; j4 < i; j4 += 4) { const f32x4 am = *(const f32x4*)(AM + i * 68 + j4 + zl);
                a -= am[0] * xs[j4]; if (j4 + 1 < i) a -= am[1] * xs[j4 + 1]; if (j4 + 2 < i) a -= am[2] * xs[j4 + 2]; if (j4 + 3 < i) a -= am[3] * xs[j4 + 3]; }
            xs[i] = a; }
#pragma unroll
        for (int i = 0; i < 64; ++i) ((bf16_t*)(X + i * 388))[tid] = f2bf(xs[i]);
    } else {
        const int t4 = tid - 256;
        for (int f = t4; f < 1024; f += 256) {
            const int ln = f & 63, ks = (f >> 6) & 7, it = f >> 9; const u32x4 w = frag_from_rows(QNb, 136, it, ks, ln); const float sc = eg[32 * it + (ln & 31)];
            const f32x4 lo = unpk4lo(w) * sc, hi = unpk4hi(w) * sc; *(u32x4*)vaddrA(Qb, ck, h, BLOB_QDF + f * 16) = pk8(lo, hi); }
        for (int f = t4; f < 1024; f += 256) {
            const int ln = f & 63, ks = (f >> 6) & 3, dt = f >> 8, r = ln & 31, hh = ln >> 5, d = 32 * dt + r, ib = 32 * (ks >> 1) + 16 * (ks & 1) + 4 * hh; float v[8];
#pragma unroll
            for (int j = 0; j < 8; ++j) { const int i = ib + 8 * (j >> 2) + (j & 3); v[j] = bf2f(KNb[i * 136 + d]) * egl[i]; }
            *(u32x4*)vaddrA(Qb, ck, h, BLOB_KDF + f * 16) = pk8((f32x4){v[0], v[1], v[2], v[3]}, (f32x4){v[4], v[5], v[6], v[7]}); }
        for (int f = t4; f < 512; f += 256) {
            const int ln = f & 63, ks = (f >> 6) & 3, it = f >> 8; *(u32x4*)(PB + BLOB_QKF + f * 16) = frag_from_rows((const bf16_t*)((const unsigned char*)X + 528), 776, it, ks, ln); }
    }
    __syncthreads();
    for (int f = tid; f < 1024; f += 512) { const int ln = f & 63, ks = (f >> 6) & 7, it = f >> 9; *(u32x4*)vaddrA(Qb, ck, h, BLOB_WF + f * 16) = frag_from_rows((const bf16_t*)X + 128, 776, it, ks, ln); }
    { const int ln = tid & 63, it = (tid >> 6) & 1, eb = tid >> 7, cc = ln & 31, hi = ln >> 5; unsigned wds[8];
#pragma unroll
      for (int rp = 0; rp < 8; ++rp) { const int i0 = 32 * it + crow(2 * rp, hi), i1 = 32 * it + crow(2 * rp + 1, hi);
          wds[rp] = (unsigned)((const bf16_t*)(X + i0 * 388))[32 * eb + cc] | ((unsigned)((const bf16_t*)(X + i1 * 388))[32 * eb + cc] << 16); }
      u32x4* dst = (u32x4*)(PB + BLOB_UF + ((eb * 2 + it) * 64 + ln) * 32); dst[0] = (u32x4){wds[0], wds[1], wds[2], wds[3]}; dst[1] = (u32x4){wds[4], wds[5], wds[6], wds[7]}; }
}

constexpr int SC_BUF = 57344, SC_OBUF = 2 * SC_BUF, SC_OLD = 136;
__device__ __forceinline__ void gdn_scan_unit(const Ctx& c, int layer, int split, int su, unsigned char* smem) {
    const int tid = otid(), lane = tid & 63, wv = __builtin_amdgcn_readfirstlane(tid >> 6);
    const int bl = su >> 3, h = su & 7, ck0 = bl * (SEQ / 64);
    unsigned char* Qb = c.R + R_QKVA; const unsigned char* PB0 = c.R + R_P2 + P2_BLOBB; const float* GL = (const float*)(c.R + R_P2 + P2_GLAST);
    const bf16_t* ZS = (const bf16_t*)(c.R + R_ZS); const float* gn = c.gdn_norm + layer * 128;
    __syncthreads();
#pragma unroll
    for (int q = 0; q < 7; ++q) { const int v = (q * 512 + tid) * 16; const unsigned char* src = q < 6 ? vaddrA(Qb, ck0, h, v) : PB0 + (size_t)(ck0 * 8 + h) * BLOB_B_BYTES + BLOB_QKF + (v - BLOB_A_BYTES);
        *(u32x4*)(smem + v) = *(const u32x4*)src; }
    f32x16 S[4] = {};
    u32x4 un[4];
    if (wv < 4) { const u32x4* up = (const u32x4*)(PB0 + (size_t)(ck0 * 8 + h) * BLOB_B_BYTES + BLOB_UF + (wv * 2 * 64 + lane) * 32); un[0] = up[0]; un[1] = up[1]; un[2] = up[128]; un[3] = up[129]; }
    __syncthreads();
    constexpr int NCH = SEQ / 64;
#pragma unroll 1
    for (int n = 0; n <= NCH; ++n) {
        const int ck = ck0 + n; unsigned char* buf = smem + (n & 1) * SC_BUF; bf16_t* ob = (bf16_t*)(smem + SC_OBUF) + (n & 1) * 64 * SC_OLD;
        if (wv < 4) {
          if (n < NCH) {
            int lane = tid & 63; asm volatile("" : "+v"(lane));
            const float gl = GL[ck * 8 + h];
            bf16x8 Sb[8];
#pragma unroll
            for (int t = 0; t < 4; ++t) { Sb[2 * t] = pack_step(S[t], 0); Sb[2 * t + 1] = pack_step(S[t], 1); }
            f32x16 vn[2], o[2];
#pragma unroll
            for (int it = 0; it < 2; ++it) { f32x16 a = {};
#pragma unroll
                for (int ks = 0; ks < 8; ++ks) a = MFMA32(*(const bf16x8*)(buf + BLOB_WF + ((it * 8 + ks) * 64 + lane) * 16), Sb[ks], a);
                const u32x4 u0 = un[2 * it], u1 = un[2 * it + 1];
                const unsigned uw[8] = {u0.x, u0.y, u0.z, u0.w, u1.x, u1.y, u1.z, u1.w};
#pragma unroll
                for (int r = 0; r < 16; ++r) vn[it][r] = bf2f((r & 1) ? (uw[r >> 1] >> 16) : (uw[r >> 1] & 0xffffu)) - a[r];
                __builtin_amdgcn_sched_barrier(0); }
            if (n + 1 < NCH) { const u32x4* up = (const u32x4*)(PB0 + (size_t)((ck + 1) * 8 + h) * BLOB_B_BYTES + BLOB_UF + (wv * 2 * 64 + lane) * 32); un[0] = up[0]; un[1] = up[1]; un[2] = up[128]; un[3] = up[129]; }
#pragma unroll
            for (int it = 0; it < 2; ++it) { f32x16 b = {};
#pragma unroll
                for (int ks = 0; ks < 8; ++ks) b = MFMA32(*(const bf16x8*)(buf + BLOB_QDF + ((it * 8 + ks) * 64 + lane) * 16), Sb[ks], b);
                o[it] = b; __builtin_amdgcn_sched_barrier(0); }
            bf16x8 vb[4];
#pragma unroll
            for (int it = 0; it < 2; ++it) { vb[2 * it] = pack_step(vn[it], 0); vb[2 * it + 1] = pack_step(vn[it], 1); }
#pragma unroll
            for (int it = 0; it < 2; ++it)
#pragma unroll
                for (int ks = 0; ks < 4; ++ks) o[it] = MFMA32(*(const bf16x8*)(buf + BLOB_A_BYTES + BLOB_QKF + ((it * 4 + ks) * 64 + lane) * 16), vb[ks], o[it]);
            __builtin_amdgcn_sched_barrier(0);
#pragma unroll
            for (int t = 0; t < 4; ++t) { S[t] = S[t] * gl;
#pragma unroll
                for (int ks = 0; ks < 4; ++ks) S[t] = MFMA32(*(const bf16x8*)(buf + BLOB_KDF + ((t * 4 + ks) * 64 + lane) * 16), vb[ks], S[t]);
                __builtin_amdgcn_sched_barrier(0); }
            { const int cc = lane & 31, hi = lane >> 5;
#pragma unroll
              for (int it = 0; it < 2; ++it)
#pragma unroll
                  for (int r = 0; r < 16; ++r) ob[(32 * it + crow(r, hi)) * SC_OLD + 32 * wv + cc] = f2bf(o[it][r]); }
          }
        } else {
            int t4 = tid - 256; asm volatile("" : "+v"(t4));
            if (n + 1 < NCH) {
                const unsigned char* pa = Qb + ((size_t)((ck + 1) * 64 + (t4 >> 4)) * 3072 + h * 128) * 2 + (t4 & 15) * 16;
                const unsigned char* pb = PB0 + (size_t)((ck + 1) * 8 + h) * BLOB_B_BYTES + BLOB_QKF + t4 * 16;
                PG8_LAS unsigned char* nb = (PG8_LAS unsigned char*)smem + ((n + 1) & 1) * SC_BUF + (wv - 4) * 1024;
#pragma unroll
                for (int q = 0; q < 12; ++q) __builtin_amdgcn_global_load_lds((const unsigned*)(pa + (size_t)(q & 3) * 16 * 6144 + (q >> 2) * 2048), (PG8_LAS unsigned*)(nb + q * 4096), 16, 0, 0);
                __builtin_amdgcn_global_load_lds((const unsigned*)pb, (PG8_LAS unsigned*)(nb + 12 * 4096), 16, 0, 0);
                __builtin_amdgcn_global_load_lds((const unsigned*)(pb + 4096), (PG8_LAS unsigned*)(nb + 13 * 4096), 16, 0, 0); }
            if (n > 0) {
                const bf16_t* po = (const bf16_t*)(smem + SC_OBUF) + ((n - 1) & 1) * 64 * SC_OLD; const int i = t4 >> 2, qc = (t4 & 3) * 32;
                const size_t rowl = (size_t)(ck - 1) * 64 + i; float ss = 0.f;
#pragma unroll
                for (int q = 0; q < 4; ++q) { const u32x4 w = *(const u32x4*)(po + i * SC_OLD + qc + 8 * q); const f32x4 a = unpk4lo(w), b = unpk4hi(w);
#pragma unroll
                    for (int j = 0; j < 4; ++j) ss += a[j] * a[j] + b[j] * b[j]; }
                ss += __shfl_xor(ss, 1); ss += __shfl_xor(ss, 2); const float rs = rsqrtf(ss * (1.f / 128.f) + EPS);
#pragma unroll
                for (int q = 0; q < 4; ++q) { const u32x4 w = *(const u32x4*)(po + i * SC_OLD + qc + 8 * q); const u32x4 z = *(const u32x4*)(ZS + rowl * 1024 + h * 128 + qc + 8 * q);
                    const f32x4 ga = *(const f32x4*)(gn + qc + 8 * q), gb = *(const f32x4*)(gn + qc + 8 * q + 4);
                    const f32x4 oa = unpk4lo(w) * rs * ga * unpk4lo(z), obv = unpk4hi(w) * rs * gb * unpk4hi(z);
                    *(u32x4*)(c.OA + ((size_t)split * MS + rowl) * 1024 + h * 128 + qc + 8 * q) = pk8(oa, obv); asm volatile("" ::: "memory"); } }
            asm volatile("s_waitcnt vmcnt(0)" ::: "memory");
        }
        __syncthreads();
    }
}
__device__ __forceinline__ void phase_gdn_prep(const Ctx& c, int layer, unsigned char* smem) { for (int u = blockIdx.x; u < (MS / 64) * 8; u += gridDim.x) gdn_prep_unit(c, layer, u, smem); }
__device__ __forceinline__ void phase_gdn_scan(const Ctx& c, int layer, int split, unsigned char* smem) { for (int u = blockIdx.x; u < BPS * 8; u += gridDim.x) gdn_scan_unit(c, layer, split, u, smem); }

#define STAGE_OPT_DSA 1
__device__ __forceinline__ unsigned fkey(float x) { const unsigned u = __float_as_uint(x); return (u & 0x80000000u) ? ~u : (u | 0x80000000u); }
__device__ __forceinline__ float fkey_inv(unsigned k) { return __uint_as_float((k & 0x80000000u) ? (k & 0x7fffffffu) : ~k); }
constexpr int SL_QIF = 0, SL_WIL = 16384, SL_ST = 16896, SL_HIST = 18432, SL_MWG = 34816, SL_MWE = 43008, SL_CAND = 51200;
__device__ __forceinline__ void dsa_select_unit(const Ctx& c, int unit, unsigned char* smem) {
    const int tid = otid(), lane = tid & 63, wv = __builtin_amdgcn_readfirstlane(tid >> 6), cc = lane & 31, hi = lane >> 5;
    const int bl = unit & (BPS - 1), qg = (SEQ / 16 - 1) - unit / BPS, t0 = 16 * qg, rb = bl * SEQ, row0 = rb + t0, nkt = (t0 + 47) >> 5;
    const bf16_t* QI = (const bf16_t*)(c.R + R_QI); const bf16_t* KI = (const bf16_t*)(c.R + R_KI); const float* WI = (const float*)(c.R + R_WI);
    float* WIL = (float*)(smem + SL_WIL); unsigned* ST = (unsigned*)(smem + SL_ST); float* STf = (float*)ST; unsigned* HIST = (unsigned*)(smem + SL_HIST);
    unsigned* MWG = (unsigned*)(smem + SL_MWG); unsigned* MWE = (unsigned*)(smem + SL_MWE); float* CAND = (float*)(smem + SL_CAND);
    const float NINF = -__builtin_inff();
    __syncthreads();
    for (int p = tid; p < 1024; p += 512) { const int f = p >> 6, ln = p & 63, rt = f >> 2, s = f & 3, r = ln & 31, hh = ln >> 5;
        *(u32x4*)(smem + SL_QIF + p * 16) = *(const u32x4*)(QI + (size_t)(row0 + 4 * rt + (r >> 3)) * 512 + (r & 7) * 64 + 16 * s + 8 * hh); }
    if (tid < 128) WIL[tid] = WI[(row0 + (tid >> 3)) * 8 + (tid & 7)];
    for (int p = tid; p < 4096; p += 512) MWG[p] = 0u;
    if (tid < 192) ST[tid] = (tid < 16) ? 0xffffffffu : 0u;
    __syncthreads();
    float sc[16][4][2];
#pragma unroll
    for (int ktl = 0; ktl < 16; ++ktl) {
        const int kt = wv + 8 * ktl;
        if (kt < nkt) {
            const bf16_t* kp = KI + (size_t)(rb + 32 * kt + cc) * 64 + 8 * hi;
            bf16x8 b[4];
#pragma unroll
            for (int s = 0; s < 4; ++s) b[s] = *(const bf16x8*)(kp + 16 * s);
            const int key = 32 * kt + cc;
#pragma unroll
            for (int rt = 0; rt < 4; ++rt) {
                f32x16 acc = {};
#pragma unroll
                for (int s = 0; s < 4; ++s) acc = MFMA32(*(const bf16x8*)(smem + SL_QIF + ((rt * 4 + s) * 64 + lane) * 16), b[s], acc);
                float p[4];
#pragma unroll
                for (int qq = 0; qq < 4; ++qq) { const f32x4 w4 = *(const f32x4*)(WIL + (4 * rt + qq) * 8 + 4 * hi);
                    p[qq] = w4[0] * fmaxf(acc[4 * qq], 0.f) + w4[1] * fmaxf(acc[4 * qq + 1], 0.f) + w4[2] * fmaxf(acc[4 * qq + 2], 0.f) + w4[3] * fmaxf(acc[4 * qq + 3], 0.f); }
                const auto r01 = __builtin_amdgcn_permlane32_swap(__float_as_uint(p[0]), __float_as_uint(p[1]), false, false);
                const auto r23 = __builtin_amdgcn_permlane32_swap(__float_as_uint(p[2]), __float_as_uint(p[3]), false, false);
                float s0 = __uint_as_float(r01[0]) + __uint_as_float(r01[1]) + 0.f, s1 = __uint_as_float(r23[0]) + __uint_as_float(r23[1]) + 0.f;
                if (key > t0 + 4 * rt + hi) s0 = NINF;
                if (key > t0 + 4 * rt + 2 + hi) s1 = NINF;
                sc[ktl][rt][0] = s0; sc[ktl][rt][1] = s1;
            }
        } else {
#pragma unroll
            for (int rt = 0; rt < 4; ++rt) { sc[ktl][rt][0] = NINF; sc[ktl][rt][1] = NINF; }
        }
    }
    if (t0 >= TOPK) {
        {
#pragma unroll
          for (int rt = 0; rt < 4; ++rt)
#pragma unroll
              for (int i = 0; i < 2; ++i) { float mn = __builtin_inff(), mx = NINF;
#pragma unroll
                  for (int ktl = 0; ktl < 16; ++ktl) { const float x = sc[ktl][rt][i]; mx = fmaxf(mx, x); mn = (x > NINF) ? fminf(mn, x) : mn; }
#pragma unroll
                  for (int o = 1; o < 32; o <<= 1) { mn = fminf(mn, __shfl_xor(mn, o)); mx = fmaxf(mx, __shfl_xor(mx, o)); }
                  if (cc == 0 && mx > NINF) { const int q = 4 * rt + 2 * i + hi; atomicMin(&ST[q], fkey(mn)); atomicMax(&ST[16 + q], fkey(mx)); } } }
        __syncthreads();
        if (tid < 16) { STf[32 + tid] = fkey_inv(ST[tid]); STf[48 + tid] = fkey_inv(ST[16 + tid]); ST[64 + tid] = TOPK; ST[96 + tid] = 0u; }
        __syncthreads();
#pragma unroll 1
        for (int level = 0; level < 12; ++level) {
            if (tid < 16 && ST[96 + tid] == 0u && STf[32 + tid] == STf[48 + tid]) { STf[80 + tid] = STf[32 + tid]; ST[96 + tid] = 1u; }
            for (int p = tid; p < 4096; p += 512) HIST[p] = 0u;
            if (tid == 0) ST[176] = 0u;
            if (tid < 16) { ST[144 + tid] = 0u; ST[tid] = 0xffffffffu; ST[16 + tid] = 0u; }
            __syncthreads();
#pragma unroll
            for (int rt = 0; rt < 4; ++rt)
#pragma unroll
                for (int i = 0; i < 2; ++i) { const int q = 4 * rt + 2 * i + hi;
                    if (ST[96 + q] == 0u) { const float lo = STf[32 + q], hv = STf[48 + q], scale = 256.f / (hv - lo);
#pragma unroll
                        for (int ktl = 0; ktl < 16; ++ktl) { float x = sc[ktl][rt][i]; asm volatile("" : "+v"(x));
                            if (x >= lo && x <= hv) { const int b = min(255, (int)((x - lo) * scale)); atomicAdd(&HIST[q * 256 + b], 1u); } } } }
            __syncthreads();
            { const int q = 2 * wv + hi;
              if (ST[96 + q] == 0u) { const unsigned krem = ST[64 + q]; unsigned loc[8]; unsigned lsum = 0;
#pragma unroll
                  for (int j = 0; j < 8; ++j) { loc[j] = HIST[q * 256 + 255 - 8 * cc - j]; lsum += loc[j]; }
                  unsigned incl = lsum;
#pragma unroll
                  for (int o = 1; o < 32; o <<= 1) { const unsigned t = __shfl_up(incl, o, 32); if (cc >= o) incl += t; }
                  const unsigned excl = incl - lsum;
                  if (excl < krem && krem <= incl) { unsigned cum = excl; int bs = 0; unsigned cn = 0; bool found = false;
#pragma unroll
                      for (int j = 0; j < 8; ++j) { if (!found) { if (cum + loc[j] >= krem) { bs = 255 - 8 * cc - j; cn = loc[j]; found = true; } else cum += loc[j]; } }
                      ST[112 + q] = (unsigned)bs; ST[64 + q] = krem - cum; ST[128 + q] = cn; } } }
            __syncthreads();
#pragma unroll
            for (int rt = 0; rt < 4; ++rt)
#pragma unroll
                for (int i = 0; i < 2; ++i) { const int q = 4 * rt + 2 * i + hi;
                    if (ST[96 + q] == 0u) { const float lo = STf[32 + q], hv = STf[48 + q], scale = 256.f / (hv - lo); const int bs = (int)ST[112 + q]; const bool small = ST[128 + q] <= 256u;
#pragma unroll
                        for (int ktl = 0; ktl < 16; ++ktl) { float x = sc[ktl][rt][i]; asm volatile("" : "+v"(x));
                            if (x >= lo && x <= hv && min(255, (int)((x - lo) * scale)) == bs) {
                                if (small) { const unsigned pos = atomicAdd(&ST[144 + q], 1u); CAND[q * 256 + pos] = x; }
                                else { atomicMin(&ST[q], fkey(x)); atomicMax(&ST[16 + q], fkey(x)); } } } } }
            __syncthreads();
            { const int q = 2 * wv + hi;
              if (ST[96 + q] == 0u) {
                  if (ST[128 + q] <= 256u) { const int cn = (int)ST[128 + q]; const unsigned want = ST[64 + q] - 1u;
                      for (int e = cc; e < cn; e += 32) { const float v = CAND[q * 256 + e]; unsigned rank = 0;
                          for (int j = 0; j < cn; ++j) { const float o = CAND[q * 256 + j]; rank += (o > v || (o == v && j < e)) ? 1u : 0u; }
                          if (rank == want) { STf[80 + q] = v; ST[96 + q] = 1u; } } }
                  else if (cc == 0) { STf[32 + q] = fkey_inv(ST[q]); STf[48 + q] = fkey_inv(ST[16 + q]); ST[176] = 1u; } } }
            __syncthreads();
            const unsigned act = ST[176];
            __syncthreads();
            if (act == 0u) break;
        }
    } else { if (tid < 16) STf[80 + tid] = NINF; }
    __syncthreads();
#pragma unroll
    for (int rt = 0; rt < 4; ++rt)
#pragma unroll
        for (int i = 0; i < 2; ++i) { const int q = 4 * rt + 2 * i + hi; const float T = STf[80 + q]; unsigned cg = 0;
#pragma unroll
            for (int ktl = 0; ktl < 16; ++ktl) { const float x = sc[ktl][rt][i]; const int kt = wv + 8 * ktl;
                const unsigned long long bg = __ballot(x > T), be = __ballot(x == T && T > NINF);
                if (kt < nkt && cc == 0) { const unsigned g = hi ? (unsigned)(bg >> 32) : (unsigned)bg, e = hi ? (unsigned)(be >> 32) : (unsigned)be; MWG[q * 128 + kt] = g; MWE[q * 128 + kt] = e; cg += __popc(g); } }
            if (cc == 0) atomicAdd(&ST[160 + q], cg); }
    __syncthreads();
    { const int q = 2 * wv + hi; const int need = TOPK - (int)ST[160 + q];
      u32x4 g = *(const u32x4*)(MWG + q * 128 + 4 * cc), e = *(const u32x4*)(MWE + q * 128 + 4 * cc);
      unsigned ew[4] = {e.x, e.y, e.z, e.w}; unsigned lsum = __popc(ew[0]) + __popc(ew[1]) + __popc(ew[2]) + __popc(ew[3]); unsigned incl = lsum;
#pragma unroll
      for (int o = 1; o < 32; o <<= 1) { const unsigned t = __shfl_up(incl, o, 32); if (cc >= o) incl += t; }
      int before = (int)(incl - lsum);
#pragma unroll
      for (int j = 0; j < 4; ++j) { const int pc = __popc(ew[j]); int allowed = need - before; allowed = allowed < 0 ? 0 : (allowed > pc ? pc : allowed);
          unsigned w = ew[j]; while (__popc(w) > allowed) w &= ~(0x80000000u >> __clz(w));
          ew[j] = w; before += pc; }
      *(u32x4*)((unsigned*)(c.R + R_P2 + P2_MASK) + (size_t)(row0 + q) * 128 + 4 * cc) = (u32x4){g.x | ew[0], g.y | ew[1], g.z | ew[2], g.w | ew[3]}; }
}
__device__ __forceinline__ void phase_dsa_select(const Ctx& c, unsigned char* smem) { for (int u = blockIdx.x; u < MS / 16; u += gridDim.x) dsa_select_unit(c, u, smem); }

typedef short s16x4 __attribute__((ext_vector_type(4)));
constexpr int AT_TILE = 16384, AT_K = 0, AT_V = 4 * AT_TILE, AT_WS = 8 * AT_TILE, AT_LDS = AT_WS + 8 * 64 * 4 * 2;
#define KSWZ(row, colB) ((row) * 256 + ((colB) ^ (((row) & 7) << 4)))
__device__ __forceinline__ int v_st(int k, int cidx) { const int kk = (k & ~0xC) | ((k & 4) << 1) | ((k & 8) >> 1); return ((kk >> 3) * 4 + (cidx >> 5)) * 512 + ((kk & 7) * 32 + (cidx & 31)) * 2; }
__device__ __forceinline__ int v_rd_base(int lane) { return ((lane & 3) << 3) | (((lane >> 2) & 3) << 6) | (((lane >> 4) & 1) << 5) | (((lane >> 5) & 1) << 8); }
constexpr int v_rd_off(int d0, int ks, int half) { return d0 * 512 + ks * 4096 + half * 2048; }
constexpr float AT_SCALE = 0.08838834764831845f, AT_THR = 8.f;
__device__ __forceinline__ unsigned cvtpk_a(float lo, float hi) { unsigned r; asm volatile("v_cvt_pk_bf16_f32 %0, %1, %2" : "=v"(r) : "v"(lo), "v"(hi)); return r; }
__device__ __forceinline__ void at_partialSM(f32x16& p0, f32x16& p1, float& m_reg, float& alpha) {
    float pmax = p0[0];
#pragma unroll
    for (int r = 1; r < 16; ++r) pmax = fmaxf(pmax, p0[r]);
#pragma unroll
    for (int r = 0; r < 16; ++r) pmax = fmaxf(pmax, p1[r]);
    { auto rr = __builtin_amdgcn_permlane32_swap(__float_as_uint(pmax), __float_as_uint(pmax), false, false); pmax = fmaxf(__uint_as_float(rr[0]), __uint_as_float(rr[1])); }
    constexpr float C2 = 1.4426950408889634f * AT_SCALE; float mn;
    if (__builtin_expect(__all((pmax - m_reg) * AT_SCALE <= AT_THR), 1)) { mn = m_reg; alpha = 1.f; }
    else { mn = fmaxf(m_reg, pmax); alpha = __builtin_amdgcn_exp2f((m_reg - mn) * C2); m_reg = mn; }
    const float mnL = -mn * C2;
#pragma unroll
    for (int r = 0; r < 16; ++r) { p0[r] = __builtin_amdgcn_exp2f(fmaf(p0[r], C2, mnL)); p1[r] = __builtin_amdgcn_exp2f(fmaf(p1[r], C2, mnL)); }
}
__device__ __forceinline__ void at_finishSM(const f32x16& p0, const f32x16& p1, float alpha, float& l_reg, bf16x8& pa0, bf16x8& pa1, bf16x8& pa2, bf16x8& pa3) {
    float ps = 0;
#pragma unroll
    for (int r = 0; r < 16; ++r) ps += p0[r];
#pragma unroll
    for (int r = 0; r < 16; ++r) ps += p1[r];
    { auto rr = __builtin_amdgcn_permlane32_swap(__float_as_uint(ps), __float_as_uint(ps), false, false); ps = __uint_as_float(rr[0]) + __uint_as_float(rr[1]); }
    l_reg = l_reg * alpha + ps;
#define AT_PK4(P, B_, OUT) do { unsigned a0 = cvtpk_a(P[B_+0], P[B_+1]), a1 = cvtpk_a(P[B_+2], P[B_+3]); unsigned b0 = cvtpk_a(P[B_+4], P[B_+5]), b1 = cvtpk_a(P[B_+6], P[B_+7]); \
        auto r0 = __builtin_amdgcn_permlane32_swap(a0, b0, false, false); auto r1 = __builtin_amdgcn_permlane32_swap(a1, b1, false, false); \
        u32x4 w = {r0[0], r1[0], r0[1], r1[1]}; OUT = __builtin_bit_cast(bf16x8, w); } while (0)
    AT_PK4(p0, 0, pa0); AT_PK4(p0, 8, pa1); AT_PK4(p1, 0, pa2); AT_PK4(p1, 8, pa3);
#undef AT_PK4
}
__device__ __forceinline__ void at_qkt(f32x16& p0, f32x16& p1, const unsigned char* Kt, int r32, int hi, const bf16x8* qr) {
    p0 = f32x16{}; p1 = f32x16{};
    const unsigned char* kb[4];
#pragma unroll
    for (int dd = 0; dd < 4; ++dd) kb[dd] = Kt + KSWZ(r32, (dd * 16 + hi * 8) * 2);
#pragma unroll
    for (int d0 = 0; d0 < 8; ++d0) { const unsigned char* a = kb[d0 & 3] + (d0 >> 2) * 128;
        const bf16x8 b0 = *reinterpret_cast<const bf16x8*>(a), b1 = *reinterpret_cast<const bf16x8*>(a + 32 * 256);
        p0 = MFMA32(b0, qr[d0], p0); p1 = MFMA32(b1, qr[d0], p1); }
}
template <int VOFF> __device__ __forceinline__ void at_pv(f32x16* o, int vb0, bf16x8 pa0, bf16x8 pa1, bf16x8 pa2, bf16x8 pa3) {
#define TRRD(dst, off) asm volatile("ds_read_b64_tr_b16 %0, %1 offset:%2" : "=&v"(dst) : "v"(vb0), "i"(off) : "memory")
#define PV_D0(d0) do { s16x4 l0, l1, l2, l3, h0, h1, h2, h3; constexpr int b_ = VOFF + v_rd_off(d0, 0, 0); \
        TRRD(l0, b_); TRRD(h0, b_ + 2048); TRRD(l1, b_ + 4096); TRRD(h1, b_ + 6144); TRRD(l2, b_ + 8192); TRRD(h2, b_ + 10240); TRRD(l3, b_ + 12288); TRRD(h3, b_ + 14336); \
        asm volatile("s_waitcnt lgkmcnt(0)" ::: "memory"); __builtin_amdgcn_sched_barrier(0); \
        o[d0] = MFMA32(pa0, ((bf16x8){l0[0], l0[1], l0[2], l0[3], h0[0], h0[1], h0[2], h0[3]}), o[d0]); \
        o[d0] = MFMA32(pa1, ((bf16x8){l1[0], l1[1], l1[2], l1[3], h1[0], h1[1], h1[2], h1[3]}), o[d0]); \
        o[d0] = MFMA32(pa2, ((bf16x8){l2[0], l2[1], l2[2], l2[3], h2[0], h2[1], h2[2], h2[3]}), o[d0]); \
        o[d0] = MFMA32(pa3, ((bf16x8){l3[0], l3[1], l3[2], l3[3], h3[0], h3[1], h3[2], h3[3]}), o[d0]); } while (0)
    PV_D0(0); PV_D0(1); PV_D0(2); PV_D0(3);
#undef PV_D0
#undef TRRD
}
__device__ __forceinline__ void dsa_attn_unit(const Ctx& c, int split, int unit, unsigned char* smem) {
    const int tid = otid(), lane = tid & 63, wv = __builtin_amdgcn_readfirstlane(tid >> 6), r32 = lane & 31, hi = lane >> 5, rg = wv & 3, kp = wv >> 2;
    const int bh = unit & (BPS * 8 - 1), qb = (SEQ / 128 - 1) - unit / (BPS * 8), bl = bh >> 3, h = bh & 7, rb = bl * SEQ, q0 = 128 * qb, nstep = qb + 1;
    const bf16_t* QB = (const bf16_t*)(c.R + R_QB); const bf16_t* KB = (const bf16_t*)(c.R + R_KB) + (size_t)rb * 1024 + h * 128; const bf16_t* VB = (const bf16_t*)(c.R + R_VB) + (size_t)rb * 1024 + h * 128;
    const unsigned* MK = (const unsigned*)(c.R + R_P2 + P2_MASK) + (size_t)(rb + q0 + 32 * rg + r32) * 128;
    float* ws = (float*)(smem + AT_WS) + wv * 128; float* li_l = ws; float* al_l = ws + 32;
    const int sr = tid >> 4, scol = (tid & 15) * 8, vst0 = v_st(sr, scol), vst1 = v_st(32 + sr, scol), kws = KSWZ(sr, scol * 2);
    const int vb0 = (int)(uintptr_t)(smem + AT_V) + kp * AT_TILE + v_rd_base(lane);
    bf16x8 qr[8];
    { const bf16_t* qp = QB + (size_t)(rb + q0 + 32 * rg + r32) * 1024 + h * 128 + hi * 8;
#pragma unroll
      for (int d0 = 0; d0 < 8; ++d0) qr[d0] = *(const bf16x8*)(qp + d0 * 16); }
    bf16x8 sk[4], sv[4];
#define AT_LOAD(j) do { const size_t o0 = (size_t)(128 * (j) + sr) * 1024 + scol; sk[0] = *(const bf16x8*)(KB + o0); sk[1] = *(const bf16x8*)(KB + o0 + 32 * 1024); sk[2] = *(const bf16x8*)(KB + o0 + 64 * 1024); sk[3] = *(const bf16x8*)(KB + o0 + 96 * 1024); \
        sv[0] = *(const bf16x8*)(VB + o0); sv[1] = *(const bf16x8*)(VB + o0 + 32 * 1024); sv[2] = *(const bf16x8*)(VB + o0 + 64 * 1024); sv[3] = *(const bf16x8*)(VB + o0 + 96 * 1024); } while (0)
#define AT_WRITE(bf) do { unsigned char* Kd = smem + AT_K + (bf) * 2 * AT_TILE; unsigned char* Vd = smem + AT_V + (bf) * 2 * AT_TILE; \
        *(bf16x8*)(Kd + kws) = sk[0]; *(bf16x8*)(Kd + kws + 32 * 256) = sk[1]; *(bf16x8*)(Kd + AT_TILE + kws) = sk[2]; *(bf16x8*)(Kd + AT_TILE + kws + 32 * 256) = sk[3]; \
        *(bf16x8*)(Vd + vst0) = sv[0]; *(bf16x8*)(Vd + vst1) = sv[1]; *(bf16x8*)(Vd + AT_TILE + vst0) = sv[2]; *(bf16x8*)(Vd + AT_TILE + vst1) = sv[3]; } while (0)
    __syncthreads();
    AT_LOAD(0); AT_WRITE(0);
    float m_reg = -1e30f, l_reg = 0.f; f32x16 o[4] = {};
    __syncthreads();
    const int lastrow = q0 + 32 * rg + 31; const float NINF = -__builtin_inff();
#define AT_STEP(j, BUF) do { \
        const int tt = 2 * (j) + kp; const bool act = 64 * tt <= lastrow; \
        uint2 mw = make_uint2(0u, 0u); if (act) mw = *(const uint2*)(MK + 2 * tt); \
        if ((j) + 1 < nstep) AT_LOAD((j) + 1); \
        if (act) { \
            const unsigned m0 = mw.x >> (4 * hi), m1 = mw.y >> (4 * hi); \
            f32x16 p0, p1; at_qkt(p0, p1, smem + AT_K + ((BUF) * 2 + kp) * AT_TILE, r32, hi, qr); \
            _Pragma("unroll") for (int r = 0; r < 16; ++r) { const unsigned bit = 1u << ((r & 3) + 8 * (r >> 2)); if (!(m0 & bit)) p0[r] = NINF; if (!(m1 & bit)) p1[r] = NINF; } \
            float alpha; at_partialSM(p0, p1, m_reg, alpha); \
            bf16x8 pa0, pa1, pa2, pa3; at_finishSM(p0, p1, alpha, l_reg, pa0, pa1, pa2, pa3); \
            if (__any(alpha < 1.f)) { if (hi == 0) al_l[r32] = alpha; asm volatile("s_waitcnt lgkmcnt(0)" ::: "memory"); \
                _Pragma("unroll") for (int d_ = 0; d_ < 4; ++d_) _Pragma("unroll") for (int r = 0; r < 16; ++r) o[d_][r] *= al_l[crow(r, hi)]; } \
            __builtin_amdgcn_sched_barrier(0); \
            at_pv<(BUF) * 2 * AT_TILE>(o, vb0, pa0, pa1, pa2, pa3); } \
        if ((j) + 1 < nstep) { asm volatile("s_waitcnt vmcnt(0)" ::: "memory"); AT_WRITE(1 - (BUF)); } \
        __syncthreads(); } while (0)
#pragma unroll 1
    for (int j = 0; j < nstep; j += 2) { AT_STEP(j, 0); if (j + 1 < nstep) AT_STEP(j + 1, 1); }
#undef AT_STEP
#undef AT_LOAD
#undef AT_WRITE
    float* mg = (float*)smem + (size_t)rg * (66 * 64);
    if (kp == 1) {
#pragma unroll
        for (int d0 = 0; d0 < 4; ++d0)
#pragma unroll
            for (int r = 0; r < 16; ++r) mg[(d0 * 16 + r) * 64 + lane] = o[d0][r];
        mg[64 * 64 + lane] = m_reg; mg[65 * 64 + lane] = l_reg; }
    __syncthreads();
    if (kp == 0) {
        constexpr float C2 = 1.4426950408889634f * AT_SCALE;
        const float m2 = mg[64 * 64 + lane], l2 = mg[65 * 64 + lane], mm = fmaxf(m_reg, m2);
        const float a1 = __builtin_amdgcn_exp2f((m_reg - mm) * C2), a2 = __builtin_amdgcn_exp2f((m2 - mm) * C2), lt = l_reg * a1 + l2 * a2;
        if (hi == 0) { li_l[r32] = __builtin_amdgcn_rcpf(lt); al_l[r32] = a1; al_l[32 + r32] = a2; }
        asm volatile("s_waitcnt lgkmcnt(0)" ::: "memory");
        bf16_t* Ow = c.AT + ((size_t)split * MS + rb + q0 + 32 * rg) * 1024 + h * 128;
#pragma unroll
        for (int r = 0; r < 16; ++r) { const int orow = crow(r, hi); const float f1 = al_l[orow] * li_l[orow], f2 = al_l[32 + orow] * li_l[orow];
#pragma unroll
            for (int d0 = 0; d0 < 4; ++d0) { const float v = o[d0][r] * f1 + mg[(d0 * 16 + r) * 64 + lane] * f2; const float vn = __shfl_xor(v, 1);
                if ((r32 & 1) == 0) *(unsigned*)(Ow + (size_t)orow * 1024 + d0 * 32 + r32) = cvtpk_s(v, vn); } } }
}

constexpr int LDS_QSLOT = LDS_BYTES - 16;
__device__ __forceinline__ int queue_next(unsigned* ctr, unsigned char* smem) {
    __syncthreads(); if (otid() == 0) *(volatile int*)(smem + LDS_QSLOT) = (int)atomicAdd(ctr, 1u); __syncthreads(); return *(volatile int*)(smem + LDS_QSLOT);
}
__device__ __forceinline__ void phase_prep_select(const Ctx& c, int layer, int split, unsigned char* smem) {
    unsigned* ctr = (unsigned*)(c.ws + WS_CTL) + 1024 + ((layer * NSPLIT + split) * 2 + 0) * 64;
    constexpr int NSEL = MS / 16, NPREP = (MS / 64) * 8;
    for (;;) { const int u = queue_next(ctr, smem); if (u >= NSEL + NPREP) break; if (u < NSEL) dsa_select_unit(c, u, smem); else gdn_prep_unit(c, layer, u - NSEL, smem); }
}
__device__ __forceinline__ void phase_scan_attn(const Ctx& c, int layer, int split, unsigned char* smem) {
    unsigned* ctr = (unsigned*)(c.ws + WS_CTL) + 1024 + ((layer * NSPLIT + split) * 2 + 1) * 64;
    constexpr int NSCAN = BPS * 8, NATT = BPS * 8 * (SEQ / 128);
    for (;;) { const int u = queue_next(ctr, smem); if (u >= NSCAN + NATT) break; if (u < NSCAN) gdn_scan_unit(c, layer, split, u, smem); else dsa_attn_unit(c, split, u - NSCAN, smem); }
}
#define LAS __attribute__((address_space(3)))
#define XB_TMO      128
#define XB_XCNT(j)  (256  + 64 * (j))
#define XB_XSUB(j)  (1280 + 64 * (j))
#define XB_XGEN(j)  (2304 + 64 * (j))
#define XB_TOP      3328
#define XB_TOPGEN   3392
#define XCD_BAR_WORDS 3456
#define XB_SPIN_CAP (1u << 18)

__device__ __forceinline__ unsigned xb_ld(unsigned* p)              { return __hip_atomic_load(p, __ATOMIC_RELAXED, __HIP_MEMORY_SCOPE_AGENT); }
__device__ __forceinline__ unsigned xb_add(unsigned* p, unsigned v) { return __hip_atomic_fetch_add(p, v, __ATOMIC_RELAXED, __HIP_MEMORY_SCOPE_AGENT); }
__device__ __forceinline__ unsigned xb_xcc_id() { return (unsigned)__builtin_amdgcn_s_getreg((3 << 11) | 20) & 0xFu; }
#define XB_SPIN(cond, bar) do { unsigned _sp = 0; while (cond) { __builtin_amdgcn_s_sleep(1); \
    if ((++_sp & 255u) == 0u) { if (xb_ld(&(bar)[XB_TMO])) break; if (_sp > XB_SPIN_CAP) { atomicAdd(&(bar)[XB_TMO], 1u); break; } } } } while (0)

struct XcdBarrier {
    unsigned* bar; unsigned x;
    volatile LAS unsigned* st;
};

__device__ __forceinline__ XcdBarrier xcd_barrier_post(unsigned* bar, volatile LAS unsigned* st) {
    XcdBarrier b; b.bar = bar; b.x = xb_xcc_id(); b.st = st;
    if (threadIdx.x == 0) (void)xb_add(&bar[XB_XCNT(b.x)], 1u);
    return b;
}
__device__ __forceinline__ void xcd_barrier_complete(unsigned* bar, unsigned x, unsigned& nloc, unsigned& nx) {
    const unsigned G = gridDim.x * gridDim.y * gridDim.z;
    unsigned sum, cnt, mine, sp = 0u;
    for (;;) {
        sum = 0u; cnt = 0u; mine = 0u;
#pragma unroll
        for (unsigned j = 0; j < 16; ++j) { const unsigned c = xb_ld(&bar[XB_XCNT(j)]); sum += c; cnt += (c > 0u) ? 1u : 0u; mine = (j == x) ? c : mine; }
        if (sum == G) break;
        __builtin_amdgcn_s_sleep(1);
        if ((++sp & 255u) == 0u) { if (xb_ld(&bar[XB_TMO])) break; if (sp > XB_SPIN_CAP) { atomicAdd(&bar[XB_TMO], 1u); break; } }
    }
    nloc = mine > 0u ? mine : 1u; nx = cnt > 0u ? cnt : 1u;
}

__device__ __forceinline__ void xcd_barrier(const XcdBarrier& b) {
    asm volatile("s_waitcnt vmcnt(0)" ::: "memory");
    __syncthreads();
    if (threadIdx.x == 0) {
        unsigned* bar = b.bar;
        __builtin_amdgcn_s_waitcnt(0);
        unsigned nloc = b.st[0], nx = b.st[1];
        if (nloc == 0u) { xcd_barrier_complete(bar, b.x, nloc, nx); b.st[0] = nloc; b.st[1] = nx; }
        const unsigned old = xb_add(&bar[XB_XSUB(b.x)], 1u);
        const unsigned gen = old / nloc;
        if (old + 1u == (gen + 1u) * nloc) {
            __builtin_amdgcn_fence(__ATOMIC_RELEASE, "agent");
            asm volatile("s_waitcnt vmcnt(0)" ::: "memory");
            const unsigned og = xb_add(&bar[XB_TOP], 1u);
            const unsigned tg = og / nx;
            if (og + 1u == (tg + 1u) * nx) xb_add(&bar[XB_TOPGEN], 1u);
            else XB_SPIN(xb_ld(&bar[XB_TOPGEN]) == tg, bar);
            __builtin_amdgcn_fence(__ATOMIC_ACQUIRE, "agent");
            xb_add(&bar[XB_XGEN(b.x)], 1u);
            asm volatile("s_waitcnt vmcnt(0)" ::: "memory");
        } else {
            XB_SPIN(xb_ld(&bar[XB_XGEN(b.x)]) == gen, bar);
            __builtin_amdgcn_fence(__ATOMIC_ACQUIRE, "agent");
            asm volatile("s_waitcnt vmcnt(0)" ::: "memory");
        }
    }
    __syncthreads();
}
typedef const __attribute__((address_space(4))) Args* KArgsP;
__device__ __forceinline__ Ctx make_ctx() {
    KArgsP a = (KArgsP)__builtin_amdgcn_kernarg_segment_ptr(); asm volatile("" : "+s"(a));
    Ctx c;
    c.x = a->in[0]; c.norm_mix = a->in[1]; c.w_in = a->in[2]; c.conv_w = a->in[3]; c.a_log = a->in[4]; c.dt_bias = a->in[5]; c.gdn_norm = a->in[6];
    c.w_out_gdn = a->in[7]; c.w_out_dsa = a->in[8]; c.w_o = a->in[9]; c.norm_ffn = a->in[10]; c.w_gate_up = a->in[11]; c.w_down = a->in[12]; c.norm_final = a->in[13];
    c.out = a->out; c.ws = a->ws; c.R = c.ws + WS_R;
    c.cosA = (float*)(c.ws + WS_TAB); c.sinA = c.cosA + SEQ * 64; c.cosI = c.sinA + SEQ * 64; c.sinI = c.cosI + SEQ * 32;
    c.XN = (bf16_t*)(c.ws + WS_XN); c.OA = (bf16_t*)(c.ws + WS_OA); c.AT = (bf16_t*)(c.ws + WS_AT);
    return c;
}
__global__ void __launch_bounds__(512, 2) fwd_kernel(Args a) {
    extern __shared__ __attribute__((aligned(16))) unsigned char smem[];
    cg::grid_group grid = cg::this_grid();
    PG8_LAS unsigned char* lds = (PG8_LAS unsigned char*)smem;
    volatile LAS unsigned* bst = (volatile LAS unsigned*)((LAS unsigned char*)smem + (LDS_BYTES - 32));
    if (otid() < 2) bst[otid()] = 0u;
    __syncthreads();
    XcdBarrier xbar = xcd_barrier_post((unsigned*)(a.ws + WS_CTL) + 4096, bst);
#define SYNC() xcd_barrier(xbar)
    { const Ctx c = make_ctx(); phase_tables(c); }
    if (ANY_OPT_GEMM) { const Ctx c = make_ctx(); phase_convert_weights(c, 0, smem); }
    { const Ctx c = make_ctx(); phase_rmsnorm(c.x, c.norm_mix, c.XN, nullptr); }
    grid.sync();
#pragma unroll 1
    for (int layer = 0; layer < DEPTH; ++layer) {
#pragma unroll 1
        for (int pc = 0; pc < 19; ++pc) {
            int st, split = 0;
            if (pc < 12) { split = pc / 6; st = pc % 6; } else st = pc - 6;
            if (STAGE_OPT_GDN && STAGE_OPT_DSA && (st == 2 || st == 4 || st == 5)) continue;
            int k0 = 0, k1 = 0;
            if (st == 0) { if (STAGE_OPT_INPROJ) { const Ctx c = make_ctx(); unsigned char* wt = c.ws + WS_WT; pg8::Gemm g{c.XN + (size_t)split * MS * DM, (const bf16_t*)(wt + WT_IN), MS, 31 * 256, DM}; pg8::StaticOrder S; S.init(MS, 31 * 256, gridDim.x, blockIdx.x);
                    EpiInProj E{c.R, c.cosA, c.sinA, c.cosI, c.sinI, c.a_log + layer * 8, c.dt_bias + layer * 8}; pg8::gemm_phase<EpiInProj, pg8::StaticOrder, true, true>(lds, g, S, E); }
                else { k0 = split * 10; k1 = k0 + 10; } }
            else if (st == 1) { const Ctx c = make_ctx(); if (STAGE_OPT_GDN && STAGE_OPT_DSA) phase_prep_select(c, layer, split, smem); else if (STAGE_OPT_GDN) phase_gdn_prep(c, layer, smem); else naive_conv(c, layer); }
            else if (st == 2) { if (!STAGE_OPT_GDN) { const Ctx c = make_ctx(); naive_l2norm(c); } }
            else if (st == 3) { const Ctx c = make_ctx(); if (STAGE_OPT_GDN && STAGE_OPT_DSA) phase_scan_attn(c, layer, split, smem); else if (STAGE_OPT_GDN) phase_gdn_scan(c, layer, split, smem); else naive_scan(c, smem); }
            else if (st == 4) { if (!STAGE_OPT_GDN) { const Ctx c = make_ctx(); naive_gate(c, layer, split); } }
            else if (st == 5) { if (!(STAGE_OPT_GDN && STAGE_OPT_DSA)) { const Ctx c = make_ctx(); naive_dsa(c, split, smem); } }
            else if (st == 6) { if (STAGE_OPT_GATES) { const Ctx c = make_ctx(); unsigned char* wt = c.ws + WS_WT; pg8::Gemm g{c.XN, (const bf16_t*)(wt + WT_IN) + (size_t)31 * 256 * DM, M, 2048, DM}; pg8::StaticOrder S; S.init(M, 2048, gridDim.x, blockIdx.x);
                    EpiGates E{(bf16_t*)(c.R + R_SG)}; pg8::gemm_phase<EpiGates, pg8::StaticOrder, true, true>(lds, g, S, E); }
                else { k0 = 20; k1 = 24; } }
            else if (st == 7) { if (STAGE_OPT_Y) { const Ctx c = make_ctx(); unsigned char* wt = c.ws + WS_WT; pg8::StaticOrder S; S.init(M, DM, gridDim.x, blockIdx.x);
                    { pg8::Gemm g{c.OA, (const bf16_t*)(wt + WT_OG), M, DM, DM}; EpiY<0> E{(const bf16_t*)(c.R + R_SG), (bf16_t*)(c.R + R_MG)}; pg8::gemm_phase<EpiY<0>, pg8::StaticOrder, false, true>(lds, g, S, E); }
                    { pg8::Gemm g{c.AT, (const bf16_t*)(wt + WT_OD), M, DM, DM}; EpiY<1> E{(const bf16_t*)(c.R + R_SG), (bf16_t*)(c.R + R_MG)}; pg8::gemm_phase<EpiY<1>, pg8::StaticOrder, false, true>(lds, g, S, E); } }
                else { k0 = 24; k1 = 28; } }
            else if (st == 8) { if (STAGE_OPT_WO) { const Ctx c = make_ctx(); unsigned char* wt = c.ws + WS_WT; pg8::Gemm g{(const bf16_t*)(c.R + R_MG), (const bf16_t*)(wt + WT_O), M, DM, DM}; pg8::StaticOrder S; S.init(M, DM, gridDim.x, blockIdx.x);
                    EpiResid E{layer == 0 ? c.x : c.out, c.out}; pg8::gemm_phase<EpiResid, pg8::StaticOrder, false, true>(lds, g, S, E); }
                else { k0 = 28; k1 = 30; } }
            else if (st == 9) { const Ctx c = make_ctx(); phase_rmsnorm(c.out, c.norm_ffn + layer * DM, c.XN, nullptr); }
            else if (st == 10) { if (STAGE_OPT_GU) { const Ctx c = make_ctx(); unsigned char* wt = c.ws + WS_WT; pg8::Gemm g{c.XN, (const bf16_t*)(wt + WT_GU), M, 2 * FF, DM}; pg8::StaticOrder S; S.init(M, 2 * FF, gridDim.x, blockIdx.x);
                    EpiSwiglu E{(bf16_t*)(c.R + R_ACT)}; pg8::gemm_phase<EpiSwiglu, pg8::StaticOrder, true, true>(lds, g, S, E); }
                else { k0 = 30; k1 = 52; } }
            else if (st == 11) { if (STAGE_OPT_DN) { const Ctx c = make_ctx(); unsigned char* wt = c.ws + WS_WT; pg8::Gemm g{(const bf16_t*)(c.R + R_ACT), (const bf16_t*)(wt + WT_DN), M, DM, FF}; pg8::StaticOrder S; S.init(M, DM, gridDim.x, blockIdx.x);
                    EpiResid E{c.out, c.out}; pg8::gemm_phase<EpiResid, pg8::StaticOrder, false, true>(lds, g, S, E); }
                else { k0 = 52; k1 = 54; } }
            else { const Ctx c = make_ctx(); if (layer + 1 < DEPTH) { phase_rmsnorm(c.out, c.norm_mix + (layer + 1) * DM, c.XN, nullptr); if (ANY_OPT_GEMM) phase_convert_weights(c, layer + 1, smem); }
                   else phase_rmsnorm(c.out, c.norm_final, nullptr, c.out); }
#pragma unroll 1
            for (int k = k0; k < k1; ++k) {
                const Ctx c = make_ctx(); const float* w_in = c.w_in + (size_t)layer * DM * INC; float* TMP = (float*)(c.R + R_TMP);
                NG g; EP e; int ng = 1;
                g.A = c.XN; g.lda = DM; g.W = w_in; g.ldw = INC; g.col0 = 0; g.ncols = 1024; g.row0 = 0; g.nrows = MS; g.K = DM; g.T = TMP; g.ldt = 1024; g.tcol0 = 0;
                e.kind = E_V; e.nrows = MS; e.rowg0 = 0; e.p0 = 0; e.layer = layer; e.dst = nullptr; e.base = nullptr;
                if (k < 20) { const int sp = k / 10, j = k % 10; g.row0 = sp * MS; e.rowg0 = sp * MS;
                    if (j < 3) { g.col0 = C_QKVA + j * 1024; e.kind = E_QKVA; e.p0 = j; }
                    else if (j == 3) { g.col0 = C_Z; e.kind = E_Z; }
                    else if (j == 4) { g.col0 = C_A; g.ncols = 16; e.kind = E_AB; }
                    else if (j == 5) { g.col0 = C_QB; e.kind = E_ROPE; e.dst = (bf16_t*)(c.R + R_QB); }
                    else if (j == 6) { g.col0 = C_KB; e.kind = E_ROPE; e.dst = (bf16_t*)(c.R + R_KB); }
                    else if (j == 7) { g.col0 = C_VB; e.kind = E_V; e.dst = (bf16_t*)(c.R + R_VB); }
                    else if (j == 8) { g.col0 = C_QI; g.ncols = 512; e.kind = E_QI; }
                    else { g.col0 = C_KI; g.ncols = 72; e.kind = E_KIWI; } }
                else if (k < 24) { const int hf = (k - 20) >> 1, gg = (k - 20) & 1; g.row0 = hf * MS; e.rowg0 = hf * MS; g.col0 = C_GA + gg * 1024; e.kind = E_SG; e.p0 = gg; }
                else if (k < 28) { const int hf = (k - 24) >> 1, wh = (k - 24) & 1; g.row0 = hf * MS; e.rowg0 = hf * MS; g.A = wh ? c.AT : c.OA;
                    g.W = (wh ? c.w_out_dsa : c.w_out_gdn) + (size_t)layer * DM * DM; g.ldw = DM; e.kind = wh ? E_YB : E_YA; }
                else if (k < 30) { const int hf = k - 28; g.row0 = hf * MS; e.rowg0 = hf * MS; g.A = (const bf16_t*)(c.R + R_MG); g.W = c.w_o + (size_t)layer * DM * DM; g.ldw = DM; e.kind = E_WO; e.base = layer == 0 ? c.x : c.out; }
                else if (k < 52) { const int hf = (k - 30) / 11, fg = (k - 30) % 11; g.row0 = hf * MS; e.rowg0 = hf * MS; g.W = c.w_gate_up + (size_t)layer * DM * 2 * FF; g.ldw = 2 * FF; g.col0 = fg * 256; g.ncols = 256;
                    ng = 2; e.kind = E_SWIGLU; e.p0 = fg; }
                else { const int hf = k - 52; g.row0 = hf * MS; e.rowg0 = hf * MS; g.A = (const bf16_t*)(c.R + R_ACT); g.lda = FF; g.K = FF; g.W = c.w_down + (size_t)layer * FF * DM; g.ldw = DM; e.kind = E_DOWN; }
#pragma unroll 1
                for (int q = 0; q < ng; ++q) { if (q == 1) { g.col0 += FF; g.tcol0 = 256; } naive_gemm(g, smem); }
                SYNC();
                epi_phase(c, e);
                if (k + 1 < k1) SYNC();
            }
            SYNC();
        }
    }
}

extern "C" void kernel_launch(void* const* d_in, const int* in_sizes, int n_in, void* d_out, int out_size, void* d_ws, size_t ws_size, hipStream_t stream) {
    static int grid = 0;
    if (grid == 0) {
        if (n_in != 14 || out_size != M * DM || ws_size < WS_END) { fprintf(stderr, "kernel_launch: unexpected problem (n_in %d out %d ws %zu need %zu)\n", n_in, out_size, ws_size, (size_t)WS_END); grid = -1; return; }
        int dev = 0, cus = 0, per_cu = 0;
        hipGetDevice(&dev); hipDeviceGetAttribute(&cus, hipDeviceAttributeMultiprocessorCount, dev);
        hipFuncSetAttribute((const void*)fwd_kernel, hipFuncAttributeMaxDynamicSharedMemorySize, LDS_BYTES);
        hipOccupancyMaxActiveBlocksPerMultiprocessor(&per_cu, (const void*)fwd_kernel, 512, LDS_BYTES);
        if (per_cu < 1) { fprintf(stderr, "kernel_launch: occupancy query says %d blocks/CU\n", per_cu); grid = -1; return; }
        grid = cus;
        (void)hipGetLastError();
    }
    if (grid < 0) return;
    hipMemsetAsync((char*)d_ws + WS_CTL, 0, 65536, stream);
    Args a{};
    for (int i = 0; i < 14; ++i) a.in[i] = (const float*)d_in[i];
    a.out = (float*)d_out; a.ws = (unsigned char*)d_ws;
    void* args[] = {&a};
    hipError_t e = hipLaunchCooperativeKernel((const void*)fwd_kernel, dim3(grid), dim3(512), args, LDS_BYTES, stream);
    if (e != hipSuccess) fprintf(stderr, "cooperative launch failed: %s (grid %d)\n", hipGetErrorString(e), grid);
}
```

```cpp
#include <hip/hip_runtime.h>
#include <hip/hip_cooperative_groups.h>
#include <cstdio>
#include <cstdint>
namespace cg = cooperative_groups;

typedef unsigned short bf16_t;
typedef float f32x4 __attribute__((ext_vector_type(4)));

constexpr int BATCH = 4, SEQ = 4096, DM = 1024, M = BATCH * SEQ, DEPTH = 2;
constexpr int GH = 8, GD = 128, CONVK = 4, CH = 64;
constexpr int AH = 8, AD = 128, IH = 8, ID = 64, TOPK = 256;
constexpr int FF = 2816, INC = 9816;
constexpr int NSPLIT = 2, MS = M / NSPLIT, BPS = BATCH / NSPLIT;
constexpr float EPS = 1e-6f;
constexpr int C_QKVA = 0, C_Z = 3072, C_A = 4096, C_B = 4104, C_QB = 4112, C_KB = 5136, C_VB = 6160, C_QI = 7184, C_KI = 7696, C_WI = 7760, C_GA = 7768, C_GB = 8792;

constexpr size_t MiB = 1u << 20;
constexpr size_t WS_CTL = 0;
constexpr size_t WS_WT = 1 * MiB;
constexpr size_t WS_TAB = 43 * MiB;
constexpr size_t WS_XN = 46 * MiB;
constexpr size_t WS_OA = 78 * MiB;
constexpr size_t WS_AT = 110 * MiB;
constexpr size_t WS_R = 142 * MiB;
constexpr size_t R_QKVA = 0, R_ZS = 48 * MiB, R_QB = 64 * MiB, R_KB = 80 * MiB, R_VB = 96 * MiB, R_QI = 112 * MiB, R_KI = 120 * MiB;
constexpr size_t R_WI = 121 * MiB, R_GG = R_WI + 256 * 1024, R_BETA = R_GG + 256 * 1024, R_HALO = 122 * MiB;
constexpr size_t R_P2 = 124 * MiB + 256 * 1024;
constexpr size_t R_TMP = R_P2;
constexpr size_t R_SG = 0, R_M1 = 64 * MiB, R_MG = R_M1;
constexpr size_t R_ACT = 0;
constexpr size_t WS_END = WS_R + R_P2 + 32 * MiB;
static_assert(WS_END <= 321650688ull, "workspace map exceeds the guaranteed d_ws size");
constexpr int LDS_BYTES = 163840;

struct Args { const float* in[14]; float* out; unsigned char* ws; };

__device__ __forceinline__ int otid() { int t = threadIdx.x; asm volatile("" : "+v"(t)); return t; }
__device__ __forceinline__ float bf2f(unsigned v) { return __uint_as_float(v << 16); }
__device__ __forceinline__ bf16_t f2bf(float f) { unsigned u = __float_as_uint(f); u += 0x7fffu + ((u >> 16) & 1u); return (bf16_t)(u >> 16); }
__device__ __forceinline__ float sigmoidf_(float x) { return 1.f / (1.f + __expf(-x)); }
__device__ __forceinline__ float siluf_(float x) { return x / (1.f + __expf(-x)); }
__device__ __forceinline__ float softplusf_(float x) { return fmaxf(x, 0.f) + log1pf(__expf(-fabsf(x))); }
__device__ __forceinline__ float wave_sum(float v) {
#pragma unroll
    for (int o = 1; o < 64; o <<= 1) v += __shfl_xor(v, o);
    return v;
}
__device__ __forceinline__ float wave_max(float v) {
#pragma unroll
    for (int o = 1; o < 64; o <<= 1) v = fmaxf(v, __shfl_xor(v, o));
    return v;
}

struct Ctx {
    const float* x; const float* norm_mix; const float* w_in; const float* conv_w; const float* a_log; const float* dt_bias; const float* gdn_norm;
    const float* w_out_gdn; const float* w_out_dsa; const float* w_o; const float* norm_ffn; const float* w_gate_up; const float* w_down; const float* norm_final;
    float* out; unsigned char* ws; unsigned char* R;
    float *cosA, *sinA, *cosI, *sinI;
    bf16_t *XN, *OA, *AT;
};

__device__ const double ROPE_INVF[64] = {1.0, 0.8659643233600653, 0.7498942093324559, 0.6493816315762113, 0.5623413251903491, 0.4869675251658631, 0.4216965034285822, 0.3651741272548377, 0.31622776601683794, 0.27384196342643613, 0.23713737056616552, 0.2053525026457146, 0.1778279410038923, 0.1539926526059492, 0.1333521432163324, 0.11547819846894582, 0.1, 0.08659643233600653, 0.07498942093324558, 0.06493816315762113, 0.05623413251903491, 0.04869675251658631, 0.042169650342858224, 0.03651741272548377, 0.03162277660168379, 0.027384196342643614, 0.023713737056616554, 0.02053525026457146, 0.01778279410038923, 0.01539926526059492, 0.01333521432163324, 0.011547819846894581, 0.01, 0.008659643233600654, 0.007498942093324558, 0.006493816315762113, 0.005623413251903491, 0.004869675251658631, 0.004216965034285823, 0.003651741272548377, 0.0031622776601683794, 0.0027384196342643613, 0.0023713737056616554, 0.002053525026457146, 0.0017782794100389228, 0.001539926526059492, 0.001333521432163324, 0.0011547819846894581, 0.001, 0.0008659643233600654, 0.0007498942093324559, 0.0006493816315762113, 0.0005623413251903491, 0.0004869675251658631, 0.00042169650342858224, 0.0003651741272548377, 0.00031622776601683794, 0.0002738419634264361, 0.00023713737056616554, 0.0002053525026457146, 0.00017782794100389227, 0.0001539926526059492, 0.0001333521432163324, 0.00011547819846894582};
__device__ __forceinline__ void rope_cs(int t, double invf, float& cs, float& sn) {
    const double ang = (double)t * invf; const double k = rint(ang * 0.15915494309189535); const float r = (float)(ang - k * 6.283185307179586);
    cs = cosf(r); sn = sinf(r);
}
__device__ __forceinline__ void phase_tables(const Ctx& c) {
    const int gt = blockIdx.x * blockDim.x + otid(), nt = gridDim.x * blockDim.x;
    for (int i = gt; i < SEQ * 64; i += nt) { const int t = i >> 6, d = i & 63; float cs, sn; rope_cs(t, ROPE_INVF[d], cs, sn); c.cosA[i] = cs; c.sinA[i] = sn; }
    for (int i = gt; i < SEQ * 32; i += nt) { const int t = i >> 5, d = i & 31; float cs, sn; rope_cs(t, ROPE_INVF[2 * d], cs, sn); c.cosI[i] = cs; c.sinI[i] = sn; }
}

__device__ __forceinline__ void phase_rmsnorm(const float* src, const float* gain, bf16_t* dst_bf, float* dst_f) {
    const int lane = otid() & 63, gw = (blockIdx.x * blockDim.x + otid()) >> 6, nw = (gridDim.x * blockDim.x) >> 6;
    for (int r = gw; r < M; r += nw) {
        const f32x4* xr = (const f32x4*)(src + (size_t)r * DM) + lane;
        f32x4 v[4]; float s = 0.f;
#pragma unroll
        for (int j = 0; j < 4; ++j) { v[j] = xr[64 * j]; s += v[j].x * v[j].x + v[j].y * v[j].y + v[j].z * v[j].z + v[j].w * v[j].w; }
        const float rs = rsqrtf(wave_sum(s) * (1.f / DM) + EPS);
#pragma unroll
        for (int j = 0; j < 4; ++j) {
            const f32x4 g = ((const f32x4*)gain)[lane + 64 * j]; const f32x4 o = v[j] * rs * g;
            if (dst_bf) { uint2 w; w.x = f2bf(o.x) | ((unsigned)f2bf(o.y) << 16); w.y = f2bf(o.z) | ((unsigned)f2bf(o.w) << 16); ((uint2*)(dst_bf + (size_t)r * DM))[lane + 64 * j] = w; }
            else ((f32x4*)(dst_f + (size_t)r * DM))[lane + 64 * j] = o;
        }
    }
}

struct NG { const bf16_t* A; int lda; const float* W; int ldw; int col0; int ncols; int row0; int nrows; int K; float* T; int ldt; int tcol0; };
__device__ __forceinline__ void naive_gemm(const NG& g, unsigned char* smem) {
    float* As = (float*)smem; float* Bs = As + 16 * 132;
    const int tid = otid(), ty = tid >> 4, tx = tid & 15;
    const int ntr = g.nrows / 128, ntc = (g.ncols + 63) / 64;
    for (int u = blockIdx.x; u < ntr * ntc; u += gridDim.x) {
        const int tr = u % ntr, tc = u / ntr, r0 = tr * 128, c0 = tc * 64;
        float acc[4][4];
#pragma unroll
        for (int i = 0; i < 4; ++i)
#pragma unroll
            for (int j = 0; j < 4; ++j) acc[i][j] = 0.f;
        for (int k0 = 0; k0 < g.K; k0 += 16) {
            { const int row = tid >> 2, kq = (tid & 3) * 4;
              const uint2 raw = *(const uint2*)(g.A + (size_t)(g.row0 + r0 + row) * g.lda + k0 + kq);
              As[(kq + 0) * 132 + row] = bf2f(raw.x & 0xffffu); As[(kq + 1) * 132 + row] = bf2f(raw.x >> 16);
              As[(kq + 2) * 132 + row] = bf2f(raw.y & 0xffffu); As[(kq + 3) * 132 + row] = bf2f(raw.y >> 16); }
            { const int k = tid >> 5, cc = (tid & 31) * 2;
              const float* wp = g.W + (size_t)(k0 + k) * g.ldw + g.col0 + c0 + cc;
              Bs[k * 68 + cc] = (c0 + cc < g.ncols) ? wp[0] : 0.f; Bs[k * 68 + cc + 1] = (c0 + cc + 1 < g.ncols) ? wp[1] : 0.f; }
            __syncthreads();
#pragma unroll
            for (int kk = 0; kk < 16; ++kk) {
                const f32x4 a = *(const f32x4*)&As[kk * 132 + ty * 4]; const f32x4 b = *(const f32x4*)&Bs[kk * 68 + tx * 4];
#pragma unroll
                for (int i = 0; i < 4; ++i)
#pragma unroll
                    for (int j = 0; j < 4; ++j) acc[i][j] += a[i] * b[j];
            }
            __syncthreads();
        }
#pragma unroll
        for (int i = 0; i < 4; ++i)
#pragma unroll
            for (int j = 0; j < 4; ++j) { const int cc = c0 + tx * 4 + j; if (cc < g.ncols) g.T[(size_t)(r0 + ty * 4 + i) * g.ldt + g.tcol0 + cc] = acc[i][j]; }
    }
}

enum { E_QKVA, E_Z, E_AB, E_ROPE, E_V, E_QI, E_KIWI, E_SG, E_YA, E_YB, E_WO, E_SWIGLU, E_DOWN };
struct EP { int kind; int nrows; int rowg0; int p0; int layer; bf16_t* dst; const float* base; };
__device__ __forceinline__ void epi_phase(const Ctx& c, const EP& e) {
    const float* T = (const float*)(c.R + R_TMP);
    const int gt = blockIdx.x * blockDim.x + otid(), nt = gridDim.x * blockDim.x;
    int W;
    switch (e.kind) { case E_QKVA: case E_Z: case E_V: case E_SG: case E_YA: case E_YB: case E_WO: case E_DOWN: W = 1024; break;
        case E_AB: W = 16; break; case E_ROPE: W = 512; break; case E_QI: W = 256; break; case E_KIWI: W = 40; break; default: W = 256; break; }
    const long total = (long)e.nrows * W;
    for (long idx = gt; idx < total; idx += nt) {
        const int r = (int)(idx / W), j = (int)(idx % W);
        const int rowg = e.rowg0 + r, rs = rowg % MS, pos = rowg % SEQ;
        const float* Tr = T + (size_t)r * 1024;
        switch (e.kind) {
        case E_QKVA: { const int col = e.p0 * 1024 + j; const bf16_t v = f2bf(Tr[j]); ((bf16_t*)(c.R + R_QKVA))[(size_t)rs * 3072 + col] = v;
                       if ((rs & 63) >= 61) ((bf16_t*)(c.R + R_HALO))[((size_t)(rs >> 6) * 3 + ((rs & 63) - 61)) * 3072 + col] = v; } break;
        case E_Z: ((bf16_t*)(c.R + R_ZS))[(size_t)rs * 1024 + j] = f2bf(siluf_(Tr[j])); break;
        case E_AB: { const int h = j & 7;
                     if (j < 8) ((float*)(c.R + R_GG))[rs * 8 + h] = -__expf(c.a_log[e.layer * 8 + h]) * softplusf_(Tr[j] + c.dt_bias[e.layer * 8 + h]);
                     else ((float*)(c.R + R_BETA))[rs * 8 + h] = sigmoidf_(Tr[j]); } break;
        case E_ROPE: { const int h = j >> 6, d = j & 63; const float x1 = Tr[h * 128 + d], x2 = Tr[h * 128 + 64 + d], cs = c.cosA[pos * 64 + d], sn = c.sinA[pos * 64 + d];
                       bf16_t* dst = e.dst + (size_t)rs * 1024 + h * 128 + d; dst[0] = f2bf(x1 * cs - x2 * sn); dst[64] = f2bf(x2 * cs + x1 * sn); } break;
        case E_V: e.dst[(size_t)rs * 1024 + j] = f2bf(Tr[j]); break;
        case E_QI: { const int h = j >> 5, d = j & 31; const float x1 = Tr[h * 64 + d], x2 = Tr[h * 64 + 32 + d], cs = c.cosI[pos * 32 + d], sn = c.sinI[pos * 32 + d];
                     bf16_t* dst = (bf16_t*)(c.R + R_QI) + (size_t)rs * 512 + h * 64 + d; dst[0] = f2bf(x1 * cs - x2 * sn); dst[32] = f2bf(x2 * cs + x1 * sn); } break;
        case E_KIWI: { if (j < 32) { const int d = j; const float x1 = Tr[d], x2 = Tr[32 + d], cs = c.cosI[pos * 32 + d], sn = c.sinI[pos * 32 + d];
                           bf16_t* dst = (bf16_t*)(c.R + R_KI) + (size_t)rs * 64 + d; dst[0] = f2bf((x1 * cs - x2 * sn) * 0.125f); dst[32] = f2bf((x2 * cs + x1 * sn) * 0.125f); }
                       else ((float*)(c.R + R_WI))[rs * 8 + (j - 32)] = Tr[64 + (j - 32)] * 0.35355339059327373f; } break;
        case E_SG: ((bf16_t*)(c.R + R_SG))[(size_t)rowg * 2048 + e.p0 * 1024 + j] = f2bf(sigmoidf_(Tr[j])); break;
        case E_YA: ((bf16_t*)(c.R + R_M1))[(size_t)rowg * 1024 + j] = f2bf(bf2f(((const bf16_t*)(c.R + R_SG))[(size_t)rowg * 2048 + j]) * Tr[j]); break;
        case E_YB: ((bf16_t*)(c.R + R_MG))[(size_t)rowg * 1024 + j] = f2bf(bf2f(((const bf16_t*)(c.R + R_M1))[(size_t)rowg * 1024 + j]) + bf2f(((const bf16_t*)(c.R + R_SG))[(size_t)rowg * 2048 + 1024 + j]) * Tr[j]); break;
        case E_WO: c.out[(size_t)rowg * 1024 + j] = e.base[(size_t)rowg * 1024 + j] + Tr[j]; break;
        case E_SWIGLU: ((bf16_t*)(c.R + R_ACT))[(size_t)rowg * FF + e.p0 * 256 + j] = f2bf(siluf_(Tr[j]) * Tr[256 + j]); break;
        case E_DOWN: c.out[(size_t)rowg * 1024 + j] += Tr[j]; break;
        }
    }
}

__device__ __forceinline__ void naive_conv(const Ctx& c, int layer) {
    bf16_t* Q = (bf16_t*)(c.R + R_QKVA); const bf16_t* H = (const bf16_t*)(c.R + R_HALO); const float* cw = c.conv_w + (size_t)layer * 4 * 3072;
    const int gt = blockIdx.x * blockDim.x + otid(), nt = gridDim.x * blockDim.x;
    for (int idx = gt; idx < (MS / 64) * 3072; idx += nt) {
        const int ch = idx % 3072, ck = idx / 3072;
        const float w0 = cw[ch], w1 = cw[3072 + ch], w2 = cw[2 * 3072 + ch], w3 = cw[3 * 3072 + ch];
        float x3 = 0.f, x2 = 0.f, x1 = 0.f;
        if ((ck * 64) % SEQ != 0) { const bf16_t* hp = H + (size_t)(ck - 1) * 3 * 3072 + ch; x3 = bf2f(hp[0]); x2 = bf2f(hp[3072]); x1 = bf2f(hp[2 * 3072]); }
        bf16_t* p = Q + (size_t)ck * 64 * 3072 + ch;
        for (int r = 0; r < 64; ++r) { const float xv = bf2f(p[(size_t)r * 3072]); const float y = w0 * x3 + w1 * x2 + w2 * x1 + w3 * xv; p[(size_t)r * 3072] = f2bf(siluf_(y)); x3 = x2; x2 = x1; x1 = xv; }
    }
}
__device__ __forceinline__ void naive_l2norm(const Ctx& c) {
    bf16_t* Q = (bf16_t*)(c.R + R_QKVA);
    const int lane = otid() & 63, gw = (blockIdx.x * blockDim.x + otid()) >> 6, nw = (gridDim.x * blockDim.x) >> 6;
    for (int t = gw; t < MS * 16; t += nw) {
        const int r = t >> 4, hh = t & 15;
        unsigned* p = (unsigned*)(Q + (size_t)r * 3072 + hh * 128) + lane; const unsigned raw = *p;
        const float a = bf2f(raw & 0xffffu), b = bf2f(raw >> 16); const float rs = rsqrtf(wave_sum(a * a + b * b) + EPS);
        *p = f2bf(a * rs) | ((unsigned)f2bf(b * rs) << 16);
    }
}
__device__ __forceinline__ void naive_scan(const Ctx& c, unsigned char* smem) {
    const bf16_t* Q = (const bf16_t*)(c.R + R_QKVA); const float* GG = (const float*)(c.R + R_GG); const float* BT = (const float*)(c.R + R_BETA); float* O = (float*)(c.R + R_TMP);
    const int lane = otid() & 63, wv = otid() >> 6, gw = blockIdx.x * 8 + wv, nw = gridDim.x * 8;
    float* kL = (float*)smem + wv * 4096; float* qL = kL + 2048;
    const int dq = lane >> 4, el = lane & 15;
    for (int task = gw; task < BPS * 8 * 8; task += nw) {
        const int eb = task & 7, h = (task >> 3) & 7, bl = task >> 6, e = eb * 16 + el;
        float S[32];
#pragma unroll
        for (int i = 0; i < 32; ++i) S[i] = 0.f;
        for (int t0 = 0; t0 < SEQ; t0 += 16) {
            for (int tk = 0; tk < 16; ++tk) { const size_t row = (size_t)bl * SEQ + t0 + tk;
                const unsigned qr = *((const unsigned*)(Q + row * 3072 + h * 128) + lane), kr = *((const unsigned*)(Q + row * 3072 + 1024 + h * 128) + lane);
                qL[tk * 128 + lane * 2] = bf2f(qr & 0xffffu); qL[tk * 128 + lane * 2 + 1] = bf2f(qr >> 16); kL[tk * 128 + lane * 2] = bf2f(kr & 0xffffu); kL[tk * 128 + lane * 2 + 1] = bf2f(kr >> 16); }
            __builtin_amdgcn_s_waitcnt(0); __builtin_amdgcn_wave_barrier();
            for (int tk = 0; tk < 16; ++tk) { const size_t row = (size_t)bl * SEQ + t0 + tk;
                const float eg = __expf(GG[row * 8 + h]), bt = BT[row * 8 + h], v = bf2f(Q[row * 3072 + 2048 + h * 128 + e]);
                const float* kp = kL + tk * 128 + dq * 32; const float* qp = qL + tk * 128 + dq * 32;
                float ks = 0.f;
#pragma unroll
                for (int i = 0; i < 32; ++i) ks += kp[i] * S[i];
                ks += __shfl_xor(ks, 16); ks += __shfl_xor(ks, 32);
                const float cc = bt * (v - eg * ks); float o = 0.f;
#pragma unroll
                for (int i = 0; i < 32; ++i) { S[i] = eg * S[i] + kp[i] * cc; o += qp[i] * S[i]; }
                o += __shfl_xor(o, 16); o += __shfl_xor(o, 32);
                if (dq == 0) O[row * 1024 + h * 128 + e] = o * 0.08838834764831845f;
            }
            __builtin_amdgcn_s_waitcnt(0); __builtin_amdgcn_wave_barrier();
        }
    }
}
__device__ __forceinline__ void naive_gate(const Ctx& c, int layer, int split) {
    const float* O = (const float*)(c.R + R_TMP); const bf16_t* Z = (const bf16_t*)(c.R + R_ZS); const float* gn = c.gdn_norm + layer * 128;
    const int lane = otid() & 63, gw = (blockIdx.x * blockDim.x + otid()) >> 6, nw = (gridDim.x * blockDim.x) >> 6;
    for (int t = gw; t < MS * 8; t += nw) {
        const int r = t >> 3, h = t & 7; const size_t off = (size_t)r * 1024 + h * 128 + lane * 2;
        const float a = O[off], b = O[off + 1]; const float rs = rsqrtf(wave_sum(a * a + b * b) * (1.f / 128.f) + EPS);
        const unsigned z = *(const unsigned*)(Z + off);
        *(unsigned*)(c.OA + (size_t)split * MS * 1024 + off) = f2bf(a * rs * gn[lane * 2] * bf2f(z & 0xffffu)) | ((unsigned)f2bf(b * rs * gn[lane * 2 + 1] * bf2f(z >> 16)) << 16);
    }
}

__device__ __forceinline__ void naive_dsa(const Ctx& c, int split, unsigned char* smem) {
    const bf16_t* QB = (const bf16_t*)(c.R + R_QB); const bf16_t* KB = (const bf16_t*)(c.R + R_KB); const bf16_t* VB = (const bf16_t*)(c.R + R_VB);
    const bf16_t* QI = (const bf16_t*)(c.R + R_QI); const bf16_t* KI = (const bf16_t*)(c.R + R_KI); const float* WI = (const float*)(c.R + R_WI);
    float* qi = (float*)smem; float* qf = qi + 512; float* sc = qf + 1024; float* scores = sc + 2048; unsigned* sel = (unsigned*)(scores + 4096); float* wi = (float*)(sel + 272); unsigned* cnt = (unsigned*)(wi + 8);
    const int tid = otid(), lane = tid & 63, wv = tid >> 6;
    for (int row = blockIdx.x; row < MS; row += gridDim.x) {
        const int t = row % SEQ, rb = row - t, n = t + 1;
        __syncthreads();
        qi[tid] = bf2f(QI[(size_t)row * 512 + tid]); qf[tid] = bf2f(QB[(size_t)row * 1024 + tid]); qf[tid + 512] = bf2f(QB[(size_t)row * 1024 + 512 + tid]);
        if (tid < 8) wi[tid] = WI[row * 8 + tid];
        if (tid == 0) { cnt[0] = 0; cnt[1] = 0; cnt[2] = 0; cnt[3] = 0; }
        __syncthreads();
        for (int s = tid; s < n; s += 512) {
            const uint4* kp = (const uint4*)(KI + (size_t)(rb + s) * 64);
            float acc = 0.f;
#pragma unroll 1
            for (int h = 0; h < 8; ++h) { float d = 0.f;
#pragma unroll 2
                for (int i = 0; i < 8; ++i) { const uint4 w = kp[i]; const float* qp = qi + h * 64 + i * 8;
                    d += qp[0] * bf2f(w.x & 0xffffu) + qp[1] * bf2f(w.x >> 16) + qp[2] * bf2f(w.y & 0xffffu) + qp[3] * bf2f(w.y >> 16)
                       + qp[4] * bf2f(w.z & 0xffffu) + qp[5] * bf2f(w.z >> 16) + qp[6] * bf2f(w.w & 0xffffu) + qp[7] * bf2f(w.w >> 16); }
                acc += wi[h] * fmaxf(d, 0.f); }
            scores[s] = acc + 0.f;
        }
        __syncthreads();
        int nsel;
        if (n <= TOPK) { for (int s = tid; s < n; s += 512) sel[s] = s; nsel = n; }
        else {
            unsigned T = 0;
            for (int bit = 31; bit >= 0; --bit) {
                const unsigned cand = T | (1u << bit); unsigned my = 0;
                for (int s = tid; s < n; s += 512) { unsigned u = __float_as_uint(scores[s]); u = (u & 0x80000000u) ? ~u : (u | 0x80000000u); my += (u >= cand) ? 1u : 0u; }
                my = (unsigned)wave_sum((float)my);
                if (lane == 0) atomicAdd(&cnt[1], my);
                __syncthreads();
                const unsigned tot = cnt[1];
                __syncthreads();
                if (tid == 0) cnt[1] = 0;
                if (tot >= (unsigned)TOPK) T = cand;
                __syncthreads();
            }
            unsigned mgt = 0, meq = 0;
            for (int s = tid; s < n; s += 512) { unsigned u = __float_as_uint(scores[s]); u = (u & 0x80000000u) ? ~u : (u | 0x80000000u); mgt += (u > T); meq += (u == T); }
            mgt = (unsigned)wave_sum((float)mgt); meq = (unsigned)wave_sum((float)meq);
            if (lane == 0) { atomicAdd(&cnt[2], mgt); atomicAdd(&cnt[3], meq); }
            __syncthreads();
            const unsigned cgt = cnt[2], ceq = cnt[3], need = TOPK - cgt;
            unsigned base = 0, eqbase = 0;
            for (int s0 = 0; s0 < n; s0 += 512) {
                const int s = s0 + tid; unsigned u = 0; if (s < n) { u = __float_as_uint(scores[s]); u = (u & 0x80000000u) ? ~u : (u | 0x80000000u); }
                const bool gt = (s < n) && (u > T), eq = (s < n) && (u == T);
                const unsigned long long bg = __ballot(gt), be = __ballot(eq), lm = (1ull << lane) - 1ull;
                if (lane == 0) { sel[256 + wv] = (unsigned)__popcll(bg); sel[264 + wv] = (unsigned)__popcll(be); }
                __syncthreads();
                unsigned pg = 0, pe = 0, tg = 0, te = 0;
                for (int w = 0; w < 8; ++w) { const unsigned a = sel[256 + w], e = sel[264 + w]; if (w < wv) { pg += a; pe += e; } tg += a; te += e; }
                const unsigned eqrank = eqbase + pe + (unsigned)__popcll(be & lm);
                const unsigned eqbefore = min(eqbase + pe + (unsigned)__popcll(be & lm), need);
                (void)eqbefore;
                const unsigned gtbefore = base + pg + (unsigned)__popcll(bg & lm);
                if (gt) sel[gtbefore + min(eqbase + pe + (unsigned)__popcll(be & lm), need)] = s;
                else if (eq && eqrank < need) sel[gtbefore + eqrank] = s;
                __syncthreads();
                base += tg; eqbase += te;
            }
            nsel = TOPK;
        }
        __syncthreads();
        for (int p = tid; p < 8 * TOPK; p += 512) { const int h = p >> 8, j = p & 255;
            if (j < nsel) { const uint4* kp = (const uint4*)(KB + (size_t)(rb + sel[j]) * 1024 + h * 128); const float* qp = qf + h * 128; float d = 0.f;
#pragma unroll 4
                for (int i = 0; i < 16; ++i) { const uint4 w = kp[i]; d += qp[i * 8] * bf2f(w.x & 0xffffu) + qp[i * 8 + 1] * bf2f(w.x >> 16) + qp[i * 8 + 2] * bf2f(w.y & 0xffffu) + qp[i * 8 + 3] * bf2f(w.y >> 16)
                        + qp[i * 8 + 4] * bf2f(w.z & 0xffffu) + qp[i * 8 + 5] * bf2f(w.z >> 16) + qp[i * 8 + 6] * bf2f(w.w & 0xffffu) + qp[i * 8 + 7] * bf2f(w.w >> 16); }
                sc[h * 256 + j] = d * 0.08838834764831845f; } }
        __syncthreads();
        { float* sp = sc + wv * 256; float mx = -3.0e38f; for (int j = lane; j < nsel; j += 64) mx = fmaxf(mx, sp[j]); mx = wave_max(mx);
          float sm = 0.f; for (int j = lane; j < nsel; j += 64) { const float pz = __expf(sp[j] - mx); sp[j] = pz; sm += pz; } sm = wave_sum(sm); const float inv = 1.f / sm;
          for (int j = lane; j < nsel; j += 64) sp[j] *= inv; }
        __syncthreads();
        { const int o = tid * 2, h = o >> 7; const float* sp = sc + h * 256; float a0 = 0.f, a1 = 0.f;
          for (int j = 0; j < nsel; ++j) { const unsigned w = *(const unsigned*)(VB + (size_t)(rb + sel[j]) * 1024 + o); const float pz = sp[j]; a0 += pz * bf2f(w & 0xffffu); a1 += pz * bf2f(w >> 16); }
          *(unsigned*)(c.AT + ((size_t)split * MS + row) * 1024 + o) = f2bf(a0) | ((unsigned)f2bf(a1) << 16); }
    }
}

namespace pg8 {
#define PG8_LAS __attribute__((address_space(3)))
typedef unsigned short bf16_t;
typedef short bf16x8 __attribute__((ext_vector_type(8)));
typedef float f32x4 __attribute__((ext_vector_type(4)));
typedef unsigned u32x4 __attribute__((ext_vector_type(4)));
constexpr int BM = 256, BK = 64, HALF = 128, HTB = HALF * BK * 2  , STAGE_BYTES = 8 * HTB, NXCD = 8, WGM = 8;

__host__ __device__ __forceinline__ int lds_byte(int r, int c) { const int st = (r >> 4) * 2 + (c >> 5), rr = r & 15, cc = c & 31, ob = rr * 64 + cc * 2; return st * 1024 + (ob ^ (((ob >> 9) & 1) << 5)); }
__host__ __device__ __forceinline__ void stage_rc(int b, int& R, int& C) { const int st = b / 1024, sb = b % 1024, swz = sb ^ (((sb >> 9) & 1) << 5); R = (st >> 1) * 16 + swz / 64; C = (st & 1) * 32 + (swz % 64) / 2; }
__host__ __device__ __forceinline__ int perm32(int rho) { const int n = rho >> 4, i = rho & 15; return 8 * (i >> 2) + 4 * n + (i & 3); }

struct Unit { int pm, pn; };
struct Gemm { const bf16_t* A; const bf16_t* Bt; int M, N, K; };

struct StaticOrder {
    int nM, nN, nwg, G, c;
    __host__ __device__ void init(int M, int N, int G_, int c_) { nM = M / BM; nN = N / BM; nwg = nM * nN; G = G_; c = c_; }
    __host__ __device__ bool next(int i, Unit& u) const {
        const long L = (long)i * G + c; if (L >= nwg) return false;
        int wgid = (int)L; { const int q = nwg / NXCD, r = nwg % NXCD, xcd = wgid % NXCD, off = wgid / NXCD; wgid = (xcd < r ? xcd * (q + 1) : r * (q + 1) + (xcd - r) * q) + off; }
        const int nig = WGM * nN, gid = wgid / nig, fm = gid * WGM, gsz = (nM - fm) < WGM ? (nM - fm) : WGM;
        u.pm = fm + ((wgid % nig) % gsz); u.pn = (wgid % nig) / gsz; return true;
    }
    __device__ __forceinline__ void a_ready(const Unit&) const {}
    __device__ __forceinline__ void done(const Unit&) const {}
};


__device__ __forceinline__ unsigned cvt_pk_bf16(float lo, float hi) { unsigned r; asm volatile("v_cvt_pk_bf16_f32 %0, %1, %2" : "=v"(r) : "v"(lo), "v"(hi)); return r; }

template <class Epi, class Sched, bool ALIGN_EPI = false, bool SP2 = false>
__device__ __forceinline__ void gemm_phase(PG8_LAS unsigned char* lds, const Gemm g, const Sched& S, const Epi& E) {
    const int tid = otid(), wid = __builtin_amdgcn_readfirstlane(tid >> 6), lane = tid & 63, wr = wid >> 2, wc = wid & 3, fr = lane & 15, fq = lane >> 4;
    const int K = g.K, nt = K / BK;
    unsigned voffA[2], voffB[2];
#pragma unroll
    for (int i = 0; i < 2; ++i) { int R, C; stage_rc(tid * 16 + i * 8192, R, C); const int Rb = Epi::PERM ? ((R & ~31) + perm32(R & 31)) : R;
        voffA[i] = (unsigned)(R * K + C) * 2u; voffB[i] = (unsigned)(Rb * K + C) * 2u; }
    const size_t kstep = (size_t)(BK * 2);
    const size_t hstep = (size_t)HALF * K * 2;
    const size_t tstep = 2 * hstep;
    const unsigned ldsw = (unsigned)wid * 1024u;
    const int aoff = lds_byte(wr * 64 + fr, fq * 8), boff = lds_byte(wc * 32 + fr, fq * 8);
#define PG8_SA(b, h) (((b) * 2 + (h)) * HTB)
#define PG8_SB(b, h) ((4 + (b) * 2 + (h)) * HTB)
#define PG8_STAGE(bufoff, gbase, voff) do { _Pragma("unroll") for (int _i = 0; _i < 2; ++_i) \
        __builtin_amdgcn_global_load_lds((const unsigned*)((const char*)(gbase) + (voff)[_i]), (PG8_LAS unsigned*)(lds + (bufoff) + ldsw + _i * 8192), 16, 0, 0); } while (0)
#define PG8_LDA(dst, b, h) do { _Pragma("unroll") for (int m = 0; m < 4; ++m) _Pragma("unroll") for (int k = 0; k < 2; ++k) dst[m][k] = *(const PG8_LAS bf16x8*)(lds + PG8_SA(b, h) + aoff + m * 2048 + k * 1024); } while (0)
#define PG8_LDB(dst, b, h) do { _Pragma("unroll") for (int n = 0; n < 2; ++n) _Pragma("unroll") for (int k = 0; k < 2; ++k) dst[n][k] = *(const PG8_LAS bf16x8*)(lds + PG8_SB(b, h) + boff + n * 2048 + k * 1024); } while (0)
#define PG8_MMA(ai, bj, At, Bt) do { __builtin_amdgcn_s_setprio(1); _Pragma("unroll") for (int m = 0; m < 4; ++m) _Pragma("unroll") for (int n = 0; n < 2; ++n) _Pragma("unroll") for (int k = 0; k < 2; ++k) \
        acc[ai][bj][m][n] = __builtin_amdgcn_mfma_f32_16x16x32_bf16(Bt[n][k], At[m][k], acc[ai][bj][m][n], 0, 0, 0); __builtin_amdgcn_s_setprio(0); } while (0)
#define PG8_WAIT_V(n) asm volatile("s_waitcnt vmcnt(" #n ")" ::: "memory")
#define PG8_WAIT_L(n) asm volatile("s_waitcnt lgkmcnt(" #n ")" ::: "memory")
#define PG8_BAR __builtin_amdgcn_s_barrier()
#define PG8_SCHED __builtin_amdgcn_sched_barrier(0)
    Unit cur, nxt; int ui = 0;
    if (!S.next(0, cur)) return;
    f32x4 acc[2][2][4][2];
#pragma unroll
    for (int a = 0; a < 2; ++a)
#pragma unroll
        for (int b = 0; b < 2; ++b)
#pragma unroll
            for (int m = 0; m < 4; ++m)
#pragma unroll
                for (int n = 0; n < 2; ++n) acc[a][b][m][n] = (f32x4){0.f, 0.f, 0.f, 0.f};
    bf16x8 At[4][2], B0[2][2], B1[2][2];
    const char* cA = (const char*)g.A + (size_t)cur.pm * tstep; const char* cB = (const char*)g.Bt + (size_t)cur.pn * tstep;
    S.a_ready(cur);
    if constexpr (SP2) {
        PG8_STAGE(PG8_SB(0, 0), cB, voffB); PG8_STAGE(PG8_SB(0, 1), cB + hstep, voffB); PG8_STAGE(PG8_SA(0, 0), cA, voffA); PG8_STAGE(PG8_SA(0, 1), cA + hstep, voffA);
        if (wr == 1) PG8_BAR;
        PG8_WAIT_V(2); PG8_BAR;
        PG8_STAGE(PG8_SB(1, 0), cB + kstep, voffB); PG8_STAGE(PG8_SA(1, 0), cA + kstep, voffA); PG8_STAGE(PG8_SB(1, 1), cB + hstep + kstep, voffB);
        PG8_WAIT_V(6); PG8_BAR;
    } else {
        PG8_STAGE(PG8_SB(0, 0), cB, voffB); PG8_STAGE(PG8_SA(0, 0), cA, voffA); PG8_STAGE(PG8_SB(0, 1), cB + hstep, voffB); PG8_STAGE(PG8_SA(0, 1), cA + hstep, voffA);
        if (wr == 1) PG8_BAR;
        PG8_WAIT_V(4); PG8_BAR;
        PG8_STAGE(PG8_SB(1, 0), cB + kstep, voffB); PG8_STAGE(PG8_SA(1, 0), cA + kstep, voffA); PG8_STAGE(PG8_SB(1, 1), cB + hstep + kstep, voffB);
        PG8_WAIT_V(6); PG8_BAR;
    }
    for (;;) {
        const bool has_next = S.next(ui + 1, nxt);
        const char* nA = has_next ? (const char*)g.A + (size_t)nxt.pm * tstep : cA; const char* nB = has_next ? (const char*)g.Bt + (size_t)nxt.pn * tstep : cB;
        for (int t = 0; t < nt; t += 2) {
            const bool last = (t == nt - 2);
            const char* a1 = cA + (size_t)(t + 1) * kstep;
            const char* a2 = last ? nA : cA + (size_t)(t + 2) * kstep; const char* b2 = last ? nB : cB + (size_t)(t + 2) * kstep;
            const char* a3 = a2 + kstep; const char* b3 = b2 + kstep;
            if (last && has_next) S.a_ready(nxt);
            if constexpr (SP2) {
            PG8_LDB(B0, 0, 0); PG8_LDB(B1, 0, 1); PG8_SCHED; PG8_LDA(At, 0, 0); PG8_STAGE(PG8_SA(1, 1), a1 + hstep, voffA);
            PG8_WAIT_V(8); PG8_WAIT_L(0); PG8_BAR; PG8_MMA(0, 0, At, B0); PG8_MMA(0, 1, At, B1); PG8_BAR; PG8_SCHED;
            PG8_LDA(At, 0, 1); PG8_STAGE(PG8_SB(0, 0), b2, voffB); PG8_STAGE(PG8_SB(0, 1), b2 + hstep, voffB); PG8_STAGE(PG8_SA(0, 0), a2, voffA);
            PG8_WAIT_V(8); PG8_WAIT_L(0); PG8_BAR; PG8_MMA(1, 0, At, B0); PG8_MMA(1, 1, At, B1); PG8_BAR; PG8_SCHED;
            PG8_LDB(B0, 1, 0); PG8_LDB(B1, 1, 1); PG8_SCHED; PG8_LDA(At, 1, 0); PG8_STAGE(PG8_SA(0, 1), a2 + hstep, voffA);
            PG8_WAIT_V(8); PG8_WAIT_L(0); PG8_BAR; PG8_MMA(0, 0, At, B0); PG8_MMA(0, 1, At, B1); PG8_BAR; PG8_SCHED;
            PG8_LDA(At, 1, 1); PG8_STAGE(PG8_SB(1, 0), b3, voffB); PG8_STAGE(PG8_SB(1, 1), b3 + hstep, voffB); PG8_STAGE(PG8_SA(1, 0), a3, voffA);
            PG8_WAIT_V(8); PG8_WAIT_L(0); PG8_BAR; PG8_MMA(1, 0, At, B0); PG8_MMA(1, 1, At, B1); PG8_BAR; PG8_SCHED;
            } else {
            PG8_LDB(B0, 0, 0); PG8_SCHED; PG8_LDA(At, 0, 0); PG8_STAGE(PG8_SA(1, 1), a1 + hstep, voffA);
            PG8_WAIT_L(8); PG8_BAR; PG8_WAIT_L(0); PG8_MMA(0, 0, At, B0); PG8_BAR; PG8_SCHED;
            PG8_LDB(B1, 0, 1); PG8_STAGE(PG8_SB(0, 0), b2, voffB);
            PG8_BAR; PG8_WAIT_L(0); PG8_MMA(0, 1, At, B1); PG8_BAR;
            PG8_LDA(At, 0, 1); PG8_STAGE(PG8_SA(0, 0), a2, voffA);
            PG8_BAR; PG8_WAIT_L(0); PG8_MMA(1, 0, At, B0); PG8_BAR; PG8_SCHED;
            PG8_STAGE(PG8_SB(0, 1), b2 + hstep, voffB);
            PG8_WAIT_V(6); PG8_BAR; PG8_MMA(1, 1, At, B1); PG8_BAR;
            PG8_LDB(B0, 1, 0); PG8_SCHED; PG8_LDA(At, 1, 0); PG8_STAGE(PG8_SA(0, 1), a2 + hstep, voffA);
            PG8_WAIT_L(8); PG8_BAR; PG8_WAIT_L(0); PG8_MMA(0, 0, At, B0); PG8_BAR; PG8_SCHED;
            PG8_LDB(B1, 1, 1); PG8_STAGE(PG8_SB(1, 0), b3, voffB);
            PG8_BAR; PG8_WAIT_L(0); PG8_MMA(0, 1, At, B1); PG8_BAR;
            PG8_LDA(At, 1, 1); PG8_STAGE(PG8_SA(1, 0), a3, voffA);
            PG8_BAR; PG8_WAIT_L(0); PG8_MMA(1, 0, At, B0); PG8_BAR; PG8_SCHED;
            PG8_STAGE(PG8_SB(1, 1), b3 + hstep, voffB);
            PG8_WAIT_V(6); PG8_BAR; PG8_MMA(1, 1, At, B1); PG8_BAR;
            }
        }
        if constexpr (ALIGN_EPI) { if (wr == 0) PG8_BAR; }
        if constexpr (!Epi::AFTER_DRAIN) { E(acc, cur, wr, wc, fr, fq); S.done(cur); }
        if (!has_next) break;
#pragma unroll
        for (int a = 0; a < 2; ++a)
#pragma unroll
            for (int b = 0; b < 2; ++b)
#pragma unroll
                for (int m = 0; m < 4; ++m)
#pragma unroll
                    for (int n = 0; n < 2; ++n) acc[a][b][m][n] = (f32x4){0.f, 0.f, 0.f, 0.f};
        cur = nxt; cA = nA; cB = nB; ++ui;
        if constexpr (ALIGN_EPI) { if (wr == 1) PG8_BAR; }
    }
    PG8_WAIT_V(0);
    if constexpr (!ALIGN_EPI) { if (wr == 0) PG8_BAR; }
    PG8_BAR;
    if constexpr (Epi::AFTER_DRAIN) { E.fused(acc, cur, wr, wc, fr, fq, lds, wid, lane); S.done(cur); }
#undef PG8_SA
#undef PG8_SB
#undef PG8_STAGE
#undef PG8_LDA
#undef PG8_LDB
#undef PG8_MMA
#undef PG8_WAIT_V
#undef PG8_WAIT_L
#undef PG8_BAR
#undef PG8_SCHED
}
}

#define STAGE_OPT_INPROJ 1
#define STAGE_OPT_GATES 1
#define STAGE_OPT_Y 1
#define STAGE_OPT_WO 1
#define STAGE_OPT_GU 1
#define STAGE_OPT_DN 1
constexpr bool ANY_OPT_GEMM = STAGE_OPT_INPROJ || STAGE_OPT_GATES || STAGE_OPT_Y || STAGE_OPT_WO || STAGE_OPT_GU || STAGE_OPT_DN;
constexpr int WIN_ROWS = 39 * 256;
constexpr size_t WT_IN = 0, WT_OG = WT_IN + (size_t)WIN_ROWS * 1024 * 2, WT_OD = WT_OG + 2 * MiB, WT_O = WT_OD + 2 * MiB, WT_GU = WT_O + 2 * MiB, WT_DN = WT_GU + (size_t)2 * FF * 1024 * 2, WT_END = WT_DN + (size_t)1024 * FF * 2;
static_assert(WT_END <= 42 * MiB, "weight region");
typedef unsigned u32x4 __attribute__((ext_vector_type(4)));
typedef unsigned u32x2 __attribute__((ext_vector_type(2)));
__device__ __forceinline__ unsigned pk2(float lo, float hi) { return pg8::cvt_pk_bf16(lo, hi); }
__device__ __forceinline__ u32x2 pk4(f32x4 v) { u32x2 w; w.x = pk2(v[0], v[1]); w.y = pk2(v[2], v[3]); return w; }
__device__ __forceinline__ u32x4 pk8(f32x4 a, f32x4 b) { u32x4 w; w.x = pk2(a[0], a[1]); w.y = pk2(a[2], a[3]); w.z = pk2(b[0], b[1]); w.w = pk2(b[2], b[3]); return w; }
__device__ __forceinline__ f32x4 unpk4lo(u32x4 w) { return (f32x4){bf2f(w.x & 0xffffu), bf2f(w.x >> 16), bf2f(w.y & 0xffffu), bf2f(w.y >> 16)}; }
__device__ __forceinline__ f32x4 unpk4hi(u32x4 w) { return (f32x4){bf2f(w.z & 0xffffu), bf2f(w.z >> 16), bf2f(w.w & 0xffffu), bf2f(w.w >> 16)}; }
__device__ __forceinline__ f32x4 sig4(f32x4 v) { return (f32x4){sigmoidf_(v[0]), sigmoidf_(v[1]), sigmoidf_(v[2]), sigmoidf_(v[3])}; }
__device__ __forceinline__ f32x4 silu4(f32x4 v) { return (f32x4){siluf_(v[0]), siluf_(v[1]), siluf_(v[2]), siluf_(v[3])}; }

__device__ __forceinline__ int rope_pos(int d, int half) { const int n = d / half, dl = d % half; return 32 * (dl >> 4) + 8 * ((dl >> 2) & 3) + 4 * n + (dl & 3); }
__device__ __forceinline__ int map_win(int n) {
    if (n < C_A) return n;
    if (n < C_B) return 30 * 256 + 72 + (n - C_A);
    if (n < C_QB) return 30 * 256 + 80 + (n - C_B);
    if (n < C_VB) { const int m = n - C_QB, hd = m >> 7, d = m & 127; return (16 + (hd >> 1)) * 256 + (hd & 1) * 128 + rope_pos(d, 64); }
    if (n < C_QI) return 24 * 256 + (n - C_VB);
    if (n < C_KI) { const int m = n - C_QI, hd = m >> 6, d = m & 63; return (28 + (hd >> 2)) * 256 + ((hd >> 1) & 1) * 128 + (hd & 1) * 64 + rope_pos(d, 32); }
    if (n < C_WI) return 30 * 256 + rope_pos(n - C_KI, 32);
    if (n < C_GA) return 30 * 256 + 64 + (n - C_WI);
    return 31 * 256 + (n - C_GA);
}
__device__ __forceinline__ int map_gu(int cidx) { const int nn = cidx >= FF ? 1 : 0, f = cidx - nn * FF; return 8 * (f >> 2) + 4 * nn + (f & 3); }
template <int MAPK> __device__ __forceinline__ void transpose_item(const float* W, int K, int N, bf16_t* WT, float* scr, int item, int lane) {
    const int nblk = (N + 31) / 32, kb = item / nblk, nb = item % nblk, k0 = 64 * kb, n0 = 32 * nb;
    const int nn = n0 + (lane & 31);
#pragma unroll 8
    for (int i = 0; i < 32; ++i) { const int kk = 2 * i + (lane >> 5); scr[kk * 33 + (lane & 31)] = nn < N ? W[(size_t)(k0 + kk) * N + nn] : 0.f; }
    asm volatile("s_waitcnt lgkmcnt(0)" ::: "memory");
    const int cch = lane & 7;
#pragma unroll
    for (int j = 0; j < 4; ++j) { const int n = (lane >> 3) + 8 * j;
        if (n0 + n < N) { const float* sp = scr + (8 * cch) * 33 + n; const int row = MAPK == 1 ? map_win(n0 + n) : (MAPK == 2 ? map_gu(n0 + n) : n0 + n);
            u32x4 o; o.x = pk2(sp[0], sp[33]); o.y = pk2(sp[2 * 33], sp[3 * 33]); o.z = pk2(sp[4 * 33], sp[5 * 33]); o.w = pk2(sp[6 * 33], sp[7 * 33]);
            *(u32x4*)(WT + (size_t)row * K + k0 + 8 * cch) = o; } }
    asm volatile("s_waitcnt lgkmcnt(0)" ::: "memory");
}
__device__ __forceinline__ void phase_convert_weights(const Ctx& c, int layer, unsigned char* smem) {
    const int lane = otid() & 63, wv = otid() >> 6, gw = blockIdx.x * 8 + wv, nw = gridDim.x * 8;
    float* scr = (float*)smem + wv * (64 * 33);
    unsigned char* wt = c.ws + WS_WT;
    constexpr int I_IN = 16 * ((INC + 31) / 32), I_SQ = 16 * 32, I_GU = 16 * (2 * FF / 32), I_DN = (FF / 64) * 32;
    for (int it = gw; it < I_IN + 3 * I_SQ + I_GU + I_DN; it += nw) {
        int r = it;
        if (r < I_IN) { transpose_item<1>(c.w_in + (size_t)layer * DM * INC, DM, INC, (bf16_t*)(wt + WT_IN), scr, r, lane); continue; } r -= I_IN;
        if (r < I_SQ) { transpose_item<0>(c.w_out_gdn + (size_t)layer * DM * DM, DM, DM, (bf16_t*)(wt + WT_OG), scr, r, lane); continue; } r -= I_SQ;
        if (r < I_SQ) { transpose_item<0>(c.w_out_dsa + (size_t)layer * DM * DM, DM, DM, (bf16_t*)(wt + WT_OD), scr, r, lane); continue; } r -= I_SQ;
        if (r < I_SQ) { transpose_item<0>(c.w_o + (size_t)layer * DM * DM, DM, DM, (bf16_t*)(wt + WT_O), scr, r, lane); continue; } r -= I_SQ;
        if (r < I_GU) { transpose_item<2>(c.w_gate_up + (size_t)layer * DM * 2 * FF, DM, 2 * FF, (bf16_t*)(wt + WT_GU), scr, r, lane); continue; } r -= I_GU;
        transpose_item<0>(c.w_down + (size_t)layer * FF * DM, FF, DM, (bf16_t*)(wt + WT_DN), scr, r, lane);
    }
}

#define EPI_ROWS(...) _Pragma("unroll") for (int ai = 0; ai < 2; ++ai) _Pragma("unroll") for (int m = 0; m < 4; ++m) { const int r = u.pm * 256 + ai * 128 + wr * 64 + m * 16 + fr; __VA_ARGS__ asm volatile("" ::: "memory"); }
struct EpiInProj {
    static constexpr bool PERM = true, AFTER_DRAIN = false;
    unsigned char* R; const float *cosA, *sinA, *cosI, *sinI, *a_log, *dt_bias;
    __device__ __forceinline__ void operator()(const f32x4 (&acc)[2][2][4][2], const pg8::Unit& u, int wr, int wc, int fr, int fq) const {
        asm volatile("" : "+v"(fr), "+v"(fq));
        const int pn = u.pn, cw = wc * 32 + 8 * fq;
        if (pn < 12) { bf16_t* Q = (bf16_t*)(R + R_QKVA); bf16_t* H = (bf16_t*)(R + R_HALO);
            EPI_ROWS(_Pragma("unroll") for (int bj = 0; bj < 2; ++bj) { const int col = pn * 256 + bj * 128 + cw; const u32x4 w = pk8(acc[ai][bj][m][0], acc[ai][bj][m][1]);
                *(u32x4*)(Q + (size_t)r * 3072 + col) = w; if (m == 3 && fr >= 13) *(u32x4*)(H + ((size_t)(r >> 6) * 3 + (fr - 13)) * 3072 + col) = w; }) }
        else if (pn < 16) { bf16_t* Z = (bf16_t*)(R + R_ZS);
            EPI_ROWS(_Pragma("unroll") for (int bj = 0; bj < 2; ++bj) { const int col = (pn - 12) * 256 + bj * 128 + cw; *(u32x4*)(Z + (size_t)r * 1024 + col) = pk8(silu4(acc[ai][bj][m][0]), silu4(acc[ai][bj][m][1])); }) }
        else if (pn < 24) { bf16_t* D = (bf16_t*)(R + ((pn - 16) >> 2 ? R_KB : R_QB)); const int dl = 16 * wc + 4 * fq;
            EPI_ROWS(const int pos = r % SEQ; const f32x4 cs = *(const f32x4*)(cosA + pos * 64 + dl), sn = *(const f32x4*)(sinA + pos * 64 + dl);
                _Pragma("unroll") for (int bj = 0; bj < 2; ++bj) { const int hd = ((pn - 16) & 3) * 2 + bj; const f32x4 x1 = acc[ai][bj][m][0], x2 = acc[ai][bj][m][1];
                    bf16_t* dp = D + (size_t)r * 1024 + hd * 128 + dl; *(u32x2*)dp = pk4(x1 * cs - x2 * sn); *(u32x2*)(dp + 64) = pk4(x2 * cs + x1 * sn); }) }
        else if (pn < 28) { bf16_t* V = (bf16_t*)(R + R_VB);
            EPI_ROWS(_Pragma("unroll") for (int bj = 0; bj < 2; ++bj) { const int col = (pn - 24) * 256 + bj * 128 + cw; *(u32x4*)(V + (size_t)r * 1024 + col) = pk8(acc[ai][bj][m][0], acc[ai][bj][m][1]); }) }
        else if (pn < 30) { bf16_t* QI = (bf16_t*)(R + R_QI); const int dl = 16 * (wc & 1) + 4 * fq;
            EPI_ROWS(const int pos = r % SEQ; const f32x4 cs = *(const f32x4*)(cosI + pos * 32 + dl), sn = *(const f32x4*)(sinI + pos * 32 + dl);
                _Pragma("unroll") for (int bj = 0; bj < 2; ++bj) { const int hd = (pn - 28) * 4 + bj * 2 + (wc >> 1); const f32x4 x1 = acc[ai][bj][m][0], x2 = acc[ai][bj][m][1];
                    bf16_t* dp = QI + (size_t)r * 512 + hd * 64 + dl; *(u32x2*)dp = pk4(x1 * cs - x2 * sn); *(u32x2*)(dp + 32) = pk4(x2 * cs + x1 * sn); }) }
        else {
            if (wc < 2) { bf16_t* KI = (bf16_t*)(R + R_KI); const int dl = 16 * wc + 4 * fq;
                EPI_ROWS(const int pos = r % SEQ; const f32x4 cs = *(const f32x4*)(cosI + pos * 32 + dl), sn = *(const f32x4*)(sinI + pos * 32 + dl);
                    const f32x4 x1 = acc[ai][0][m][0], x2 = acc[ai][0][m][1]; bf16_t* dp = KI + (size_t)r * 64 + dl;
                    *(u32x2*)dp = pk4((x1 * cs - x2 * sn) * 0.125f); *(u32x2*)(dp + 32) = pk4((x2 * cs + x1 * sn) * 0.125f);) }
            else if (wc == 2) {
                if (fq == 0) { float* WI = (float*)(R + R_WI); EPI_ROWS(*(f32x4*)(WI + r * 8) = acc[ai][0][m][0] * 0.35355339059327373f; *(f32x4*)(WI + r * 8 + 4) = acc[ai][0][m][1] * 0.35355339059327373f;) }
                else if (fq == 1) { float* GG = (float*)(R + R_GG);
                    EPI_ROWS(_Pragma("unroll") for (int n = 0; n < 2; ++n) { f32x4 o; _Pragma("unroll") for (int j = 0; j < 4; ++j) o[j] = -__expf(a_log[n * 4 + j]) * softplusf_(acc[ai][0][m][n][j] + dt_bias[n * 4 + j]); *(f32x4*)(GG + r * 8 + n * 4) = o; }) }
                else if (fq == 2) { float* BT = (float*)(R + R_BETA); EPI_ROWS(*(f32x4*)(BT + r * 8) = sig4(acc[ai][0][m][0]); *(f32x4*)(BT + r * 8 + 4) = sig4(acc[ai][0][m][1]);) }
            }
        }
    }
};
struct EpiGates {
    static constexpr bool PERM = true, AFTER_DRAIN = false; bf16_t* SG;
    __device__ __forceinline__ void operator()(const f32x4 (&acc)[2][2][4][2], const pg8::Unit& u, int wr, int wc, int fr, int fq) const {
        EPI_ROWS(_Pragma("unroll") for (int bj = 0; bj < 2; ++bj) { const int col = u.pn * 256 + bj * 128 + wc * 32 + 8 * fq; *(u32x4*)(SG + (size_t)r * 2048 + col) = pk8(sig4(acc[ai][bj][m][0]), sig4(acc[ai][bj][m][1])); })
    }
};
template <int WHICH> struct EpiY {
    static constexpr bool PERM = true, AFTER_DRAIN = false; const bf16_t* SG; bf16_t* MG;
    __device__ __forceinline__ void operator()(const f32x4 (&acc)[2][2][4][2], const pg8::Unit& u, int wr, int wc, int fr, int fq) const {
        EPI_ROWS(_Pragma("unroll") for (int bj = 0; bj < 2; ++bj) { const int col = u.pn * 256 + bj * 128 + wc * 32 + 8 * fq;
            const u32x4 g = *(const u32x4*)(SG + (size_t)r * 2048 + WHICH * 1024 + col); f32x4 lo = unpk4lo(g) * acc[ai][bj][m][0], hi = unpk4hi(g) * acc[ai][bj][m][1];
            if (WHICH == 1) { const u32x4 p = *(const u32x4*)(MG + (size_t)r * 1024 + col); lo += unpk4lo(p); hi += unpk4hi(p); }
            *(u32x4*)(MG + (size_t)r * 1024 + col) = pk8(lo, hi); })
    }
};
struct EpiResid {
    static constexpr bool PERM = true, AFTER_DRAIN = false; const float* base; float* out;
    __device__ __forceinline__ void operator()(const f32x4 (&acc)[2][2][4][2], const pg8::Unit& u, int wr, int wc, int fr, int fq) const {
        EPI_ROWS(_Pragma("unroll") for (int bj = 0; bj < 2; ++bj) { const size_t off = (size_t)r * 1024 + u.pn * 256 + bj * 128 + wc * 32 + 8 * fq;
            const f32x4 b0 = *(const f32x4*)(base + off), b1 = *(const f32x4*)(base + off + 4); *(f32x4*)(out + off) = b0 + acc[ai][bj][m][0]; *(f32x4*)(out + off + 4) = b1 + acc[ai][bj][m][1]; })
    }
};
struct EpiSwiglu {
    static constexpr bool PERM = true, AFTER_DRAIN = false; bf16_t* ACT;
    __device__ __forceinline__ void operator()(const f32x4 (&acc)[2][2][4][2], const pg8::Unit& u, int wr, int wc, int fr, int fq) const {
        EPI_ROWS(_Pragma("unroll") for (int bj = 0; bj < 2; ++bj) { const int f0 = u.pn * 128 + bj * 64 + wc * 16 + 4 * fq; *(u32x2*)(ACT + (size_t)r * FF + f0) = pk4(silu4(acc[ai][bj][m][0]) * acc[ai][bj][m][1]); })
    }
};

#define STAGE_OPT_GDN 1
typedef short bf16x8 __attribute__((ext_vector_type(8)));
typedef float f32x16 __attribute__((ext_vector_type(16)));
typedef float f32x2_t __attribute__((ext_vector_type(2)));
typedef __bf16 bf16x2_t __attribute__((ext_vector_type(2)));
__device__ __forceinline__ unsigned cvtpk_s(float lo, float hi) { f32x2_t v = {lo, hi}; bf16x2_t b = __builtin_convertvector(v, bf16x2_t); return __builtin_bit_cast(unsigned, b); }
__device__ __forceinline__ int crow(int r, int hi) { return (r & 3) + 8 * (r >> 2) + 4 * hi; }
#define MFMA32(a, b, c) __builtin_amdgcn_mfma_f32_32x32x16_bf16((a), (b), (c), 0, 0, 0)
__device__ __forceinline__ bf16x8 pack_step(const f32x16& x, int s) {
    u32x4 p; p.x = cvtpk_s(x[8 * s], x[8 * s + 1]); p.y = cvtpk_s(x[8 * s + 2], x[8 * s + 3]); p.z = cvtpk_s(x[8 * s + 4], x[8 * s + 5]); p.w = cvtpk_s(x[8 * s + 6], x[8 * s + 7]);
    return __builtin_bit_cast(bf16x8, p);
}
constexpr int BLOB_WF = 0, BLOB_QDF = 16384, BLOB_KDF = 32768, BLOB_A_BYTES = 49152, BLOB_QKF = 0, BLOB_UF = 8192, BLOB_B_BYTES = 24576;
constexpr size_t P2_BLOBB = 0, P2_GLAST = 24 * MiB, P2_MASK = 25 * MiB;
__device__ __forceinline__ unsigned char* vaddrA(unsigned char* qkva, int ck, int h, int v) { const int i = (v >> 8) & 63, part = v >> 14; return qkva + ((size_t)(ck * 64 + i) * 3072 + part * 1024 + h * 128) * 2 + (v & 255); }
__device__ __forceinline__ u32x4 frag_from_rows(const bf16_t* T, int ld, int it, int ks, int lane) {
    const int r = lane & 31, hh = lane >> 5; const bf16_t* p = T + (size_t)(32 * it + r) * ld + 32 * (ks >> 1) + 16 * (ks & 1) + 4 * hh;
    const u32x2 a = *(const u32x2*)p, b = *(const u32x2*)(p + 8); return (u32x4){a.x, a.y, b.x, b.y};
}

__device__ __forceinline__ void gdn_prep_unit(const Ctx& c, int layer, int unit, unsigned char* smem) {
    const int tid = otid(), lane = tid & 63, wv = tid >> 6;
    const int h = unit & 7, ck = unit >> 3;
    bf16_t* Q = (bf16_t*)(c.R + R_QKVA); const bf16_t* HL = (const bf16_t*)(c.R + R_HALO);
    const float* cw = c.conv_w + (size_t)layer * 4 * 3072;
    float* X = (float*)smem;
    float* rq = X + 64 * 388; float* rk = rq + 64; float* gam = rk + 64; float* eg = gam + 64; float* egl = eg + 64; float* bet = egl + 64; float* gg = bet + 64;
    bf16_t* KNb = (bf16_t*)(gg + 64); bf16_t* QNb = KNb + 64 * 136;
    float* AM = (float*)(QNb + 64 * 136);
    const int row0 = ck * 64;
    __syncthreads();
    bf16_t* RAW = KNb;
    { const bool first = (row0 % SEQ) == 0;
      for (int p = tid; p < 67 * 48; p += 512) { const int rr = p / 48, cq = p - rr * 48, part = cq >> 4, col = part * 1024 + h * 128 + (cq & 15) * 8;
          u32x4 v = {0u, 0u, 0u, 0u};
          if (rr >= 3) v = *(const u32x4*)(Q + (size_t)(row0 + rr - 3) * 3072 + col);
          else if (!first) v = *(const u32x4*)(HL + ((size_t)(ck - 1) * 3 + rr) * 3072 + col);
          *(u32x4*)(RAW + rr * 384 + cq * 8) = v; } }
    __syncthreads();
    for (int q = tid; q < 4 * 384; q += 512) {
        const int g = q / 384, ch = q - g * 384, part = ch >> 7, col = part * 1024 + h * 128 + (ch & 127);
        const float w0 = cw[col], w1 = cw[3072 + col], w2 = cw[2 * 3072 + col], w3 = cw[3 * 3072 + col];
        const bf16_t* p = RAW + (16 * g) * 384 + ch;
        float x3 = bf2f(p[0]), x2 = bf2f(p[384]), x1 = bf2f(p[2 * 384]);
#pragma unroll
        for (int r = 0; r < 16; ++r) { const float xv = bf2f(p[(r + 3) * 384]); X[(16 * g + r) * 388 + ch] = siluf_(w0 * x3 + w1 * x2 + w2 * x1 + w3 * xv); x3 = x2; x2 = x1; x1 = xv; }
    }
    if (tid < 64) { gg[tid] = ((const float*)(c.R + R_GG))[(row0 + tid) * 8 + h]; bet[tid] = ((const float*)(c.R + R_BETA))[(row0 + tid) * 8 + h]; }
    __syncthreads();
    for (int p = wv * 16; p < wv * 16 + 16; ++p) { const int which = p & 1, i = p >> 1; const f32x2_t v = *(const f32x2_t*)(X + i * 388 + which * 128 + lane * 2);
        const float rs = rsqrtf(wave_sum(v.x * v.x + v.y * v.y) + EPS); if (lane == 0) { if (which) rk[i] = rs; else rq[i] = rs; } }
    if (wv == 7) { float v = gg[lane];
#pragma unroll
        for (int o = 1; o < 64; o <<= 1) { const float t = __shfl_up(v, o); if (lane >= o) v += t; }
        const float gl = __shfl(v, 63); gam[lane] = v; eg[lane] = __expf(v); egl[lane] = __expf(gl - v);
        if (lane == 0) ((float*)(c.R + R_P2 + P2_GLAST))[ck * 8 + h] = __expf(gl); }
    __syncthreads();
    for (int q = tid; q < 64 * 64; q += 512) { const int i = q >> 6, d = (q & 63) * 2; const f32x2_t a = *(const f32x2_t*)(X + i * 388 + d), b = *(const f32x2_t*)(X + i * 388 + 128 + d);
        const float sq = rq[i] * 0.08838834764831845f, sk = rk[i];
        *(unsigned*)(QNb + i * 136 + d) = cvtpk_s(a.x * sq, a.y * sq); *(unsigned*)(KNb + i * 136 + d) = cvtpk_s(b.x * sk, b.y * sk); }
    __syncthreads();
    { const int prod = wv >> 2, ti = (wv >> 1) & 1, tj = wv & 1, r = lane & 31, hh = lane >> 5;
      const bf16_t* Ab = (prod ? QNb : KNb) + (32 * ti + r) * 136 + 8 * hh; const bf16_t* Bb = KNb + (32 * tj + r) * 136 + 8 * hh;
      f32x16 acc = {};
#pragma unroll
      for (int ks = 0; ks < 8; ++ks) acc = MFMA32(*(const bf16x8*)(Ab + 16 * ks), *(const bf16x8*)(Bb + 16 * ks), acc);
      const int jj = 32 * tj + r; const float gj = gam[jj];
#pragma unroll
      for (int rr = 0; rr < 16; ++rr) { const int i = 32 * ti + crow(rr, hh); const float dec = __expf(gam[i] - gj);
          if (prod == 0) AM[i * 68 + jj] = (jj < i) ? bet[i] * acc[rr] * dec : 0.f;
          else ((bf16_t*)((unsigned char*)(X + i * 388) + 528))[jj] = f2bf((jj <= i) ? acc[rr] * dec : 0.f); } }
    __syncthreads();
    unsigned char* Qb = (unsigned char*)Q; unsigned char* PB = c.R + R_P2 + P2_BLOBB + (size_t)(ck * 8 + h) * BLOB_B_BYTES;
    int zl = 0; asm volatile("" : "+v"(zl));
    if (wv < 4) {
        float xs[64];
        if (tid < 128) {
#pragma unroll
            for (int i = 0; i < 64; ++i) xs[i] = X[i * 388 + 256 + tid] * bet[i + zl]; }
        else {
#pragma unroll
            for (int i = 0; i < 64; ++i) xs[i] = bf2f(KNb[i * 136 + (tid - 128)]) * (bet[i + zl] * eg[i + zl]); }
#pragma unroll
        for (int i = 1; i < 64; ++i) { float a = xs[i];
#pragma unroll
            for (int j4 = 0; j4 < i; j4 += 4) { const f32x4 am = *(const f32x4*)(AM + i * 68 + j4 + zl);
                a -= am[0] * xs[j4]; if (j4 + 1 < i) a -= am[1] * xs[j4 + 1]; if (j4 + 2 < i) a -= am[2] * xs[j4 + 2]; if (j4 + 3 < i) a -= am[3] * xs[j4 + 3]; }
            xs[i] = a; }
#pragma unroll
        for (int i = 0; i < 64; ++i) ((bf16_t*)(X + i * 388))[tid] = f2bf(xs[i]);
    } else {
        const int t4 = tid - 256;
        for (int f = t4; f < 1024; f += 256) {
            const int ln = f & 63, ks = (f >> 6) & 7, it = f >> 9; const u32x4 w = frag_from_rows(QNb, 136, it, ks, ln); const float sc = eg[32 * it + (ln & 31)];
            const f32x4 lo = unpk4lo(w) * sc, hi = unpk4hi(w) * sc; *(u32x4*)vaddrA(Qb, ck, h, BLOB_QDF + f * 16) = pk8(lo, hi); }
        for (int f = t4; f < 1024; f += 256) {
            const int ln = f & 63, ks = (f >> 6) & 3, dt = f >> 8, r = ln & 31, hh = ln >> 5, d = 32 * dt + r, ib = 32 * (ks >> 1) + 16 * (ks & 1) + 4 * hh; float v[8];
#pragma unroll
            for (int j = 0; j < 8; ++j) { const int i = ib + 8 * (j >> 2) + (j & 3); v[j] = bf2f(KNb[i * 136 + d]) * egl[i]; }
            *(u32x4*)vaddrA(Qb, ck, h, BLOB_KDF + f * 16) = pk8((f32x4){v[0], v[1], v[2], v[3]}, (f32x4){v[4], v[5], v[6], v[7]}); }
        for (int f = t4; f < 512; f += 256) {
            const int ln = f & 63, ks = (f >> 6) & 3, it = f >> 8; *(u32x4*)(PB + BLOB_QKF + f * 16) = frag_from_rows((const bf16_t*)((const unsigned char*)X + 528), 776, it, ks, ln); }
    }
    __syncthreads();
    for (int f = tid; f < 1024; f += 512) { const int ln = f & 63, ks = (f >> 6) & 7, it = f >> 9; *(u32x4*)vaddrA(Qb, ck, h, BLOB_WF + f * 16) = frag_from_rows((const bf16_t*)X + 128, 776, it, ks, ln); }
    { const int ln = tid & 63, it = (tid >> 6) & 1, eb = tid >> 7, cc = ln & 31, hi = ln >> 5; unsigned wds[8];
#pragma unroll
      for (int rp = 0; rp < 8; ++rp) { const int i0 = 32 * it + crow(2 * rp, hi), i1 = 32 * it + crow(2 * rp + 1, hi);
          wds[rp] = (unsigned)((const bf16_t*)(X + i0 * 388))[32 * eb + cc] | ((unsigned)((const bf16_t*)(X + i1 * 388))[32 * eb + cc] << 16); }
      u32x4* dst = (u32x4*)(PB + BLOB_UF + ((eb * 2 + it) * 64 + ln) * 32); dst[0] = (u32x4){wds[0], wds[1], wds[2], wds[3]}; dst[1] = (u32x4){wds[4], wds[5], wds[6], wds[7]}; }
}

constexpr int SC_BUF = 57344, SC_OBUF = 2 * SC_BUF, SC_OLD = 136;
__device__ __forceinline__ void gdn_scan_unit(const Ctx& c, int layer, int split, int su, unsigned char* smem) {
    const int tid = otid(), lane = tid & 63, wv = __builtin_amdgcn_readfirstlane(tid >> 6);
    const int bl = su >> 3, h = su & 7, ck0 = bl * (SEQ / 64);
    unsigned char* Qb = c.R + R_QKVA; const unsigned char* PB0 = c.R + R_P2 + P2_BLOBB; const float* GL = (const float*)(c.R + R_P2 + P2_GLAST);
    const bf16_t* ZS = (const bf16_t*)(c.R + R_ZS); const float* gn = c.gdn_norm + layer * 128;
    __syncthreads();
#pragma unroll
    for (int q = 0; q < 7; ++q) { const int v = (q * 512 + tid) * 16; const unsigned char* src = q < 6 ? vaddrA(Qb, ck0, h, v) : PB0 + (size_t)(ck0 * 8 + h) * BLOB_B_BYTES + BLOB_QKF + (v - BLOB_A_BYTES);
        *(u32x4*)(smem + v) = *(const u32x4*)src; }
    f32x16 S[4] = {};
    u32x4 zsn[4] = {};
    u32x4 un[4];
    if (wv < 4) { const u32x4* up = (const u32x4*)(PB0 + (size_t)(ck0 * 8 + h) * BLOB_B_BYTES + BLOB_UF + (wv * 2 * 64 + lane) * 32); un[0] = up[0]; un[1] = up[1]; un[2] = up[128]; un[3] = up[129]; }
    __syncthreads();
    constexpr int NCH = SEQ / 64;
#pragma unroll 1
    for (int n = 0; n <= NCH; ++n) {
        const int ck = ck0 + n; unsigned char* buf = smem + (n & 1) * SC_BUF; bf16_t* ob = (bf16_t*)(smem + SC_OBUF) + (n & 1) * 64 * SC_OLD;
        if (wv < 4) {
          if (n < NCH) {
            int lane = tid & 63; asm volatile("" : "+v"(lane));
            const float gl = GL[ck * 8 + h];
            bf16x8 Sb[8];
#pragma unroll
            for (int t = 0; t < 4; ++t) { Sb[2 * t] = pack_step(S[t], 0); Sb[2 * t + 1] = pack_step(S[t], 1); }
            f32x16 vn[2], o[2];
#pragma unroll
            for (int it = 0; it < 2; ++it) { f32x16 a = {};
#pragma unroll
                for (int ks = 0; ks < 8; ++ks) a = MFMA32(*(const bf16x8*)(buf + BLOB_WF + ((it * 8 + ks) * 64 + lane) * 16), Sb[ks], a);
                const u32x4 u0 = un[2 * it], u1 = un[2 * it + 1];
                const unsigned uw[8] = {u0.x, u0.y, u0.z, u0.w, u1.x, u1.y, u1.z, u1.w};
#pragma unroll
                for (int r = 0; r < 16; ++r) vn[it][r] = bf2f((r & 1) ? (uw[r >> 1] >> 16) : (uw[r >> 1] & 0xffffu)) - a[r];
                __builtin_amdgcn_sched_barrier(0); }
            if (n + 1 < NCH) { const u32x4* up = (const u32x4*)(PB0 + (size_t)((ck + 1) * 8 + h) * BLOB_B_BYTES + BLOB_UF + (wv * 2 * 64 + lane) * 32); un[0] = up[0]; un[1] = up[1]; un[2] = up[128]; un[3] = up[129]; }
#pragma unroll
            for (int it = 0; it < 2; ++it) { f32x16 b = {};
#pragma unroll
                for (int ks = 0; ks < 8; ++ks) b = MFMA32(*(const bf16x8*)(buf + BLOB_QDF + ((it * 8 + ks) * 64 + lane) * 16), Sb[ks], b);
                o[it] = b; __builtin_amdgcn_sched_barrier(0); }
            bf16x8 vb[4];
#pragma unroll
            for (int it = 0; it < 2; ++it) { vb[2 * it] = pack_step(vn[it], 0); vb[2 * it + 1] = pack_step(vn[it], 1); }
#pragma unroll
            for (int it = 0; it < 2; ++it)
#pragma unroll
                for (int ks = 0; ks < 4; ++ks) o[it] = MFMA32(*(const bf16x8*)(buf + BLOB_A_BYTES + BLOB_QKF + ((it * 4 + ks) * 64 + lane) * 16), vb[ks], o[it]);
            __builtin_amdgcn_sched_barrier(0);
#pragma unroll
            for (int t = 0; t < 4; ++t) { S[t] = S[t] * gl;
#pragma unroll
                for (int ks = 0; ks < 4; ++ks) S[t] = MFMA32(*(const bf16x8*)(buf + BLOB_KDF + ((t * 4 + ks) * 64 + lane) * 16), vb[ks], S[t]);
                __builtin_amdgcn_sched_barrier(0); }
            { const int cc = lane & 31, hi = lane >> 5;
#pragma unroll
              for (int it = 0; it < 2; ++it)
#pragma unroll
                  for (int r = 0; r < 16; ++r) ob[(32 * it + crow(r, hi)) * SC_OLD + 32 * wv + cc] = f2bf(o[it][r]); }
          }
        } else {
            int t4 = tid - 256; asm volatile("" : "+v"(t4));
            if (n + 1 < NCH) {
                const unsigned char* pa = Qb + ((size_t)((ck + 1) * 64 + (t4 >> 4)) * 3072 + h * 128) * 2 + (t4 & 15) * 16;
                const unsigned char* pb = PB0 + (size_t)((ck + 1) * 8 + h) * BLOB_B_BYTES + BLOB_QKF + t4 * 16;
                PG8_LAS unsigned char* nb = (PG8_LAS unsigned char*)smem + ((n + 1) & 1) * SC_BUF + (wv - 4) * 1024;
#pragma unroll
                for (int q = 0; q < 12; ++q) __builtin_amdgcn_global_load_lds((const unsigned*)(pa + (size_t)(q & 3) * 16 * 6144 + (q >> 2) * 2048), (PG8_LAS unsigned*)(nb + q * 4096), 16, 0, 0);
                __builtin_amdgcn_global_load_lds((const unsigned*)pb, (PG8_LAS unsigned*)(nb + 12 * 4096), 16, 0, 0);
                __builtin_amdgcn_global_load_lds((const unsigned*)(pb + 4096), (PG8_LAS unsigned*)(nb + 13 * 4096), 16, 0, 0); }
            u32x4 zc[4] = {zsn[0], zsn[1], zsn[2], zsn[3]};
            if (n < NCH) { const bf16_t* zp = ZS + ((size_t)ck * 64 + (t4 >> 2)) * 1024 + h * 128 + (t4 & 3) * 32;
#pragma unroll
                for (int q = 0; q < 4; ++q) zsn[q] = *(const u32x4*)(zp + 8 * q); }
            if (n > 0) {
                const bf16_t* po = (const bf16_t*)(smem + SC_OBUF) + ((n - 1) & 1) * 64 * SC_OLD; const int i = t4 >> 2, qc = (t4 & 3) * 32;
                const size_t rowl = (size_t)(ck - 1) * 64 + i; float ss = 0.f;
#pragma unroll
                for (int q = 0; q < 4; ++q) { const u32x4 w = *(const u32x4*)(po + i * SC_OLD + qc + 8 * q); const f32x4 a = unpk4lo(w), b = unpk4hi(w);
#pragma unroll
                    for (int j = 0; j < 4; ++j) ss += a[j] * a[j] + b[j] * b[j]; }
                ss += __shfl_xor(ss, 1); ss += __shfl_xor(ss, 2); const float rs = rsqrtf(ss * (1.f / 128.f) + EPS);
#pragma unroll
                for (int q = 0; q < 4; ++q) { const u32x4 w = *(const u32x4*)(po + i * SC_OLD + qc + 8 * q); const u32x4 z = zc[q];
                    const f32x4 ga = *(const f32x4*)(gn + qc + 8 * q), gb = *(const f32x4*)(gn + qc + 8 * q + 4);
                    const f32x4 oa = unpk4lo(w) * rs * ga * unpk4lo(z), obv = unpk4hi(w) * rs * gb * unpk4hi(z);
                    *(u32x4*)(c.OA + ((size_t)split * MS + rowl) * 1024 + h * 128 + qc + 8 * q) = pk8(oa, obv); } }
            asm volatile("s_waitcnt vmcnt(0)" ::: "memory");
        }
        __syncthreads();
    }
}
__device__ __forceinline__ void phase_gdn_prep(const Ctx& c, int layer, unsigned char* smem) { for (int u = blockIdx.x; u < (MS / 64) * 8; u += gridDim.x) gdn_prep_unit(c, layer, u, smem); }
__device__ __forceinline__ void phase_gdn_scan(const Ctx& c, int layer, int split, unsigned char* smem) { for (int u = blockIdx.x; u < BPS * 8; u += gridDim.x) gdn_scan_unit(c, layer, split, u, smem); }

#define STAGE_OPT_DSA 1
#ifndef PROBE_DUP_MASK
#define PROBE_DUP_MASK 0
#endif
__device__ __forceinline__ unsigned fkey(float x) { const unsigned u = __float_as_uint(x); return (u & 0x80000000u) ? ~u : (u | 0x80000000u); }
__device__ __forceinline__ float fkey_inv(unsigned k) { return __uint_as_float((k & 0x80000000u) ? (k & 0x7fffffffu) : ~k); }
constexpr int SL_QIF = 0, SL_WIL = 16384, SL_ST = 16896, SL_HIST = 18432, SL_MWG = 34816, SL_MWE = 43008, SL_CAND = 51200;
__device__ __forceinline__ void dsa_select_unit(const Ctx& c, int unit, unsigned char* smem) {
    const int tid = otid(), lane = tid & 63, wv = __builtin_amdgcn_readfirstlane(tid >> 6), cc = lane & 31, hi = lane >> 5;
    const int bl = unit & (BPS - 1), qg = (SEQ / 16 - 1) - unit / BPS, t0 = 16 * qg, rb = bl * SEQ, row0 = rb + t0, nkt = (t0 + 47) >> 5;
    const bf16_t* QI = (const bf16_t*)(c.R + R_QI); const bf16_t* KI = (const bf16_t*)(c.R + R_KI); const float* WI = (const float*)(c.R + R_WI);
    float* WIL = (float*)(smem + SL_WIL); unsigned* ST = (unsigned*)(smem + SL_ST); float* STf = (float*)ST; unsigned* HIST = (unsigned*)(smem + SL_HIST);
    unsigned* MWG = (unsigned*)(smem + SL_MWG); unsigned* MWE = (unsigned*)(smem + SL_MWE); float* CAND = (float*)(smem + SL_CAND);
    const float NINF = -__builtin_inff();
    __syncthreads();
    for (int p = tid; p < 1024; p += 512) { const int f = p >> 6, ln = p & 63, rt = f >> 2, s = f & 3, r = ln & 31, hh = ln >> 5;
        *(u32x4*)(smem + SL_QIF + p * 16) = *(const u32x4*)(QI + (size_t)(row0 + 4 * rt + (r >> 3)) * 512 + (r & 7) * 64 + 16 * s + 8 * hh); }
    if (tid < 128) WIL[tid] = WI[(row0 + (tid >> 3)) * 8 + (tid & 7)];
    for (int p = tid; p < 4096; p += 512) MWG[p] = 0u;
    if (tid < 192) ST[tid] = (tid < 16) ? 0xffffffffu : 0u;
    __syncthreads();
    float sc[16][4][2];
    bf16x8 bq[3][4];
#define SEL_LOADB(slot, ktl_) do { if (wv + 8 * (ktl_) < nkt) { const bf16_t* kp_ = KI + (size_t)(rb + 32 * (wv + 8 * (ktl_)) + cc) * 64 + 8 * hi; \
        _Pragma("unroll") for (int s_ = 0; s_ < 4; ++s_) bq[slot][s_] = *(const bf16x8*)(kp_ + 16 * s_); } } while (0)
    SEL_LOADB(0, 0); SEL_LOADB(1, 1);
#pragma unroll
    for (int ktl = 0; ktl < 16; ++ktl) {
        const int kt = wv + 8 * ktl;
        if (ktl + 2 < 16) SEL_LOADB((ktl + 2) % 3, ktl + 2);
        if (kt < nkt) {
            const int key = 32 * kt + cc;
#pragma unroll
            for (int rt = 0; rt < 4; ++rt) {
                f32x16 acc = {};
#pragma unroll
                for (int s = 0; s < 4; ++s) acc = MFMA32(*(const bf16x8*)(smem + SL_QIF + ((rt * 4 + s) * 64 + lane) * 16), bq[ktl % 3][s], acc);
                float p[4];
#pragma unroll
                for (int qq = 0; qq < 4; ++qq) { const f32x4 w4 = *(const f32x4*)(WIL + (4 * rt + qq) * 8 + 4 * hi);
                    p[qq] = w4[0] * fmaxf(acc[4 * qq], 0.f) + w4[1] * fmaxf(acc[4 * qq + 1], 0.f) + w4[2] * fmaxf(acc[4 * qq + 2], 0.f) + w4[3] * fmaxf(acc[4 * qq + 3], 0.f); }
                const auto r01 = __builtin_amdgcn_permlane32_swap(__float_as_uint(p[0]), __float_as_uint(p[1]), false, false);
                const auto r23 = __builtin_amdgcn_permlane32_swap(__float_as_uint(p[2]), __float_as_uint(p[3]), false, false);
                float s0 = __uint_as_float(r01[0]) + __uint_as_float(r01[1]) + 0.f, s1 = __uint_as_float(r23[0]) + __uint_as_float(r23[1]) + 0.f;
                if (key > t0 + 4 * rt + hi) s0 = NINF;
                if (key > t0 + 4 * rt + 2 + hi) s1 = NINF;
                sc[ktl][rt][0] = s0; sc[ktl][rt][1] = s1;
            }
        } else {
#pragma unroll
            for (int rt = 0; rt < 4; ++rt) { sc[ktl][rt][0] = NINF; sc[ktl][rt][1] = NINF; }
        }
    }
#undef SEL_LOADB
    if (t0 >= TOPK) {
        {
#pragma unroll
          for (int rt = 0; rt < 4; ++rt)
#pragma unroll
              for (int i = 0; i < 2; ++i) { float mn = __builtin_inff(), mx = NINF;
#pragma unroll
                  for (int ktl = 0; ktl < 16; ++ktl) { const float x = sc[ktl][rt][i]; mx = fmaxf(mx, x); mn = (x > NINF) ? fminf(mn, x) : mn; }
#pragma unroll
                  for (int o = 1; o < 32; o <<= 1) { mn = fminf(mn, __shfl_xor(mn, o)); mx = fmaxf(mx, __shfl_xor(mx, o)); }
                  if (cc == 0 && mx > NINF) { const int q = 4 * rt + 2 * i + hi; atomicMin(&ST[q], fkey(mn)); atomicMax(&ST[16 + q], fkey(mx)); } } }
        __syncthreads();
        if (tid < 16) { STf[32 + tid] = fkey_inv(ST[tid]); STf[48 + tid] = fkey_inv(ST[16 + tid]); ST[64 + tid] = TOPK; ST[96 + tid] = 0u; }
        __syncthreads();
#pragma unroll 1
        for (int level = 0; level < 12; ++level) {
            if (tid < 16 && ST[96 + tid] == 0u && STf[32 + tid] == STf[48 + tid]) { STf[80 + tid] = STf[32 + tid]; ST[96 + tid] = 1u; }
            for (int p = tid; p < 4096; p += 512) HIST[p] = 0u;
            if (tid == 0) ST[176] = 0u;
            if (tid < 16) { ST[144 + tid] = 0u; ST[tid] = 0xffffffffu; ST[16 + tid] = 0u; }
            __syncthreads();
#pragma unroll
            for (int rt = 0; rt < 4; ++rt)
#pragma unroll
                for (int i = 0; i < 2; ++i) { const int q = 4 * rt + 2 * i + hi;
                    if (ST[96 + q] == 0u) { const float lo = STf[32 + q], hv = STf[48 + q], scale = 256.f / (hv - lo);
#pragma unroll
                        for (int ktl = 0; ktl < 16; ++ktl) { float x = sc[ktl][rt][i]; asm volatile("" : "+v"(x));
                            if (x >= lo && x <= hv) { const int b = min(255, (int)((x - lo) * scale)); atomicAdd(&HIST[q * 256 + b], 1u); } } } }
            __syncthreads();
            { const int q = 2 * wv + hi;
              if (ST[96 + q] == 0u) { const unsigned krem = ST[64 + q]; unsigned loc[8]; unsigned lsum = 0;
#pragma unroll
                  for (int j = 0; j < 8; ++j) { loc[j] = HIST[q * 256 + 255 - 8 * cc - j]; lsum += loc[j]; }
                  unsigned incl = lsum;
#pragma unroll
                  for (int o = 1; o < 32; o <<= 1) { const unsigned t = __shfl_up(incl, o, 32); if (cc >= o) incl += t; }
                  const unsigned excl = incl - lsum;
                  if (excl < krem && krem <= incl) { unsigned cum = excl; int bs = 0; unsigned cn = 0; bool found = false;
#pragma unroll
                      for (int j = 0; j < 8; ++j) { if (!found) { if (cum + loc[j] >= krem) { bs = 255 - 8 * cc - j; cn = loc[j]; found = true; } else cum += loc[j]; } }
                      ST[112 + q] = (unsigned)bs; ST[64 + q] = krem - cum; ST[128 + q] = cn; } } }
            __syncthreads();
#pragma unroll
            for (int rt = 0; rt < 4; ++rt)
#pragma unroll
                for (int i = 0; i < 2; ++i) { const int q = 4 * rt + 2 * i + hi;
                    if (ST[96 + q] == 0u) { const float lo = STf[32 + q], hv = STf[48 + q], scale = 256.f / (hv - lo); const int bs = (int)ST[112 + q]; const bool small = ST[128 + q] <= 256u;
#pragma unroll
                        for (int ktl = 0; ktl < 16; ++ktl) { float x = sc[ktl][rt][i]; asm volatile("" : "+v"(x));
                            if (x >= lo && x <= hv && min(255, (int)((x - lo) * scale)) == bs) {
                                if (small) { const unsigned pos = atomicAdd(&ST[144 + q], 1u); CAND[q * 256 + pos] = x; }
                                else { atomicMin(&ST[q], fkey(x)); atomicMax(&ST[16 + q], fkey(x)); } } } } }
            __syncthreads();
            { const int q = 2 * wv + hi;
              if (ST[96 + q] == 0u) {
                  if (ST[128 + q] <= 256u) { const int cn = (int)ST[128 + q]; const unsigned want = ST[64 + q] - 1u;
                      for (int e = cc; e < cn; e += 32) { const float v = CAND[q * 256 + e]; unsigned rank = 0;
                          for (int j = 0; j < cn; ++j) { const float o = CAND[q * 256 + j]; rank += (o > v || (o == v && j < e)) ? 1u : 0u; }
                          if (rank == want) { STf[80 + q] = v; ST[96 + q] = 1u; } } }
                  else if (cc == 0) { STf[32 + q] = fkey_inv(ST[q]); STf[48 + q] = fkey_inv(ST[16 + q]); ST[176] = 1u; } } }
            __syncthreads();
            const unsigned act = ST[176];
            __syncthreads();
            if (act == 0u) break;
        }
    } else { if (tid < 16) STf[80 + tid] = NINF; }
    __syncthreads();
#pragma unroll
    for (int rt = 0; rt < 4; ++rt)
#pragma unroll
        for (int i = 0; i < 2; ++i) { const int q = 4 * rt + 2 * i + hi; const float T = STf[80 + q]; unsigned cg = 0;
#pragma unroll
            for (int ktl = 0; ktl < 16; ++ktl) { const float x = sc[ktl][rt][i]; const int kt = wv + 8 * ktl;
                const unsigned long long bg = __ballot(x > T), be = __ballot(x == T && T > NINF);
                if (kt < nkt && cc == 0) { const unsigned g = hi ? (unsigned)(bg >> 32) : (unsigned)bg, e = hi ? (unsigned)(be >> 32) : (unsigned)be; MWG[q * 128 + kt] = g; MWE[q * 128 + kt] = e; cg += __popc(g); } }
            if (cc == 0) atomicAdd(&ST[160 + q], cg); }
    __syncthreads();
    { const int q = 2 * wv + hi; const int need = TOPK - (int)ST[160 + q];
      u32x4 g = *(const u32x4*)(MWG + q * 128 + 4 * cc), e = *(const u32x4*)(MWE + q * 128 + 4 * cc);
      unsigned ew[4] = {e.x, e.y, e.z, e.w}; unsigned lsum = __popc(ew[0]) + __popc(ew[1]) + __popc(ew[2]) + __popc(ew[3]); unsigned incl = lsum;
#pragma unroll
      for (int o = 1; o < 32; o <<= 1) { const unsigned t = __shfl_up(incl, o, 32); if (cc >= o) incl += t; }
      int before = (int)(incl - lsum);
#pragma unroll
      for (int j = 0; j < 4; ++j) { const int pc = __popc(ew[j]); int allowed = need - before; allowed = allowed < 0 ? 0 : (allowed > pc ? pc : allowed);
          unsigned w = ew[j]; while (__popc(w) > allowed) w &= ~(0x80000000u >> __clz(w));
          ew[j] = w; before += pc; }
      *(u32x4*)((unsigned*)(c.R + R_P2 + P2_MASK) + (size_t)(row0 + q) * 128 + 4 * cc) = (u32x4){g.x | ew[0], g.y | ew[1], g.z | ew[2], g.w | ew[3]}; }
}
__device__ __forceinline__ void phase_dsa_select(const Ctx& c, unsigned char* smem) { for (int u = blockIdx.x; u < MS / 16; u += gridDim.x) dsa_select_unit(c, u, smem); }

typedef short s16x4 __attribute__((ext_vector_type(4)));
constexpr int AT_TILE = 16384, AT_K = 0, AT_V = 4 * AT_TILE, AT_WS = 8 * AT_TILE, AT_LDS = AT_WS + 8 * 64 * 4 * 2;
#define KSWZ(row, colB) ((row) * 256 + ((colB) ^ (((row) & 7) << 4)))
__device__ __forceinline__ int v_st(int k, int cidx) { const int kk = (k & ~0xC) | ((k & 4) << 1) | ((k & 8) >> 1); return ((kk >> 3) * 4 + (cidx >> 5)) * 512 + ((kk & 7) * 32 + (cidx & 31)) * 2; }
__device__ __forceinline__ int v_rd_base(int lane) { return ((lane & 3) << 3) | (((lane >> 2) & 3) << 6) | (((lane >> 4) & 1) << 5) | (((lane >> 5) & 1) << 8); }
constexpr int v_rd_off(int d0, int ks, int half) { return d0 * 512 + ks * 4096 + half * 2048; }
constexpr float AT_SCALE = 0.08838834764831845f, AT_THR = 8.f;
__device__ __forceinline__ unsigned cvtpk_a(float lo, float hi) { unsigned r; asm volatile("v_cvt_pk_bf16_f32 %0, %1, %2" : "=v"(r) : "v"(lo), "v"(hi)); return r; }
__device__ __forceinline__ void at_partialSM(f32x16& p0, f32x16& p1, float& m_reg, float& alpha) {
    float pmax = p0[0];
#pragma unroll
    for (int r = 1; r < 16; ++r) pmax = fmaxf(pmax, p0[r]);
#pragma unroll
    for (int r = 0; r < 16; ++r) pmax = fmaxf(pmax, p1[r]);
    { auto rr = __builtin_amdgcn_permlane32_swap(__float_as_uint(pmax), __float_as_uint(pmax), false, false); pmax = fmaxf(__uint_as_float(rr[0]), __uint_as_float(rr[1])); }
    constexpr float C2 = 1.4426950408889634f * AT_SCALE; float mn;
    if (__builtin_expect(__all((pmax - m_reg) * AT_SCALE <= AT_THR), 1)) { mn = m_reg; alpha = 1.f; }
    else { mn = fmaxf(m_reg, pmax); alpha = __builtin_amdgcn_exp2f((m_reg - mn) * C2); m_reg = mn; }
    const float mnL = -mn * C2;
#pragma unroll
    for (int r = 0; r < 16; ++r) { p0[r] = __builtin_amdgcn_exp2f(fmaf(p0[r], C2, mnL)); p1[r] = __builtin_amdgcn_exp2f(fmaf(p1[r], C2, mnL)); }
}
__device__ __forceinline__ void at_finishSM(const f32x16& p0, const f32x16& p1, float alpha, float& l_reg, bf16x8& pa0, bf16x8& pa1, bf16x8& pa2, bf16x8& pa3) {
    float ps = 0;
#pragma unroll
    for (int r = 0; r < 16; ++r) ps += p0[r];
#pragma unroll
    for (int r = 0; r < 16; ++r) ps += p1[r];
    { auto rr = __builtin_amdgcn_permlane32_swap(__float_as_uint(ps), __float_as_uint(ps), false, false); ps = __uint_as_float(rr[0]) + __uint_as_float(rr[1]); }
    l_reg = l_reg * alpha + ps;
#define AT_PK4(P, B_, OUT) do { unsigned a0 = cvtpk_a(P[B_+0], P[B_+1]), a1 = cvtpk_a(P[B_+2], P[B_+3]); unsigned b0 = cvtpk_a(P[B_+4], P[B_+5]), b1 = cvtpk_a(P[B_+6], P[B_+7]); \
        auto r0 = __builtin_amdgcn_permlane32_swap(a0, b0, false, false); auto r1 = __builtin_amdgcn_permlane32_swap(a1, b1, false, false); \
        u32x4 w = {r0[0], r1[0], r0[1], r1[1]}; OUT = __builtin_bit_cast(bf16x8, w); } while (0)
    AT_PK4(p0, 0, pa0); AT_PK4(p0, 8, pa1); AT_PK4(p1, 0, pa2); AT_PK4(p1, 8, pa3);
#undef AT_PK4
}
__device__ __forceinline__ void at_qkt(f32x16& p0, f32x16& p1, const unsigned char* Kt, int r32, int hi, const bf16x8* qr) {
    p0 = f32x16{}; p1 = f32x16{};
    const unsigned char* kb[4];
#pragma unroll
    for (int dd = 0; dd < 4; ++dd) kb[dd] = Kt + KSWZ(r32, (dd * 16 + hi * 8) * 2);
#pragma unroll
    for (int d0 = 0; d0 < 8; ++d0) { const unsigned char* a = kb[d0 & 3] + (d0 >> 2) * 128;
        const bf16x8 b0 = *reinterpret_cast<const bf16x8*>(a), b1 = *reinterpret_cast<const bf16x8*>(a + 32 * 256);
        p0 = MFMA32(b0, qr[d0], p0); p1 = MFMA32(b1, qr[d0], p1); }
}
template <int VOFF> __device__ __forceinline__ void at_pv(f32x16* o, int vb0, bf16x8 pa0, bf16x8 pa1, bf16x8 pa2, bf16x8 pa3) {
#define TRRD(dst, off) asm volatile("ds_read_b64_tr_b16 %0, %1 offset:%2" : "=&v"(dst) : "v"(vb0), "i"(off) : "memory")
#define PV_D0(d0) do { s16x4 l0, l1, l2, l3, h0, h1, h2, h3; constexpr int b_ = VOFF + v_rd_off(d0, 0, 0); \
        TRRD(l0, b_); TRRD(h0, b_ + 2048); TRRD(l1, b_ + 4096); TRRD(h1, b_ + 6144); TRRD(l2, b_ + 8192); TRRD(h2, b_ + 10240); TRRD(l3, b_ + 12288); TRRD(h3, b_ + 14336); \
        asm volatile("s_waitcnt lgkmcnt(0)" ::: "memory"); __builtin_amdgcn_sched_barrier(0); \
        o[d0] = MFMA32(pa0, ((bf16x8){l0[0], l0[1], l0[2], l0[3], h0[0], h0[1], h0[2], h0[3]}), o[d0]); \
        o[d0] = MFMA32(pa1, ((bf16x8){l1[0], l1[1], l1[2], l1[3], h1[0], h1[1], h1[2], h1[3]}), o[d0]); \
        o[d0] = MFMA32(pa2, ((bf16x8){l2[0], l2[1], l2[2], l2[3], h2[0], h2[1], h2[2], h2[3]}), o[d0]); \
        o[d0] = MFMA32(pa3, ((bf16x8){l3[0], l3[1], l3[2], l3[3], h3[0], h3[1], h3[2], h3[3]}), o[d0]); } while (0)
    PV_D0(0); PV_D0(1); PV_D0(2); PV_D0(3);
#undef PV_D0
#undef TRRD
}
__device__ __forceinline__ void dsa_attn_unit(const Ctx& c, int split, int unit, unsigned char* smem) {
    const int tid = otid(), lane = tid & 63, wv = __builtin_amdgcn_readfirstlane(tid >> 6), r32 = lane & 31, hi = lane >> 5, rg = wv & 3, kp = wv >> 2;
    const int bh = unit & (BPS * 8 - 1), qb = (SEQ / 128 - 1) - unit / (BPS * 8), bl = bh >> 3, h = bh & 7, rb = bl * SEQ, q0 = 128 * qb, nstep = qb + 1;
    const bf16_t* QB = (const bf16_t*)(c.R + R_QB); const bf16_t* KB = (const bf16_t*)(c.R + R_KB) + (size_t)rb * 1024 + h * 128; const bf16_t* VB = (const bf16_t*)(c.R + R_VB) + (size_t)rb * 1024 + h * 128;
    const unsigned* MK = (const unsigned*)(c.R + R_P2 + P2_MASK) + (size_t)(rb + q0 + 32 * rg + r32) * 128;
    float* ws = (float*)(smem + AT_WS) + wv * 128; float* li_l = ws; float* al_l = ws + 32;
    const int sr = tid >> 4, scol = (tid & 15) * 8, vst0 = v_st(sr, scol), vst1 = v_st(32 + sr, scol), kws = KSWZ(sr, scol * 2);
    const int vb0 = (int)(uintptr_t)(smem + AT_V) + kp * AT_TILE + v_rd_base(lane);
    bf16x8 qr[8];
    { const bf16_t* qp = QB + (size_t)(rb + q0 + 32 * rg + r32) * 1024 + h * 128 + hi * 8;
#pragma unroll
      for (int d0 = 0; d0 < 8; ++d0) qr[d0] = *(const bf16x8*)(qp + d0 * 16); }
    bf16x8 sk[4], sv[4];
#define AT_LOAD(j) do { const size_t o0 = (size_t)(128 * (j) + sr) * 1024 + scol; sk[0] = *(const bf16x8*)(KB + o0); sk[1] = *(const bf16x8*)(KB + o0 + 32 * 1024); sk[2] = *(const bf16x8*)(KB + o0 + 64 * 1024); sk[3] = *(const bf16x8*)(KB + o0 + 96 * 1024); \
        sv[0] = *(const bf16x8*)(VB + o0); sv[1] = *(const bf16x8*)(VB + o0 + 32 * 1024); sv[2] = *(const bf16x8*)(VB + o0 + 64 * 1024); sv[3] = *(const bf16x8*)(VB + o0 + 96 * 1024); } while (0)
#define AT_WRITE(bf) do { unsigned char* Kd = smem + AT_K + (bf) * 2 * AT_TILE; unsigned char* Vd = smem + AT_V + (bf) * 2 * AT_TILE; \
        *(bf16x8*)(Kd + kws) = sk[0]; *(bf16x8*)(Kd + kws + 32 * 256) = sk[1]; *(bf16x8*)(Kd + AT_TILE + kws) = sk[2]; *(bf16x8*)(Kd + AT_TILE + kws + 32 * 256) = sk[3]; \
        *(bf16x8*)(Vd + vst0) = sv[0]; *(bf16x8*)(Vd + vst1) = sv[1]; *(bf16x8*)(Vd + AT_TILE + vst0) = sv[2]; *(bf16x8*)(Vd + AT_TILE + vst1) = sv[3]; } while (0)
    __syncthreads();
    AT_LOAD(0); AT_WRITE(0);
    float m_reg = -1e30f, l_reg = 0.f; f32x16 o[4] = {};
    __syncthreads();
    const int lastrow = q0 + 32 * rg + 31; const float NINF = -__builtin_inff();
#define AT_STEP(j, BUF) do { \
        const int tt = 2 * (j) + kp; const bool act = 64 * tt <= lastrow; \
        uint2 mw = make_uint2(0u, 0u); if (act) mw = *(const uint2*)(MK + 2 * tt); \
        if ((j) + 1 < nstep) AT_LOAD((j) + 1); \
        if (act) { \
            const unsigned m0 = mw.x >> (4 * hi), m1 = mw.y >> (4 * hi); \
            f32x16 p0, p1; at_qkt(p0, p1, smem + AT_K + ((BUF) * 2 + kp) * AT_TILE, r32, hi, qr); \
            _Pragma("unroll") for (int r = 0; r < 16; ++r) { const unsigned bit = 1u << ((r & 3) + 8 * (r >> 2)); if (!(m0 & bit)) p0[r] = NINF; if (!(m1 & bit)) p1[r] = NINF; } \
            float alpha; at_partialSM(p0, p1, m_reg, alpha); \
            bf16x8 pa0, pa1, pa2, pa3; at_finishSM(p0, p1, alpha, l_reg, pa0, pa1, pa2, pa3); \
            if (__any(alpha < 1.f)) { if (hi == 0) al_l[r32] = alpha; asm volatile("s_waitcnt lgkmcnt(0)" ::: "memory"); \
                _Pragma("unroll") for (int d_ = 0; d_ < 4; ++d_) _Pragma("unroll") for (int r = 0; r < 16; ++r) o[d_][r] *= al_l[crow(r, hi)]; } \
            __builtin_amdgcn_sched_barrier(0); \
            at_pv<(BUF) * 2 * AT_TILE>(o, vb0, pa0, pa1, pa2, pa3); } \
        if ((j) + 1 < nstep) { asm volatile("s_waitcnt vmcnt(0)" ::: "memory"); AT_WRITE(1 - (BUF)); } \
        __syncthreads(); } while (0)
#pragma unroll 1
    for (int j = 0; j < nstep; j += 2) { AT_STEP(j, 0); if (j + 1 < nstep) AT_STEP(j + 1, 1); }
#undef AT_STEP
#undef AT_LOAD
#undef AT_WRITE
    float* mg = (float*)smem + (size_t)rg * (66 * 64);
    if (kp == 1) {
#pragma unroll
        for (int d0 = 0; d0 < 4; ++d0)
#pragma unroll
            for (int r = 0; r < 16; ++r) mg[(d0 * 16 + r) * 64 + lane] = o[d0][r];
        mg[64 * 64 + lane] = m_reg; mg[65 * 64 + lane] = l_reg; }
    __syncthreads();
    if (kp == 0) {
        constexpr float C2 = 1.4426950408889634f * AT_SCALE;
        const float m2 = mg[64 * 64 + lane], l2 = mg[65 * 64 + lane], mm = fmaxf(m_reg, m2);
        const float a1 = __builtin_amdgcn_exp2f((m_reg - mm) * C2), a2 = __builtin_amdgcn_exp2f((m2 - mm) * C2), lt = l_reg * a1 + l2 * a2;
        if (hi == 0) { li_l[r32] = __builtin_amdgcn_rcpf(lt); al_l[r32] = a1; al_l[32 + r32] = a2; }
        asm volatile("s_waitcnt lgkmcnt(0)" ::: "memory");
        bf16_t* Ow = c.AT + ((size_t)split * MS + rb + q0 + 32 * rg) * 1024 + h * 128;
#pragma unroll
        for (int r = 0; r < 16; ++r) { const int orow = crow(r, hi); const float f1 = al_l[orow] * li_l[orow], f2 = al_l[32 + orow] * li_l[orow];
#pragma unroll
            for (int d0 = 0; d0 < 4; ++d0) { const float v = o[d0][r] * f1 + mg[(d0 * 16 + r) * 64 + lane] * f2; const float vn = __shfl_xor(v, 1);
                if ((r32 & 1) == 0) *(unsigned*)(Ow + (size_t)orow * 1024 + d0 * 32 + r32) = cvtpk_s(v, vn); } } }
}

constexpr int LDS_QSLOT = LDS_BYTES - 16;
__device__ __forceinline__ int queue_next(unsigned* ctr, unsigned char* smem) {
    __syncthreads(); if (otid() == 0) *(volatile int*)(smem + LDS_QSLOT) = (int)atomicAdd(ctr, 1u); __syncthreads(); return *(volatile int*)(smem + LDS_QSLOT);
}
__device__ __forceinline__ void phase_prep_select(const Ctx& c, int layer, int split, int rep, unsigned char* smem) {
    unsigned* ctr = (unsigned*)(c.ws + WS_CTL) + 1024 + (((layer * NSPLIT + split) * 2 + 0) * 2 + rep) * 64;
    constexpr int NSEL = MS / 16, NPREP = (MS / 64) * 8;
    for (;;) { const int u = queue_next(ctr, smem); if (u >= (rep ? NSEL : NSEL + NPREP)) break; if (u < NSEL) dsa_select_unit(c, u, smem); else gdn_prep_unit(c, layer, u - NSEL, smem); }
}
__device__ __forceinline__ void phase_scan_attn(const Ctx& c, int layer, int split, int rep, unsigned char* smem) {
    unsigned* ctr = (unsigned*)(c.ws + WS_CTL) + 1024 + (((layer * NSPLIT + split) * 2 + 1) * 2 + rep) * 64;
    constexpr int NSCAN = BPS * 8, NATT = BPS * 8 * (SEQ / 128);
    for (;;) { const int u = queue_next(ctr, smem); if (u >= NSCAN + NATT) break; if (u < NSCAN) gdn_scan_unit(c, layer, split, u, smem); else dsa_attn_unit(c, split, u - NSCAN, smem); }
}
#define LAS __attribute__((address_space(3)))
#define XB_TMO      128
#define XB_XCNT(j)  (256  + 64 * (j))
#define XB_XSUB(j)  (1280 + 64 * (j))
#define XB_XGEN(j)  (2304 + 64 * (j))
#define XB_TOP      3328
#define XB_TOPGEN   3392
#define XCD_BAR_WORDS 3456
#define XB_SPIN_CAP (1u << 18)

__device__ __forceinline__ unsigned xb_ld(unsigned* p)              { return __hip_atomic_load(p, __ATOMIC_RELAXED, __HIP_MEMORY_SCOPE_AGENT); }
__device__ __forceinline__ unsigned xb_add(unsigned* p, unsigned v) { return __hip_atomic_fetch_add(p, v, __ATOMIC_RELAXED, __HIP_MEMORY_SCOPE_AGENT); }
__device__ __forceinline__ unsigned xb_xcc_id() { return (unsigned)__builtin_amdgcn_s_getreg((3 << 11) | 20) & 0xFu; }
#define XB_SPIN(cond, bar) do { unsigned _sp = 0; while (cond) { __builtin_amdgcn_s_sleep(1); \
    if ((++_sp & 255u) == 0u) { if (xb_ld(&(bar)[XB_TMO])) break; if (_sp > XB_SPIN_CAP) { atomicAdd(&(bar)[XB_TMO], 1u); break; } } } } while (0)

struct XcdBarrier {
    unsigned* bar; unsigned x;
    volatile LAS unsigned* st;
};

__device__ __forceinline__ XcdBarrier xcd_barrier_post(unsigned* bar, volatile LAS unsigned* st) {
    XcdBarrier b; b.bar = bar; b.x = xb_xcc_id(); b.st = st;
    if (threadIdx.x == 0) (void)xb_add(&bar[XB_XCNT(b.x)], 1u);
    return b;
}
__device__ __forceinline__ void xcd_barrier_complete(unsigned* bar, unsigned x, unsigned& nloc, unsigned& nx) {
    const unsigned G = gridDim.x * gridDim.y * gridDim.z;
    unsigned sum, cnt, mine, sp = 0u;
    for (;;) {
        sum = 0u; cnt = 0u; mine = 0u;
#pragma unroll
        for (unsigned j = 0; j < 16; ++j) { const unsigned c = xb_ld(&bar[XB_XCNT(j)]); sum += c; cnt += (c > 0u) ? 1u : 0u; mine = (j == x) ? c : mine; }
        if (sum == G) break;
        __builtin_amdgcn_s_sleep(1);
        if ((++sp & 255u) == 0u) { if (xb_ld(&bar[XB_TMO])) break; if (sp > XB_SPIN_CAP) { atomicAdd(&bar[XB_TMO], 1u); break; } }
    }
    nloc = mine > 0u ? mine : 1u; nx = cnt > 0u ? cnt : 1u;
}

__device__ __forceinline__ void xcd_barrier(const XcdBarrier& b) {
    asm volatile("s_waitcnt vmcnt(0)" ::: "memory");
    __syncthreads();
    if (threadIdx.x == 0) {
        unsigned* bar = b.bar;
        __builtin_amdgcn_s_waitcnt(0);
        unsigned nloc = b.st[0], nx = b.st[1];
        if (nloc == 0u) { xcd_barrier_complete(bar, b.x, nloc, nx); b.st[0] = nloc; b.st[1] = nx; }
        const unsigned old = xb_add(&bar[XB_XSUB(b.x)], 1u);
        const unsigned gen = old / nloc;
        if (old + 1u == (gen + 1u) * nloc) {
            __builtin_amdgcn_fence(__ATOMIC_RELEASE, "agent");
            asm volatile("s_waitcnt vmcnt(0)" ::: "memory");
            const unsigned og = xb_add(&bar[XB_TOP], 1u);
            const unsigned tg = og / nx;
            if (og + 1u == (tg + 1u) * nx) xb_add(&bar[XB_TOPGEN], 1u);
            else XB_SPIN(xb_ld(&bar[XB_TOPGEN]) == tg, bar);
            __builtin_amdgcn_fence(__ATOMIC_ACQUIRE, "agent");
            xb_add(&bar[XB_XGEN(b.x)], 1u);
            asm volatile("s_waitcnt vmcnt(0)" ::: "memory");
        } else {
            XB_SPIN(xb_ld(&bar[XB_XGEN(b.x)]) == gen, bar);
            __builtin_amdgcn_fence(__ATOMIC_ACQUIRE, "agent");
            asm volatile("s_waitcnt vmcnt(0)" ::: "memory");
        }
    }
    __syncthreads();
}
typedef const __attribute__((address_space(4))) Args* KArgsP;
__device__ __forceinline__ Ctx make_ctx() {
    KArgsP a = (KArgsP)__builtin_amdgcn_kernarg_segment_ptr(); asm volatile("" : "+s"(a));
    Ctx c;
    c.x = a->in[0]; c.norm_mix = a->in[1]; c.w_in = a->in[2]; c.conv_w = a->in[3]; c.a_log = a->in[4]; c.dt_bias = a->in[5]; c.gdn_norm = a->in[6];
    c.w_out_gdn = a->in[7]; c.w_out_dsa = a->in[8]; c.w_o = a->in[9]; c.norm_ffn = a->in[10]; c.w_gate_up = a->in[11]; c.w_down = a->in[12]; c.norm_final = a->in[13];
    c.out = a->out; c.ws = a->ws; c.R = c.ws + WS_R;
    c.cosA = (float*)(c.ws + WS_TAB); c.sinA = c.cosA + SEQ * 64; c.cosI = c.sinA + SEQ * 64; c.sinI = c.cosI + SEQ * 32;
    c.XN = (bf16_t*)(c.ws + WS_XN); c.OA = (bf16_t*)(c.ws + WS_OA); c.AT = (bf16_t*)(c.ws + WS_AT);
    return c;
}
__global__ void __launch_bounds__(512, 2) fwd_kernel(Args a) {
    extern __shared__ __attribute__((aligned(16))) unsigned char smem[];
    cg::grid_group grid = cg::this_grid();
    PG8_LAS unsigned char* lds = (PG8_LAS unsigned char*)smem;
    volatile LAS unsigned* bst = (volatile LAS unsigned*)((LAS unsigned char*)smem + (LDS_BYTES - 32));
    if (otid() < 2) bst[otid()] = 0u;
    __syncthreads();
    XcdBarrier xbar = xcd_barrier_post((unsigned*)(a.ws + WS_CTL) + 4096, bst);
#define SYNC() xcd_barrier(xbar)
    { const Ctx c = make_ctx(); phase_tables(c); }
    if (ANY_OPT_GEMM) { const Ctx c = make_ctx(); phase_convert_weights(c, 0, smem); }
    { const Ctx c = make_ctx(); phase_rmsnorm(c.x, c.norm_mix, c.XN, nullptr); }
    grid.sync();
#pragma unroll 1
    for (int layer = 0; layer < DEPTH; ++layer) {
#pragma unroll 1
        for (int pc = 0; pc < 19; ++pc) {
            int st, split = 0;
            if (pc < 12) { split = pc / 6; st = pc % 6; } else st = pc - 6;
            if (STAGE_OPT_GDN && STAGE_OPT_DSA && (st == 2 || st == 4 || st == 5)) continue;
            const int nrep = ((PROBE_DUP_MASK >> st) & 1) ? 2 : 1;
#pragma unroll 1
            for (int rep = 0; rep < nrep; ++rep) {
            int k0 = 0, k1 = 0;
            if (st == 0) { if (STAGE_OPT_INPROJ) { const Ctx c = make_ctx(); unsigned char* wt = c.ws + WS_WT; pg8::Gemm g{c.XN + (size_t)split * MS * DM, (const bf16_t*)(wt + WT_IN), MS, 31 * 256, DM}; pg8::StaticOrder S; S.init(MS, 31 * 256, gridDim.x, blockIdx.x);
                    EpiInProj E{c.R, c.cosA, c.sinA, c.cosI, c.sinI, c.a_log + layer * 8, c.dt_bias + layer * 8}; pg8::gemm_phase<EpiInProj, pg8::StaticOrder, true, true>(lds, g, S, E); }
                else { k0 = split * 10; k1 = k0 + 10; } }
            else if (st == 1) { const Ctx c = make_ctx(); if (STAGE_OPT_GDN && STAGE_OPT_DSA) phase_prep_select(c, layer, split, rep, smem); else if (STAGE_OPT_GDN) phase_gdn_prep(c, layer, smem); else naive_conv(c, layer); }
            else if (st == 2) { if (!STAGE_OPT_GDN) { const Ctx c = make_ctx(); naive_l2norm(c); } }
            else if (st == 3) { const Ctx c = make_ctx(); if (STAGE_OPT_GDN && STAGE_OPT_DSA) phase_scan_attn(c, layer, split, rep, smem); else if (STAGE_OPT_GDN) phase_gdn_scan(c, layer, split, smem); else naive_scan(c, smem); }
            else if (st == 4) { if (!STAGE_OPT_GDN) { const Ctx c = make_ctx(); naive_gate(c, layer, split); } }
            else if (st == 5) { if (!(STAGE_OPT_GDN && STAGE_OPT_DSA)) { const Ctx c = make_ctx(); naive_dsa(c, split, smem); } }
            else if (st == 6) { if (STAGE_OPT_GATES) { const Ctx c = make_ctx(); unsigned char* wt = c.ws + WS_WT; pg8::Gemm g{c.XN, (const bf16_t*)(wt + WT_IN) + (size_t)31 * 256 * DM, M, 2048, DM}; pg8::StaticOrder S; S.init(M, 2048, gridDim.x, blockIdx.x);
                    EpiGates E{(bf16_t*)(c.R + R_SG)}; pg8::gemm_phase<EpiGates, pg8::StaticOrder, true, true>(lds, g, S, E); }
                else { k0 = 20; k1 = 24; } }
            else if (st == 7) { if (STAGE_OPT_Y) { const Ctx c = make_ctx(); unsigned char* wt = c.ws + WS_WT; pg8::StaticOrder S; S.init(M, DM, gridDim.x, blockIdx.x);
                    { pg8::Gemm g{c.OA, (const bf16_t*)(wt + WT_OG), M, DM, DM}; EpiY<0> E{(const bf16_t*)(c.R + R_SG), (bf16_t*)(c.R + R_MG)}; pg8::gemm_phase<EpiY<0>, pg8::StaticOrder, false, true>(lds, g, S, E); }
                    { pg8::Gemm g{c.AT, (const bf16_t*)(wt + WT_OD), M, DM, DM}; EpiY<1> E{(const bf16_t*)(c.R + R_SG), (bf16_t*)(c.R + R_MG)}; pg8::gemm_phase<EpiY<1>, pg8::StaticOrder, false, true>(lds, g, S, E); } }
                else { k0 = 24; k1 = 28; } }
            else if (st == 8) { if (STAGE_OPT_WO) { const Ctx c = make_ctx(); unsigned char* wt = c.ws + WS_WT; pg8::Gemm g{(const bf16_t*)(c.R + R_MG), (const bf16_t*)(wt + WT_O), M, DM, DM}; pg8::StaticOrder S; S.init(M, DM, gridDim.x, blockIdx.x);
                    EpiResid E{layer == 0 ? c.x : c.out, c.out}; pg8::gemm_phase<EpiResid, pg8::StaticOrder, false, true>(lds, g, S, E); }
                else { k0 = 28; k1 = 30; } }
            else if (st == 9) { const Ctx c = make_ctx(); phase_rmsnorm(c.out, c.norm_ffn + layer * DM, c.XN, nullptr); }
            else if (st == 10) { if (STAGE_OPT_GU) { const Ctx c = make_ctx(); unsigned char* wt = c.ws + WS_WT; pg8::Gemm g{c.XN, (const bf16_t*)(wt + WT_GU), M, 2 * FF, DM}; pg8::StaticOrder S; S.init(M, 2 * FF, gridDim.x, blockIdx.x);
                    EpiSwiglu E{(bf16_t*)(c.R + R_ACT)}; pg8::gemm_phase<EpiSwiglu, pg8::StaticOrder, true, true>(lds, g, S, E); }
                else { k0 = 30; k1 = 52; } }
            else if (st == 11) { if (STAGE_OPT_DN) { const Ctx c = make_ctx(); unsigned char* wt = c.ws + WS_WT; pg8::Gemm g{(const bf16_t*)(c.R + R_ACT), (const bf16_t*)(wt + WT_DN), M, DM, FF}; pg8::StaticOrder S; S.init(M, DM, gridDim.x, blockIdx.x);
                    EpiResid E{c.out, c.out}; pg8::gemm_phase<EpiResid, pg8::StaticOrder, false, true>(lds, g, S, E); }
                else { k0 = 52; k1 = 54; } }
            else { const Ctx c = make_ctx(); if (layer + 1 < DEPTH) { phase_rmsnorm(c.out, c.norm_mix + (layer + 1) * DM, c.XN, nullptr); if (ANY_OPT_GEMM) phase_convert_weights(c, layer + 1, smem); }
                   else phase_rmsnorm(c.out, c.norm_final, nullptr, c.out); }
#pragma unroll 1
            for (int k = k0; k < k1; ++k) {
                const Ctx c = make_ctx(); const float* w_in = c.w_in + (size_t)layer * DM * INC; float* TMP = (float*)(c.R + R_TMP);
                NG g; EP e; int ng = 1;
                g.A = c.XN; g.lda = DM; g.W = w_in; g.ldw = INC; g.col0 = 0; g.ncols = 1024; g.row0 = 0; g.nrows = MS; g.K = DM; g.T = TMP; g.ldt = 1024; g.tcol0 = 0;
                e.kind = E_V; e.nrows = MS; e.rowg0 = 0; e.p0 = 0; e.layer = layer; e.dst = nullptr; e.base = nullptr;
                if (k < 20) { const int sp = k / 10, j = k % 10; g.row0 = sp * MS; e.rowg0 = sp * MS;
                    if (j < 3) { g.col0 = C_QKVA + j * 1024; e.kind = E_QKVA; e.p0 = j; }
                    else if (j == 3) { g.col0 = C_Z; e.kind = E_Z; }
                    else if (j == 4) { g.col0 = C_A; g.ncols = 16; e.kind = E_AB; }
                    else if (j == 5) { g.col0 = C_QB; e.kind = E_ROPE; e.dst = (bf16_t*)(c.R + R_QB); }
                    else if (j == 6) { g.col0 = C_KB; e.kind = E_ROPE; e.dst = (bf16_t*)(c.R + R_KB); }
                    else if (j == 7) { g.col0 = C_VB; e.kind = E_V; e.dst = (bf16_t*)(c.R + R_VB); }
                    else if (j == 8) { g.col0 = C_QI; g.ncols = 512; e.kind = E_QI; }
                    else { g.col0 = C_KI; g.ncols = 72; e.kind = E_KIWI; } }
                else if (k < 24) { const int hf = (k - 20) >> 1, gg = (k - 20) & 1; g.row0 = hf * MS; e.rowg0 = hf * MS; g.col0 = C_GA + gg * 1024; e.kind = E_SG; e.p0 = gg; }
                else if (k < 28) { const int hf = (k - 24) >> 1, wh = (k - 24) & 1; g.row0 = hf * MS; e.rowg0 = hf * MS; g.A = wh ? c.AT : c.OA;
                    g.W = (wh ? c.w_out_dsa : c.w_out_gdn) + (size_t)layer * DM * DM; g.ldw = DM; e.kind = wh ? E_YB : E_YA; }
                else if (k < 30) { const int hf = k - 28; g.row0 = hf * MS; e.rowg0 = hf * MS; g.A = (const bf16_t*)(c.R + R_MG); g.W = c.w_o + (size_t)layer * DM * DM; g.ldw = DM; e.kind = E_WO; e.base = layer == 0 ? c.x : c.out; }
                else if (k < 52) { const int hf = (k - 30) / 11, fg = (k - 30) % 11; g.row0 = hf * MS; e.rowg0 = hf * MS; g.W = c.w_gate_up + (size_t)layer * DM * 2 * FF; g.ldw = 2 * FF; g.col0 = fg * 256; g.ncols = 256;
                    ng = 2; e.kind = E_SWIGLU; e.p0 = fg; }
                else { const int hf = k - 52; g.row0 = hf * MS; e.rowg0 = hf * MS; g.A = (const bf16_t*)(c.R + R_ACT); g.lda = FF; g.K = FF; g.W = c.w_down + (size_t)layer * FF * DM; g.ldw = DM; e.kind = E_DOWN; }
#pragma unroll 1
                for (int q = 0; q < ng; ++q) { if (q == 1) { g.col0 += FF; g.tcol0 = 256; } naive_gemm(g, smem); }
                SYNC();
                epi_phase(c, e);
                if (k + 1 < k1) SYNC();
            }
            SYNC();
            }
        }
    }
}

extern "C" void kernel_launch(void* const* d_in, const int* in_sizes, int n_in, void* d_out, int out_size, void* d_ws, size_t ws_size, hipStream_t stream) {
    static int grid = 0;
    if (grid == 0) {
        if (n_in != 14 || out_size != M * DM || ws_size < WS_END) { fprintf(stderr, "kernel_launch: unexpected problem (n_in %d out %d ws %zu need %zu)\n", n_in, out_size, ws_size, (size_t)WS_END); grid = -1; return; }
        int dev = 0, cus = 0, per_cu = 0;
        hipGetDevice(&dev); hipDeviceGetAttribute(&cus, hipDeviceAttributeMultiprocessorCount, dev);
        hipFuncSetAttribute((const void*)fwd_kernel, hipFuncAttributeMaxDynamicSharedMemorySize, LDS_BYTES);
        hipOccupancyMaxActiveBlocksPerMultiprocessor(&per_cu, (const void*)fwd_kernel, 512, LDS_BYTES);
        if (per_cu < 1) { fprintf(stderr, "kernel_launch: occupancy query says %d blocks/CU\n", per_cu); grid = -1; return; }
        grid = cus;
        (void)hipGetLastError();
    }
    if (grid < 0) return;
    hipMemsetAsync((char*)d_ws + WS_CTL, 0, 65536, stream);
    Args a{};
    for (int i = 0; i < 14; ++i) a.in[i] = (const float*)d_in[i];
    a.out = (float*)d_out; a.ws = (unsigned char*)d_ws;
    void* args[] = {&a};
    hipError_t e = hipLaunchCooperativeKernel((const void*)fwd_kernel, dim3(grid), dim3(512), args, LDS_BYTES, stream);
    if (e != hipSuccess) fprintf(stderr, "cooperative launch failed: %s (grid %d)\n", hipGetErrorString(e), grid);
}
```

```cpp
#include <hip/hip_runtime.h>
#include <hip/hip_cooperative_groups.h>
#include <cstdio>
#include <cstdint>
namespace cg = cooperative_groups;

typedef unsigned short bf16_t;
typedef float f32x4 __attribute__((ext_vector_type(4)));

constexpr int BATCH = 4, SEQ = 4096, DM = 1024, M = BATCH * SEQ, DEPTH = 2;
constexpr int GH = 8, GD = 128, CONVK = 4, CH = 64;
constexpr int AH = 8, AD = 128, IH = 8, ID = 64, TOPK = 256;
constexpr int FF = 2816, INC = 9816;
constexpr int NSPLIT = 2, MS = M / NSPLIT, BPS = BATCH / NSPLIT;
constexpr float EPS = 1e-6f;
constexpr int C_QKVA = 0, C_Z = 3072, C_A = 4096, C_B = 4104, C_QB = 4112, C_KB = 5136, C_VB = 6160, C_QI = 7184, C_KI = 7696, C_WI = 7760, C_GA = 7768, C_GB = 8792;

constexpr size_t MiB = 1u << 20;
constexpr size_t WS_CTL = 0;
constexpr size_t WS_WT = 1 * MiB;
constexpr size_t WS_TAB = 43 * MiB;
constexpr size_t WS_XN = 46 * MiB;
constexpr size_t WS_OA = 78 * MiB;
constexpr size_t WS_AT = 110 * MiB;
constexpr size_t WS_R = 142 * MiB;
constexpr size_t R_QKVA = 0, R_ZS = 48 * MiB, R_QB = 64 * MiB, R_KB = 80 * MiB, R_VB = 96 * MiB, R_QI = 112 * MiB, R_KI = 120 * MiB;
constexpr size_t R_WI = 121 * MiB, R_GG = R_WI + 256 * 1024, R_BETA = R_GG + 256 * 1024, R_HALO = 122 * MiB;
constexpr size_t R_P2 = 124 * MiB + 256 * 1024;
constexpr size_t R_TMP = R_P2;
constexpr size_t R_SG = 0, R_M1 = 64 * MiB, R_MG = R_M1;
constexpr size_t R_ACT = 0;
constexpr size_t WS_END = WS_R + R_P2 + 32 * MiB;
static_assert(WS_END <= 321650688ull, "workspace map exceeds the guaranteed d_ws size");
constexpr int LDS_BYTES = 163840;

struct Args { const float* in[14]; float* out; unsigned char* ws; };

__device__ __forceinline__ int otid() { int t = threadIdx.x; asm volatile("" : "+v"(t)); return t; }
__device__ __forceinline__ float bf2f(unsigned v) { return __uint_as_float(v << 16); }
__device__ __forceinline__ bf16_t f2bf(float f) { unsigned u = __float_as_uint(f); u += 0x7fffu + ((u >> 16) & 1u); return (bf16_t)(u >> 16); }
__device__ __forceinline__ float sigmoidf_(float x) { return 1.f / (1.f + __expf(-x)); }
__device__ __forceinline__ float siluf_(float x) { return x / (1.f + __expf(-x)); }
__device__ __forceinline__ float softplusf_(float x) { return fmaxf(x, 0.f) + log1pf(__expf(-fabsf(x))); }
__device__ __forceinline__ float wave_sum(float v) {
#pragma unroll
    for (int o = 1; o < 64; o <<= 1) v += __shfl_xor(v, o);
    return v;
}
__device__ __forceinline__ float wave_max(float v) {
#pragma unroll
    for (int o = 1; o < 64; o <<= 1) v = fmaxf(v, __shfl_xor(v, o));
    return v;
}

struct Ctx {
    const float* x; const float* norm_mix; const float* w_in; const float* conv_w; const float* a_log; const float* dt_bias; const float* gdn_norm;
    const float* w_out_gdn; const float* w_out_dsa; const float* w_o; const float* norm_ffn; const float* w_gate_up; const float* w_down; const float* norm_final;
    float* out; unsigned char* ws; unsigned char* R;
    float *cosA, *sinA, *cosI, *sinI;
    bf16_t *XN, *OA, *AT;
};

__device__ const double ROPE_INVF[64] = {1.0, 0.8659643233600653, 0.7498942093324559, 0.6493816315762113, 0.5623413251903491, 0.4869675251658631, 0.4216965034285822, 0.3651741272548377, 0.31622776601683794, 0.27384196342643613, 0.23713737056616552, 0.2053525026457146, 0.1778279410038923, 0.1539926526059492, 0.1333521432163324, 0.11547819846894582, 0.1, 0.08659643233600653, 0.07498942093324558, 0.06493816315762113, 0.05623413251903491, 0.04869675251658631, 0.042169650342858224, 0.03651741272548377, 0.03162277660168379, 0.027384196342643614, 0.023713737056616554, 0.02053525026457146, 0.01778279410038923, 0.01539926526059492, 0.01333521432163324, 0.011547819846894581, 0.01, 0.008659643233600654, 0.007498942093324558, 0.006493816315762113, 0.005623413251903491, 0.004869675251658631, 0.004216965034285823, 0.003651741272548377, 0.0031622776601683794, 0.0027384196342643613, 0.0023713737056616554, 0.002053525026457146, 0.0017782794100389228, 0.001539926526059492, 0.001333521432163324, 0.0011547819846894581, 0.001, 0.0008659643233600654, 0.0007498942093324559, 0.0006493816315762113, 0.0005623413251903491, 0.0004869675251658631, 0.00042169650342858224, 0.0003651741272548377, 0.00031622776601683794, 0.0002738419634264361, 0.00023713737056616554, 0.0002053525026457146, 0.00017782794100389227, 0.0001539926526059492, 0.0001333521432163324, 0.00011547819846894582};
__device__ __forceinline__ void rope_cs(int t, double invf, float& cs, float& sn) {
    const double ang = (double)t * invf; const double k = rint(ang * 0.15915494309189535); const float r = (float)(ang - k * 6.283185307179586);
    cs = cosf(r); sn = sinf(r);
}
__device__ __forceinline__ void phase_tables(const Ctx& c) {
    const int gt = blockIdx.x * blockDim.x + otid(), nt = gridDim.x * blockDim.x;
    for (int i = gt; i < SEQ * 64; i += nt) { const int t = i >> 6, d = i & 63; float cs, sn; rope_cs(t, ROPE_INVF[d], cs, sn); c.cosA[i] = cs; c.sinA[i] = sn; }
    for (int i = gt; i < SEQ * 32; i += nt) { const int t = i >> 5, d = i & 31; float cs, sn; rope_cs(t, ROPE_INVF[2 * d], cs, sn); c.cosI[i] = cs; c.sinI[i] = sn; }
}

__device__ __forceinline__ void phase_rmsnorm(const float* src, const float* gain, bf16_t* dst_bf, float* dst_f) {
    const int lane = otid() & 63, gw = (blockIdx.x * blockDim.x + otid()) >> 6, nw = (gridDim.x * blockDim.x) >> 6;
    for (int r = gw; r < M; r += nw) {
        const f32x4* xr = (const f32x4*)(src + (size_t)r * DM) + lane;
        f32x4 v[4]; float s = 0.f;
#pragma unroll
        for (int j = 0; j < 4; ++j) { v[j] = xr[64 * j]; s += v[j].x * v[j].x + v[j].y * v[j].y + v[j].z * v[j].z + v[j].w * v[j].w; }
        const float rs = rsqrtf(wave_sum(s) * (1.f / DM) + EPS);
#pragma unroll
        for (int j = 0; j < 4; ++j) {
            const f32x4 g = ((const f32x4*)gain)[lane + 64 * j]; const f32x4 o = v[j] * rs * g;
            if (dst_bf) { uint2 w; w.x = f2bf(o.x) | ((unsigned)f2bf(o.y) << 16); w.y = f2bf(o.z) | ((unsigned)f2bf(o.w) << 16); ((uint2*)(dst_bf + (size_t)r * DM))[lane + 64 * j] = w; }
            else ((f32x4*)(dst_f + (size_t)r * DM))[lane + 64 * j] = o;
        }
    }
}

struct NG { const bf16_t* A; int lda; const float* W; int ldw; int col0; int ncols; int row0; int nrows; int K; float* T; int ldt; int tcol0; };
__device__ __forceinline__ void naive_gemm(const NG& g, unsigned char* smem) {
    float* As = (float*)smem; float* Bs = As + 16 * 132;
    const int tid = otid(), ty = tid >> 4, tx = tid & 15;
    const int ntr = g.nrows / 128, ntc = (g.ncols + 63) / 64;
    for (int u = blockIdx.x; u < ntr * ntc; u += gridDim.x) {
        const int tr = u % ntr, tc = u / ntr, r0 = tr * 128, c0 = tc * 64;
        float acc[4][4];
#pragma unroll
        for (int i = 0; i < 4; ++i)
#pragma unroll
            for (int j = 0; j < 4; ++j) acc[i][j] = 0.f;
        for (int k0 = 0; k0 < g.K; k0 += 16) {
            { const int row = tid >> 2, kq = (tid & 3) * 4;
              const uint2 raw = *(const uint2*)(g.A + (size_t)(g.row0 + r0 + row) * g.lda + k0 + kq);
              As[(kq + 0) * 132 + row] = bf2f(raw.x & 0xffffu); As[(kq + 1) * 132 + row] = bf2f(raw.x >> 16);
              As[(kq + 2) * 132 + row] = bf2f(raw.y & 0xffffu); As[(kq + 3) * 132 + row] = bf2f(raw.y >> 16); }
            { const int k = tid >> 5, cc = (tid & 31) * 2;
              const float* wp = g.W + (size_t)(k0 + k) * g.ldw + g.col0 + c0 + cc;
              Bs[k * 68 + cc] = (c0 + cc < g.ncols) ? wp[0] : 0.f; Bs[k * 68 + cc + 1] = (c0 + cc + 1 < g.ncols) ? wp[1] : 0.f; }
            __syncthreads();
#pragma unroll
            for (int kk = 0; kk < 16; ++kk) {
                const f32x4 a = *(const f32x4*)&As[kk * 132 + ty * 4]; const f32x4 b = *(const f32x4*)&Bs[kk * 68 + tx * 4];
#pragma unroll
                for (int i = 0; i < 4; ++i)
#pragma unroll
                    for (int j = 0; j < 4; ++j) acc[i][j] += a[i] * b[j];
            }
            __syncthreads();
        }
#pragma unroll
        for (int i = 0; i < 4; ++i)
#pragma unroll
            for (int j = 0; j < 4; ++j) { const int cc = c0 + tx * 4 + j; if (cc < g.ncols) g.T[(size_t)(r0 + ty * 4 + i) * g.ldt + g.tcol0 + cc] = acc[i][j]; }
    }
}

enum { E_QKVA, E_Z, E_AB, E_ROPE, E_V, E_QI, E_KIWI, E_SG, E_YA, E_YB, E_WO, E_SWIGLU, E_DOWN };
struct EP { int kind; int nrows; int rowg0; int p0; int layer; bf16_t* dst; const float* base; };
__device__ __forceinline__ void epi_phase(const Ctx& c, const EP& e) {
    const float* T = (const float*)(c.R + R_TMP);
    const int gt = blockIdx.x * blockDim.x + otid(), nt = gridDim.x * blockDim.x;
    int W;
    switch (e.kind) { case E_QKVA: case E_Z: case E_V: case E_SG: case E_YA: case E_YB: case E_WO: case E_DOWN: W = 1024; break;
        case E_AB: W = 16; break; case E_ROPE: W = 512; break; case E_QI: W = 256; break; case E_KIWI: W = 40; break; default: W = 256; break; }
    const long total = (long)e.nrows * W;
    for (long idx = gt; idx < total; idx += nt) {
        const int r = (int)(idx / W), j = (int)(idx % W);
        const int rowg = e.rowg0 + r, rs = rowg % MS, pos = rowg % SEQ;
        const float* Tr = T + (size_t)r * 1024;
        switch (e.kind) {
        case E_QKVA: { const int col = e.p0 * 1024 + j; const bf16_t v = f2bf(Tr[j]); ((bf16_t*)(c.R + R_QKVA))[(size_t)rs * 3072 + col] = v;
                       if ((rs & 63) >= 61) ((bf16_t*)(c.R + R_HALO))[((size_t)(rs >> 6) * 3 + ((rs & 63) - 61)) * 3072 + col] = v; } break;
        case E_Z: ((bf16_t*)(c.R + R_ZS))[(size_t)rs * 1024 + j] = f2bf(siluf_(Tr[j])); break;
        case E_AB: { const int h = j & 7;
                     if (j < 8) ((float*)(c.R + R_GG))[rs * 8 + h] = -__expf(c.a_log[e.layer * 8 + h]) * softplusf_(Tr[j] + c.dt_bias[e.layer * 8 + h]);
                     else ((float*)(c.R + R_BETA))[rs * 8 + h] = sigmoidf_(Tr[j]); } break;
        case E_ROPE: { const int h = j >> 6, d = j & 63; const float x1 = Tr[h * 128 + d], x2 = Tr[h * 128 + 64 + d], cs = c.cosA[pos * 64 + d], sn = c.sinA[pos * 64 + d];
                       bf16_t* dst = e.dst + (size_t)rs * 1024 + h * 128 + d; dst[0] = f2bf(x1 * cs - x2 * sn); dst[64] = f2bf(x2 * cs + x1 * sn); } break;
        case E_V: e.dst[(size_t)rs * 1024 + j] = f2bf(Tr[j]); break;
        case E_QI: { const int h = j >> 5, d = j & 31; const float x1 = Tr[h * 64 + d], x2 = Tr[h * 64 + 32 + d], cs = c.cosI[pos * 32 + d], sn = c.sinI[pos * 32 + d];
                     bf16_t* dst = (bf16_t*)(c.R + R_QI) + (size_t)rs * 512 + h * 64 + d; dst[0] = f2bf(x1 * cs - x2 * sn); dst[32] = f2bf(x2 * cs + x1 * sn); } break;
        case E_KIWI: { if (j < 32) { const int d = j; const float x1 = Tr[d], x2 = Tr[32 + d], cs = c.cosI[pos * 32 + d], sn = c.sinI[pos * 32 + d];
                           bf16_t* dst = (bf16_t*)(c.R + R_KI) + (size_t)rs * 64 + d; dst[0] = f2bf((x1 * cs - x2 * sn) * 0.125f); dst[32] = f2bf((x2 * cs + x1 * sn) * 0.125f); }
                       else ((float*)(c.R + R_WI))[rs * 8 + (j - 32)] = Tr[64 + (j - 32)] * 0.35355339059327373f; } break;
        case E_SG: ((bf16_t*)(c.R + R_SG))[(size_t)rowg * 2048 + e.p0 * 1024 + j] = f2bf(sigmoidf_(Tr[j])); break;
        case E_YA: ((bf16_t*)(c.R + R_M1))[(size_t)rowg * 1024 + j] = f2bf(bf2f(((const bf16_t*)(c.R + R_SG))[(size_t)rowg * 2048 + j]) * Tr[j]); break;
        case E_YB: ((bf16_t*)(c.R + R_MG))[(size_t)rowg * 1024 + j] = f2bf(bf2f(((const bf16_t*)(c.R + R_M1))[(size_t)rowg * 1024 + j]) + bf2f(((const bf16_t*)(c.R + R_SG))[(size_t)rowg * 2048 + 1024 + j]) * Tr[j]); break;
        case E_WO: c.out[(size_t)rowg * 1024 + j] = e.base[(size_t)rowg * 1024 + j] + Tr[j]; break;
        case E_SWIGLU: ((bf16_t*)(c.R + R_ACT))[(size_t)rowg * FF + e.p0 * 256 + j] = f2bf(siluf_(Tr[j]) * Tr[256 + j]); break;
        case E_DOWN: c.out[(size_t)rowg * 1024 + j] += Tr[j]; break;
        }
    }
}

__device__ __forceinline__ void naive_conv(const Ctx& c, int layer) {
    bf16_t* Q = (bf16_t*)(c.R + R_QKVA); const bf16_t* H = (const bf16_t*)(c.R + R_HALO); const float* cw = c.conv_w + (size_t)layer * 4 * 3072;
    const int gt = blockIdx.x * blockDim.x + otid(), nt = gridDim.x * blockDim.x;
    for (int idx = gt; idx < (MS / 64) * 3072; idx += nt) {
        const int ch = idx % 3072, ck = idx / 3072;
        const float w0 = cw[ch], w1 = cw[3072 + ch], w2 = cw[2 * 3072 + ch], w3 = cw[3 * 3072 + ch];
        float x3 = 0.f, x2 = 0.f, x1 = 0.f;
        if ((ck * 64) % SEQ != 0) { const bf16_t* hp = H + (size_t)(ck - 1) * 3 * 3072 + ch; x3 = bf2f(hp[0]); x2 = bf2f(hp[3072]); x1 = bf2f(hp[2 * 3072]); }
        bf16_t* p = Q + (size_t)ck * 64 * 3072 + ch;
        for (int r = 0; r < 64; ++r) { const float xv = bf2f(p[(size_t)r * 3072]); const float y = w0 * x3 + w1 * x2 + w2 * x1 + w3 * xv; p[(size_t)r * 3072] = f2bf(siluf_(y)); x3 = x2; x2 = x1; x1 = xv; }
    }
}
__device__ __forceinline__ void naive_l2norm(const Ctx& c) {
    bf16_t* Q = (bf16_t*)(c.R + R_QKVA);
    const int lane = otid() & 63, gw = (blockIdx.x * blockDim.x + otid()) >> 6, nw = (gridDim.x * blockDim.x) >> 6;
    for (int t = gw; t < MS * 16; t += nw) {
        const int r = t >> 4, hh = t & 15;
        unsigned* p = (unsigned*)(Q + (size_t)r * 3072 + hh * 128) + lane; const unsigned raw = *p;
        const float a = bf2f(raw & 0xffffu), b = bf2f(raw >> 16); const float rs = rsqrtf(wave_sum(a * a + b * b) + EPS);
        *p = f2bf(a * rs) | ((unsigned)f2bf(b * rs) << 16);
    }
}
__device__ __forceinline__ void naive_scan(const Ctx& c, unsigned char* smem) {
    const bf16_t* Q = (const bf16_t*)(c.R + R_QKVA); const float* GG = (const float*)(c.R + R_GG); const float* BT = (const float*)(c.R + R_BETA); float* O = (float*)(c.R + R_TMP);
    const int lane = otid() & 63, wv = otid() >> 6, gw = blockIdx.x * 8 + wv, nw = gridDim.x * 8;
    float* kL = (float*)smem + wv * 4096; float* qL = kL + 2048;
    const int dq = lane >> 4, el = lane & 15;
    for (int task = gw; task < BPS * 8 * 8; task += nw) {
        const int eb = task & 7, h = (task >> 3) & 7, bl = task >> 6, e = eb * 16 + el;
        float S[32];
#pragma unroll
        for (int i = 0; i < 32; ++i) S[i] = 0.f;
        for (int t0 = 0; t0 < SEQ; t0 += 16) {
            for (int tk = 0; tk < 16; ++tk) { const size_t row = (size_t)bl * SEQ + t0 + tk;
                const unsigned qr = *((const unsigned*)(Q + row * 3072 + h * 128) + lane), kr = *((const unsigned*)(Q + row * 3072 + 1024 + h * 128) + lane);
                qL[tk * 128 + lane * 2] = bf2f(qr & 0xffffu); qL[tk * 128 + lane * 2 + 1] = bf2f(qr >> 16); kL[tk * 128 + lane * 2] = bf2f(kr & 0xffffu); kL[tk * 128 + lane * 2 + 1] = bf2f(kr >> 16); }
            __builtin_amdgcn_s_waitcnt(0); __builtin_amdgcn_wave_barrier();
            for (int tk = 0; tk < 16; ++tk) { const size_t row = (size_t)bl * SEQ + t0 + tk;
                const float eg = __expf(GG[row * 8 + h]), bt = BT[row * 8 + h], v = bf2f(Q[row * 3072 + 2048 + h * 128 + e]);
                const float* kp = kL + tk * 128 + dq * 32; const float* qp = qL + tk * 128 + dq * 32;
                float ks = 0.f;
#pragma unroll
                for (int i = 0; i < 32; ++i) ks += kp[i] * S[i];
                ks += __shfl_xor(ks, 16); ks += __shfl_xor(ks, 32);
                const float cc = bt * (v - eg * ks); float o = 0.f;
#pragma unroll
                for (int i = 0; i < 32; ++i) { S[i] = eg * S[i] + kp[i] * cc; o += qp[i] * S[i]; }
                o += __shfl_xor(o, 16); o += __shfl_xor(o, 32);
                if (dq == 0) O[row * 1024 + h * 128 + e] = o * 0.08838834764831845f;
            }
            __builtin_amdgcn_s_waitcnt(0); __builtin_amdgcn_wave_barrier();
        }
    }
}
__device__ __forceinline__ void naive_gate(const Ctx& c, int layer, int split) {
    const float* O = (const float*)(c.R + R_TMP); const bf16_t* Z = (const bf16_t*)(c.R + R_ZS); const float* gn = c.gdn_norm + layer * 128;
    const int lane = otid() & 63, gw = (blockIdx.x * blockDim.x + otid()) >> 6, nw = (gridDim.x * blockDim.x) >> 6;
    for (int t = gw; t < MS * 8; t += nw) {
        const int r = t >> 3, h = t & 7; const size_t off = (size_t)r * 1024 + h * 128 + lane * 2;
        const float a = O[off], b = O[off + 1]; const float rs = rsqrtf(wave_sum(a * a + b * b) * (1.f / 128.f) + EPS);
        const unsigned z = *(const unsigned*)(Z + off);
        *(unsigned*)(c.OA + (size_t)split * MS * 1024 + off) = f2bf(a * rs * gn[lane * 2] * bf2f(z & 0xffffu)) | ((unsigned)f2bf(b * rs * gn[lane * 2 + 1] * bf2f(z >> 16)) << 16);
    }
}

__device__ __forceinline__ void naive_dsa(const Ctx& c, int split, unsigned char* smem) {
    const bf16_t* QB = (const bf16_t*)(c.R + R_QB); const bf16_t* KB = (const bf16_t*)(c.R + R_KB); const bf16_t* VB = (const bf16_t*)(c.R + R_VB);
    const bf16_t* QI = (const bf16_t*)(c.R + R_QI); const bf16_t* KI = (const bf16_t*)(c.R + R_KI); const float* WI = (const float*)(c.R + R_WI);
    float* qi = (float*)smem; float* qf = qi + 512; float* sc = qf + 1024; float* scores = sc + 2048; unsigned* sel = (unsigned*)(scores + 4096); float* wi = (float*)(sel + 272); unsigned* cnt = (unsigned*)(wi + 8);
    const int tid = otid(), lane = tid & 63, wv = tid >> 6;
    for (int row = blockIdx.x; row < MS; row += gridDim.x) {
        const int t = row % SEQ, rb = row - t, n = t + 1;
        __syncthreads();
        qi[tid] = bf2f(QI[(size_t)row * 512 + tid]); qf[tid] = bf2f(QB[(size_t)row * 1024 + tid]); qf[tid + 512] = bf2f(QB[(size_t)row * 1024 + 512 + tid]);
        if (tid < 8) wi[tid] = WI[row * 8 + tid];
        if (tid == 0) { cnt[0] = 0; cnt[1] = 0; cnt[2] = 0; cnt[3] = 0; }
        __syncthreads();
        for (int s = tid; s < n; s += 512) {
            const uint4* kp = (const uint4*)(KI + (size_t)(rb + s) * 64);
            float acc = 0.f;
#pragma unroll 1
            for (int h = 0; h < 8; ++h) { float d = 0.f;
#pragma unroll 2
                for (int i = 0; i < 8; ++i) { const uint4 w = kp[i]; const float* qp = qi + h * 64 + i * 8;
                    d += qp[0] * bf2f(w.x & 0xffffu) + qp[1] * bf2f(w.x >> 16) + qp[2] * bf2f(w.y & 0xffffu) + qp[3] * bf2f(w.y >> 16)
                       + qp[4] * bf2f(w.z & 0xffffu) + qp[5] * bf2f(w.z >> 16) + qp[6] * bf2f(w.w & 0xffffu) + qp[7] * bf2f(w.w >> 16); }
                acc += wi[h] * fmaxf(d, 0.f); }
            scores[s] = acc + 0.f;
        }
        __syncthreads();
        int nsel;
        if (n <= TOPK) { for (int s = tid; s < n; s += 512) sel[s] = s; nsel = n; }
        else {
            unsigned T = 0;
            for (int bit = 31; bit >= 0; --bit) {
                const unsigned cand = T | (1u << bit); unsigned my = 0;
                for (int s = tid; s < n; s += 512) { unsigned u = __float_as_uint(scores[s]); u = (u & 0x80000000u) ? ~u : (u | 0x80000000u); my += (u >= cand) ? 1u : 0u; }
                my = (unsigned)wave_sum((float)my);
                if (lane == 0) atomicAdd(&cnt[1], my);
                __syncthreads();
                const unsigned tot = cnt[1];
                __syncthreads();
                if (tid == 0) cnt[1] = 0;
                if (tot >= (unsigned)TOPK) T = cand;
                __syncthreads();
            }
            unsigned mgt = 0, meq = 0;
            for (int s = tid; s < n; s += 512) { unsigned u = __float_as_uint(scores[s]); u = (u & 0x80000000u) ? ~u : (u | 0x80000000u); mgt += (u > T); meq += (u == T); }
            mgt = (unsigned)wave_sum((float)mgt); meq = (unsigned)wave_sum((float)meq);
            if (lane == 0) { atomicAdd(&cnt[2], mgt); atomicAdd(&cnt[3], meq); }
            __syncthreads();
            const unsigned cgt = cnt[2], ceq = cnt[3], need = TOPK - cgt;
            unsigned base = 0, eqbase = 0;
            for (int s0 = 0; s0 < n; s0 += 512) {
                const int s = s0 + tid; unsigned u = 0; if (s < n) { u = __float_as_uint(scores[s]); u = (u & 0x80000000u) ? ~u : (u | 0x80000000u); }
                const bool gt = (s < n) && (u > T), eq = (s < n) && (u == T);
                const unsigned long long bg = __ballot(gt), be = __ballot(eq), lm = (1ull << lane) - 1ull;
                if (lane == 0) { sel[256 + wv] = (unsigned)__popcll(bg); sel[264 + wv] = (unsigned)__popcll(be); }
                __syncthreads();
                unsigned pg = 0, pe = 0, tg = 0, te = 0;
                for (int w = 0; w < 8; ++w) { const unsigned a = sel[256 + w], e = sel[264 + w]; if (w < wv) { pg += a; pe += e; } tg += a; te += e; }
                const unsigned eqrank = eqbase + pe + (unsigned)__popcll(be & lm);
                const unsigned eqbefore = min(eqbase + pe + (unsigned)__popcll(be & lm), need);
                (void)eqbefore;
                const unsigned gtbefore = base + pg + (unsigned)__popcll(bg & lm);
                if (gt) sel[gtbefore + min(eqbase + pe + (unsigned)__popcll(be & lm), need)] = s;
                else if (eq && eqrank < need) sel[gtbefore + eqrank] = s;
                __syncthreads();
                base += tg; eqbase += te;
            }
            nsel = TOPK;
        }
        __syncthreads();
        for (int p = tid; p < 8 * TOPK; p += 512) { const int h = p >> 8, j = p & 255;
            if (j < nsel) { const uint4* kp = (const uint4*)(KB + (size_t)(rb + sel[j]) * 1024 + h * 128); const float* qp = qf + h * 128; float d = 0.f;
#pragma unroll 4
                for (int i = 0; i < 16; ++i) { const uint4 w = kp[i]; d += qp[i * 8] * bf2f(w.x & 0xffffu) + qp[i * 8 + 1] * bf2f(w.x >> 16) + qp[i * 8 + 2] * bf2f(w.y & 0xffffu) + qp[i * 8 + 3] * bf2f(w.y >> 16)
                        + qp[i * 8 + 4] * bf2f(w.z & 0xffffu) + qp[i * 8 + 5] * bf2f(w.z >> 16) + qp[i * 8 + 6] * bf2f(w.w & 0xffffu) + qp[i * 8 + 7] * bf2f(w.w >> 16); }
                sc[h * 256 + j] = d * 0.08838834764831845f; } }
        __syncthreads();
        { float* sp = sc + wv * 256; float mx = -3.0e38f; for (int j = lane; j < nsel; j += 64) mx = fmaxf(mx, sp[j]); mx = wave_max(mx);
          float sm = 0.f; for (int j = lane; j < nsel; j += 64) { const float pz = __expf(sp[j] - mx); sp[j] = pz; sm += pz; } sm = wave_sum(sm); const float inv = 1.f / sm;
          for (int j = lane; j < nsel; j += 64) sp[j] *= inv; }
        __syncthreads();
        { const int o = tid * 2, h = o >> 7; const float* sp = sc + h * 256; float a0 = 0.f, a1 = 0.f;
          for (int j = 0; j < nsel; ++j) { const unsigned w = *(const unsigned*)(VB + (size_t)(rb + sel[j]) * 1024 + o); const float pz = sp[j]; a0 += pz * bf2f(w & 0xffffu); a1 += pz * bf2f(w >> 16); }
          *(unsigned*)(c.AT + ((size_t)split * MS + row) * 1024 + o) = f2bf(a0) | ((unsigned)f2bf(a1) << 16); }
    }
}

namespace pg8 {
#define PG8_LAS __attribute__((address_space(3)))
typedef unsigned short bf16_t;
typedef short bf16x8 __attribute__((ext_vector_type(8)));
typedef float f32x4 __attribute__((ext_vector_type(4)));
typedef unsigned u32x4 __attribute__((ext_vector_type(4)));
constexpr int BM = 256, BK = 64, HALF = 128, HTB = HALF * BK * 2  , STAGE_BYTES = 8 * HTB, NXCD = 8, WGM = 8;

__host__ __device__ __forceinline__ int lds_byte(int r, int c) { const int st = (r >> 4) * 2 + (c >> 5), rr = r & 15, cc = c & 31, ob = rr * 64 + cc * 2; return st * 1024 + (ob ^ (((ob >> 9) & 1) << 5)); }
__host__ __device__ __forceinline__ void stage_rc(int b, int& R, int& C) { const int st = b / 1024, sb = b % 1024, swz = sb ^ (((sb >> 9) & 1) << 5); R = (st >> 1) * 16 + swz / 64; C = (st & 1) * 32 + (swz % 64) / 2; }
__host__ __device__ __forceinline__ int perm32(int rho) { const int n = rho >> 4, i = rho & 15; return 8 * (i >> 2) + 4 * n + (i & 3); }

struct Unit { int pm, pn; };
struct Gemm { const bf16_t* A; const bf16_t* Bt; int M, N, K; };

struct StaticOrder {
    int nM, nN, nwg, G, c;
    __host__ __device__ void init(int M, int N, int G_, int c_) { nM = M / BM; nN = N / BM; nwg = nM * nN; G = G_; c = c_; }
    __host__ __device__ bool next(int i, Unit& u) const {
        const long L = (long)i * G + c; if (L >= nwg) return false;
        int wgid = (int)L; { const int q = nwg / NXCD, r = nwg % NXCD, xcd = wgid % NXCD, off = wgid / NXCD; wgid = (xcd < r ? xcd * (q + 1) : r * (q + 1) + (xcd - r) * q) + off; }
        const int nig = WGM * nN, gid = wgid / nig, fm = gid * WGM, gsz = (nM - fm) < WGM ? (nM - fm) : WGM;
        u.pm = fm + ((wgid % nig) % gsz); u.pn = (wgid % nig) / gsz; return true;
    }
    __device__ __forceinline__ void a_ready(const Unit&) const {}
    __device__ __forceinline__ void done(const Unit&) const {}
};


__device__ __forceinline__ unsigned cvt_pk_bf16(float lo, float hi) { unsigned r; asm volatile("v_cvt_pk_bf16_f32 %0, %1, %2" : "=v"(r) : "v"(lo), "v"(hi)); return r; }

template <class Epi, class Sched, bool ALIGN_EPI = false, bool SP2 = false>
__device__ __forceinline__ void gemm_phase(PG8_LAS unsigned char* lds, const Gemm g, const Sched& S, const Epi& E) {
    const int tid = otid(), wid = __builtin_amdgcn_readfirstlane(tid >> 6), lane = tid & 63, wr = wid >> 2, wc = wid & 3, fr = lane & 15, fq = lane >> 4;
    const int K = g.K, nt = K / BK;
    unsigned voffA[2], voffB[2];
#pragma unroll
    for (int i = 0; i < 2; ++i) { int R, C; stage_rc(tid * 16 + i * 8192, R, C); const int Rb = Epi::PERM ? ((R & ~31) + perm32(R & 31)) : R;
        voffA[i] = (unsigned)(R * K + C) * 2u; voffB[i] = (unsigned)(Rb * K + C) * 2u; }
    const size_t kstep = (size_t)(BK * 2);
    const size_t hstep = (size_t)HALF * K * 2;
    const size_t tstep = 2 * hstep;
    const unsigned ldsw = (unsigned)wid * 1024u;
    const int aoff = lds_byte(wr * 64 + fr, fq * 8), boff = lds_byte(wc * 32 + fr, fq * 8);
#define PG8_SA(b, h) (((b) * 2 + (h)) * HTB)
#define PG8_SB(b, h) ((4 + (b) * 2 + (h)) * HTB)
#define PG8_STAGE(bufoff, gbase, voff) do { _Pragma("unroll") for (int _i = 0; _i < 2; ++_i) \
        __builtin_amdgcn_global_load_lds((const unsigned*)((const char*)(gbase) + (voff)[_i]), (PG8_LAS unsigned*)(lds + (bufoff) + ldsw + _i * 8192), 16, 0, 0); } while (0)
#define PG8_LDA(dst, b, h) do { _Pragma("unroll") for (int m = 0; m < 4; ++m) _Pragma("unroll") for (int k = 0; k < 2; ++k) dst[m][k] = *(const PG8_LAS bf16x8*)(lds + PG8_SA(b, h) + aoff + m * 2048 + k * 1024); } while (0)
#define PG8_LDB(dst, b, h) do { _Pragma("unroll") for (int n = 0; n < 2; ++n) _Pragma("unroll") for (int k = 0; k < 2; ++k) dst[n][k] = *(const PG8_LAS bf16x8*)(lds + PG8_SB(b, h) + boff + n * 2048 + k * 1024); } while (0)
#define PG8_MMA(ai, bj, At, Bt) do { __builtin_amdgcn_s_setprio(1); _Pragma("unroll") for (int m = 0; m < 4; ++m) _Pragma("unroll") for (int n = 0; n < 2; ++n) _Pragma("unroll") for (int k = 0; k < 2; ++k) \
        acc[ai][bj][m][n] = __builtin_amdgcn_mfma_f32_16x16x32_bf16(Bt[n][k], At[m][k], acc[ai][bj][m][n], 0, 0, 0); __builtin_amdgcn_s_setprio(0); } while (0)
#define PG8_WAIT_V(n) asm volatile("s_waitcnt vmcnt(" #n ")" ::: "memory")
#define PG8_WAIT_L(n) asm volatile("s_waitcnt lgkmcnt(" #n ")" ::: "memory")
#define PG8_BAR __builtin_amdgcn_s_barrier()
#define PG8_SCHED __builtin_amdgcn_sched_barrier(0)
    Unit cur, nxt; int ui = 0;
    if (!S.next(0, cur)) return;
    f32x4 acc[2][2][4][2];
#pragma unroll
    for (int a = 0; a < 2; ++a)
#pragma unroll
        for (int b = 0; b < 2; ++b)
#pragma unroll
            for (int m = 0; m < 4; ++m)
#pragma unroll
                for (int n = 0; n < 2; ++n) acc[a][b][m][n] = (f32x4){0.f, 0.f, 0.f, 0.f};
    bf16x8 At[4][2], B0[2][2], B1[2][2];
    const char* cA = (const char*)g.A + (size_t)cur.pm * tstep; const char* cB = (const char*)g.Bt + (size_t)cur.pn * tstep;
    S.a_ready(cur);
    if constexpr (SP2) {
        PG8_STAGE(PG8_SB(0, 0), cB, voffB); PG8_STAGE(PG8_SB(0, 1), cB + hstep, voffB); PG8_STAGE(PG8_SA(0, 0), cA, voffA); PG8_STAGE(PG8_SA(0, 1), cA + hstep, voffA);
        if (wr == 1) PG8_BAR;
        PG8_WAIT_V(2); PG8_BAR;
        PG8_STAGE(PG8_SB(1, 0), cB + kstep, voffB); PG8_STAGE(PG8_SA(1, 0), cA + kstep, voffA); PG8_STAGE(PG8_SB(1, 1), cB + hstep + kstep, voffB);
        PG8_WAIT_V(6); PG8_BAR;
    } else {
        PG8_STAGE(PG8_SB(0, 0), cB, voffB); PG8_STAGE(PG8_SA(0, 0), cA, voffA); PG8_STAGE(PG8_SB(0, 1), cB + hstep, voffB); PG8_STAGE(PG8_SA(0, 1), cA + hstep, voffA);
        if (wr == 1) PG8_BAR;
        PG8_WAIT_V(4); PG8_BAR;
        PG8_STAGE(PG8_SB(1, 0), cB + kstep, voffB); PG8_STAGE(PG8_SA(1, 0), cA + kstep, voffA); PG8_STAGE(PG8_SB(1, 1), cB + hstep + kstep, voffB);
        PG8_WAIT_V(6); PG8_BAR;
    }
    for (;;) {
        const bool has_next = S.next(ui + 1, nxt);
        const char* nA = has_next ? (const char*)g.A + (size_t)nxt.pm * tstep : cA; const char* nB = has_next ? (const char*)g.Bt + (size_t)nxt.pn * tstep : cB;
        for (int t = 0; t < nt; t += 2) {
            const bool last = (t == nt - 2);
            const char* a1 = cA + (size_t)(t + 1) * kstep;
            const char* a2 = last ? nA : cA + (size_t)(t + 2) * kstep; const char* b2 = last ? nB : cB + (size_t)(t + 2) * kstep;
            const char* a3 = a2 + kstep; const char* b3 = b2 + kstep;
            if (last && has_next) S.a_ready(nxt);
            if constexpr (SP2) {
            PG8_LDB(B0, 0, 0); PG8_LDB(B1, 0, 1); PG8_SCHED; PG8_LDA(At, 0, 0); PG8_STAGE(PG8_SA(1, 1), a1 + hstep, voffA);
            PG8_WAIT_V(8); PG8_WAIT_L(0); PG8_BAR; PG8_MMA(0, 0, At, B0); PG8_MMA(0, 1, At, B1); PG8_BAR; PG8_SCHED;
            PG8_LDA(At, 0, 1); PG8_STAGE(PG8_SB(0, 0), b2, voffB); PG8_STAGE(PG8_SB(0, 1), b2 + hstep, voffB); PG8_STAGE(PG8_SA(0, 0), a2, voffA);
            PG8_WAIT_V(8); PG8_WAIT_L(0); PG8_BAR; PG8_MMA(1, 0, At, B0); PG8_MMA(1, 1, At, B1); PG8_BAR; PG8_SCHED;
            PG8_LDB(B0, 1, 0); PG8_LDB(B1, 1, 1); PG8_SCHED; PG8_LDA(At, 1, 0); PG8_STAGE(PG8_SA(0, 1), a2 + hstep, voffA);
            PG8_WAIT_V(8); PG8_WAIT_L(0); PG8_BAR; PG8_MMA(0, 0, At, B0); PG8_MMA(0, 1, At, B1); PG8_BAR; PG8_SCHED;
            PG8_LDA(At, 1, 1); PG8_STAGE(PG8_SB(1, 0), b3, voffB); PG8_STAGE(PG8_SB(1, 1), b3 + hstep, voffB); PG8_STAGE(PG8_SA(1, 0), a3, voffA);
            PG8_WAIT_V(8); PG8_WAIT_L(0); PG8_BAR; PG8_MMA(1, 0, At, B0); PG8_MMA(1, 1, At, B1); PG8_BAR; PG8_SCHED;
            } else {
            PG8_LDB(B0, 0, 0); PG8_SCHED; PG8_LDA(At, 0, 0); PG8_STAGE(PG8_SA(1, 1), a1 + hstep, voffA);
            PG8_WAIT_L(8); PG8_BAR; PG8_WAIT_L(0); PG8_MMA(0, 0, At, B0); PG8_BAR; PG8_SCHED;
            PG8_LDB(B1, 0, 1); PG8_STAGE(PG8_SB(0, 0), b2, voffB);
            PG8_BAR; PG8_WAIT_L(0); PG8_MMA(0, 1, At, B1); PG8_BAR;
            PG8_LDA(At, 0, 1); PG8_STAGE(PG8_SA(0, 0), a2, voffA);
            PG8_BAR; PG8_WAIT_L(0); PG8_MMA(1, 0, At, B0); PG8_BAR; PG8_SCHED;
            PG8_STAGE(PG8_SB(0, 1), b2 + hstep, voffB);
            PG8_WAIT_V(6); PG8_BAR; PG8_MMA(1, 1, At, B1); PG8_BAR;
            PG8_LDB(B0, 1, 0); PG8_SCHED; PG8_LDA(At, 1, 0); PG8_STAGE(PG8_SA(0, 1), a2 + hstep, voffA);
            PG8_WAIT_L(8); PG8_BAR; PG8_WAIT_L(0); PG8_MMA(0, 0, At, B0); PG8_BAR; PG8_SCHED;
            PG8_LDB(B1, 1, 1); PG8_STAGE(PG8_SB(1, 0), b3, voffB);
            PG8_BAR; PG8_WAIT_L(0); PG8_MMA(0, 1, At, B1); PG8_BAR;
            PG8_LDA(At, 1, 1); PG8_STAGE(PG8_SA(1, 0), a3, voffA);
            PG8_BAR; PG8_WAIT_L(0); PG8_MMA(1, 0, At, B0); PG8_BAR; PG8_SCHED;
            PG8_STAGE(PG8_SB(1, 1), b3 + hstep, voffB);
            PG8_WAIT_V(6); PG8_BAR; PG8_MMA(1, 1, At, B1); PG8_BAR;
            }
        }
        if constexpr (ALIGN_EPI) { if (wr == 0) PG8_BAR; }
        if constexpr (!Epi::AFTER_DRAIN) { E(acc, cur, wr, wc, fr, fq); S.done(cur); }
        if (!has_next) break;
#pragma unroll
        for (int a = 0; a < 2; ++a)
#pragma unroll
            for (int b = 0; b < 2; ++b)
#pragma unroll
                for (int m = 0; m < 4; ++m)
#pragma unroll
                    for (int n = 0; n < 2; ++n) acc[a][b][m][n] = (f32x4){0.f, 0.f, 0.f, 0.f};
        cur = nxt; cA = nA; cB = nB; ++ui;
        if constexpr (ALIGN_EPI) { if (wr == 1) PG8_BAR; }
    }
    PG8_WAIT_V(0);
    if constexpr (!ALIGN_EPI) { if (wr == 0) PG8_BAR; }
    PG8_BAR;
    if constexpr (Epi::AFTER_DRAIN) { E.fused(acc, cur, wr, wc, fr, fq, lds, wid, lane); S.done(cur); }
#undef PG8_SA
#undef PG8_SB
#undef PG8_STAGE
#undef PG8_LDA
#undef PG8_LDB
#undef PG8_MMA
#undef PG8_WAIT_V
#undef PG8_WAIT_L
#undef PG8_BAR
#undef PG8_SCHED
}
}

#define STAGE_OPT_INPROJ 1
#define STAGE_OPT_GATES 1
#define STAGE_OPT_Y 1
#define STAGE_OPT_WO 1
#define STAGE_OPT_GU 1
#define STAGE_OPT_DN 1
constexpr bool ANY_OPT_GEMM = STAGE_OPT_INPROJ || STAGE_OPT_GATES || STAGE_OPT_Y || STAGE_OPT_WO || STAGE_OPT_GU || STAGE_OPT_DN;
constexpr int WIN_ROWS = 39 * 256;
constexpr size_t WT_IN = 0, WT_OG = WT_IN + (size_t)WIN_ROWS * 1024 * 2, WT_OD = WT_OG + 2 * MiB, WT_O = WT_OD + 2 * MiB, WT_GU = WT_O + 2 * MiB, WT_DN = WT_GU + (size_t)2 * FF * 1024 * 2, WT_END = WT_DN + (size_t)1024 * FF * 2;
static_assert(WT_END <= 42 * MiB, "weight region");
typedef unsigned u32x4 __attribute__((ext_vector_type(4)));
typedef unsigned u32x2 __attribute__((ext_vector_type(2)));
__device__ __forceinline__ unsigned pk2(float lo, float hi) { return pg8::cvt_pk_bf16(lo, hi); }
__device__ __forceinline__ u32x2 pk4(f32x4 v) { u32x2 w; w.x = pk2(v[0], v[1]); w.y = pk2(v[2], v[3]); return w; }
__device__ __forceinline__ u32x4 pk8(f32x4 a, f32x4 b) { u32x4 w; w.x = pk2(a[0], a[1]); w.y = pk2(a[2], a[3]); w.z = pk2(b[0], b[1]); w.w = pk2(b[2], b[3]); return w; }
__device__ __forceinline__ f32x4 unpk4lo(u32x4 w) { return (f32x4){bf2f(w.x & 0xffffu), bf2f(w.x >> 16), bf2f(w.y & 0xffffu), bf2f(w.y >> 16)}; }
__device__ __forceinline__ f32x4 unpk4hi(u32x4 w) { return (f32x4){bf2f(w.z & 0xffffu), bf2f(w.z >> 16), bf2f(w.w & 0xffffu), bf2f(w.w >> 16)}; }
__device__ __forceinline__ f32x4 sig4(f32x4 v) { return (f32x4){sigmoidf_(v[0]), sigmoidf_(v[1]), sigmoidf_(v[2]), sigmoidf_(v[3])}; }
__device__ __forceinline__ f32x4 silu4(f32x4 v) { return (f32x4){siluf_(v[0]), siluf_(v[1]), siluf_(v[2]), siluf_(v[3])}; }

__device__ __forceinline__ int rope_pos(int d, int half) { const int n = d / half, dl = d % half; return 32 * (dl >> 4) + 8 * ((dl >> 2) & 3) + 4 * n + (dl & 3); }
__device__ __forceinline__ int map_win(int n) {
    if (n < C_A) return n;
    if (n < C_B) return 30 * 256 + 72 + (n - C_A);
    if (n < C_QB) return 30 * 256 + 80 + (n - C_B);
    if (n < C_VB) { const int m = n - C_QB, hd = m >> 7, d = m & 127; return (16 + (hd >> 1)) * 256 + (hd & 1) * 128 + rope_pos(d, 64); }
    if (n < C_QI) return 24 * 256 + (n - C_VB);
    if (n < C_KI) { const int m = n - C_QI, hd = m >> 6, d = m & 63; return (28 + (hd >> 2)) * 256 + ((hd >> 1) & 1) * 128 + (hd & 1) * 64 + rope_pos(d, 32); }
    if (n < C_WI) return 30 * 256 + rope_pos(n - C_KI, 32);
    if (n < C_GA) return 30 * 256 + 64 + (n - C_WI);
    return 31 * 256 + (n - C_GA);
}
__device__ __forceinline__ int map_gu(int cidx) { const int nn = cidx >= FF ? 1 : 0, f = cidx - nn * FF; return 8 * (f >> 2) + 4 * nn + (f & 3); }
template <int MAPK> __device__ __forceinline__ void transpose_item(const float* W, int K, int N, bf16_t* WT, float* scr, int item, int lane) {
    const int nblk = (N + 31) / 32, kb = item / nblk, nb = item % nblk, k0 = 64 * kb, n0 = 32 * nb;
    const int nn = n0 + (lane & 31);
#pragma unroll 8
    for (int i = 0; i < 32; ++i) { const int kk = 2 * i + (lane >> 5); scr[kk * 33 + (lane & 31)] = nn < N ? W[(size_t)(k0 + kk) * N + nn] : 0.f; }
    asm volatile("s_waitcnt lgkmcnt(0)" ::: "memory");
    const int cch = lane & 7;
#pragma unroll
    for (int j = 0; j < 4; ++j) { const int n = (lane >> 3) + 8 * j;
        if (n0 + n < N) { const float* sp = scr + (8 * cch) * 33 + n; const int row = MAPK == 1 ? map_win(n0 + n) : (MAPK == 2 ? map_gu(n0 + n) : n0 + n);
            u32x4 o; o.x = pk2(sp[0], sp[33]); o.y = pk2(sp[2 * 33], sp[3 * 33]); o.z = pk2(sp[4 * 33], sp[5 * 33]); o.w = pk2(sp[6 * 33], sp[7 * 33]);
            *(u32x4*)(WT + (size_t)row * K + k0 + 8 * cch) = o; } }
    asm volatile("s_waitcnt lgkmcnt(0)" ::: "memory");
}
__device__ __forceinline__ void phase_convert_weights(const Ctx& c, int layer, unsigned char* smem) {
    const int lane = otid() & 63, wv = otid() >> 6, gw = blockIdx.x * 8 + wv, nw = gridDim.x * 8;
    float* scr = (float*)smem + wv * (64 * 33);
    unsigned char* wt = c.ws + WS_WT;
    constexpr int I_IN = 16 * ((INC + 31) / 32), I_SQ = 16 * 32, I_GU = 16 * (2 * FF / 32), I_DN = (FF / 64) * 32;
    for (int it = gw; it < I_IN + 3 * I_SQ + I_GU + I_DN; it += nw) {
        int r = it;
        if (r < I_IN) { transpose_item<1>(c.w_in + (size_t)layer * DM * INC, DM, INC, (bf16_t*)(wt + WT_IN), scr, r, lane); continue; } r -= I_IN;
        if (r < I_SQ) { transpose_item<0>(c.w_out_gdn + (size_t)layer * DM * DM, DM, DM, (bf16_t*)(wt + WT_OG), scr, r, lane); continue; } r -= I_SQ;
        if (r < I_SQ) { transpose_item<0>(c.w_out_dsa + (size_t)layer * DM * DM, DM, DM, (bf16_t*)(wt + WT_OD), scr, r, lane); continue; } r -= I_SQ;
        if (r < I_SQ) { transpose_item<0>(c.w_o + (size_t)layer * DM * DM, DM, DM, (bf16_t*)(wt + WT_O), scr, r, lane); continue; } r -= I_SQ;
        if (r < I_GU) { transpose_item<2>(c.w_gate_up + (size_t)layer * DM * 2 * FF, DM, 2 * FF, (bf16_t*)(wt + WT_GU), scr, r, lane); continue; } r -= I_GU;
        transpose_item<0>(c.w_down + (size_t)layer * FF * DM, FF, DM, (bf16_t*)(wt + WT_DN), scr, r, lane);
    }
}

#define EPI_ROWS(...) _Pragma("unroll") for (int ai = 0; ai < 2; ++ai) _Pragma("unroll") for (int m = 0; m < 4; ++m) { const int r = u.pm * 256 + ai * 128 + wr * 64 + m * 16 + fr; __VA_ARGS__ asm volatile("" ::: "memory"); }
struct EpiInProj {
    static constexpr bool PERM = true, AFTER_DRAIN = false;
    unsigned char* R; const float *cosA, *sinA, *cosI, *sinI, *a_log, *dt_bias;
    __device__ __forceinline__ void operator()(const f32x4 (&acc)[2][2][4][2], const pg8::Unit& u, int wr, int wc, int fr, int fq) const {
        asm volatile("" : "+v"(fr), "+v"(fq));
        const int pn = u.pn, cw = wc * 32 + 8 * fq;
        if (pn < 12) { bf16_t* Q = (bf16_t*)(R + R_QKVA); bf16_t* H = (bf16_t*)(R + R_HALO);
            EPI_ROWS(_Pragma("unroll") for (int bj = 0; bj < 2; ++bj) { const int col = pn * 256 + bj * 128 + cw; const u32x4 w = pk8(acc[ai][bj][m][0], acc[ai][bj][m][1]);
                *(u32x4*)(Q + (size_t)r * 3072 + col) = w; if (m == 3 && fr >= 13) *(u32x4*)(H + ((size_t)(r >> 6) * 3 + (fr - 13)) * 3072 + col) = w; }) }
        else if (pn < 16) { bf16_t* Z = (bf16_t*)(R + R_ZS);
            EPI_ROWS(_Pragma("unroll") for (int bj = 0; bj < 2; ++bj) { const int col = (pn - 12) * 256 + bj * 128 + cw; *(u32x4*)(Z + (size_t)r * 1024 + col) = pk8(silu4(acc[ai][bj][m][0]), silu4(acc[ai][bj][m][1])); }) }
        else if (pn < 24) { bf16_t* D = (bf16_t*)(R + ((pn - 16) >> 2 ? R_KB : R_QB)); const int dl = 16 * wc + 4 * fq;
            EPI_ROWS(const int pos = r % SEQ; const f32x4 cs = *(const f32x4*)(cosA + pos * 64 + dl), sn = *(const f32x4*)(sinA + pos * 64 + dl);
                _Pragma("unroll") for (int bj = 0; bj < 2; ++bj) { const int hd = ((pn - 16) & 3) * 2 + bj; const f32x4 x1 = acc[ai][bj][m][0], x2 = acc[ai][bj][m][1];
                    bf16_t* dp = D + (size_t)r * 1024 + hd * 128 + dl; *(u32x2*)dp = pk4(x1 * cs - x2 * sn); *(u32x2*)(dp + 64) = pk4(x2 * cs + x1 * sn); }) }
        else if (pn < 28) { bf16_t* V = (bf16_t*)(R + R_VB);
            EPI_ROWS(_Pragma("unroll") for (int bj = 0; bj < 2; ++bj) { const int col = (pn - 24) * 256 + bj * 128 + cw; *(u32x4*)(V + (size_t)r * 1024 + col) = pk8(acc[ai][bj][m][0], acc[ai][bj][m][1]); }) }
        else if (pn < 30) { bf16_t* QI = (bf16_t*)(R + R_QI); const int dl = 16 * (wc & 1) + 4 * fq;
            EPI_ROWS(const int pos = r % SEQ; const f32x4 cs = *(const f32x4*)(cosI + pos * 32 + dl), sn = *(const f32x4*)(sinI + pos * 32 + dl);
                _Pragma("unroll") for (int bj = 0; bj < 2; ++bj) { const int hd = (pn - 28) * 4 + bj * 2 + (wc >> 1); const f32x4 x1 = acc[ai][bj][m][0], x2 = acc[ai][bj][m][1];
                    bf16_t* dp = QI + (size_t)r * 512 + hd * 64 + dl; *(u32x2*)dp = pk4(x1 * cs - x2 * sn); *(u32x2*)(dp + 32) = pk4(x2 * cs + x1 * sn); }) }
        else {
            if (wc < 2) { bf16_t* KI = (bf16_t*)(R + R_KI); const int dl = 16 * wc + 4 * fq;
                EPI_ROWS(const int pos = r % SEQ; const f32x4 cs = *(const f32x4*)(cosI + pos * 32 + dl), sn = *(const f32x4*)(sinI + pos * 32 + dl);
                    const f32x4 x1 = acc[ai][0][m][0], x2 = acc[ai][0][m][1]; bf16_t* dp = KI + (size_t)r * 64 + dl;
                    *(u32x2*)dp = pk4((x1 * cs - x2 * sn) * 0.125f); *(u32x2*)(dp + 32) = pk4((x2 * cs + x1 * sn) * 0.125f);) }
            else if (wc == 2) {
                if (fq == 0) { float* WI = (float*)(R + R_WI); EPI_ROWS(*(f32x4*)(WI + r * 8) = acc[ai][0][m][0] * 0.35355339059327373f; *(f32x4*)(WI + r * 8 + 4) = acc[ai][0][m][1] * 0.35355339059327373f;) }
                else if (fq == 1) { float* GG = (float*)(R + R_GG);
                    EPI_ROWS(_Pragma("unroll") for (int n = 0; n < 2; ++n) { f32x4 o; _Pragma("unroll") for (int j = 0; j < 4; ++j) o[j] = -__expf(a_log[n * 4 + j]) * softplusf_(acc[ai][0][m][n][j] + dt_bias[n * 4 + j]); *(f32x4*)(GG + r * 8 + n * 4) = o; }) }
                else if (fq == 2) { float* BT = (float*)(R + R_BETA); EPI_ROWS(*(f32x4*)(BT + r * 8) = sig4(acc[ai][0][m][0]); *(f32x4*)(BT + r * 8 + 4) = sig4(acc[ai][0][m][1]);) }
            }
        }
    }
};
struct EpiGates {
    static constexpr bool PERM = true, AFTER_DRAIN = false; bf16_t* SG;
    __device__ __forceinline__ void operator()(const f32x4 (&acc)[2][2][4][2], const pg8::Unit& u, int wr, int wc, int fr, int fq) const {
        EPI_ROWS(_Pragma("unroll") for (int bj = 0; bj < 2; ++bj) { const int col = u.pn * 256 + bj * 128 + wc * 32 + 8 * fq; *(u32x4*)(SG + (size_t)r * 2048 + col) = pk8(sig4(acc[ai][bj][m][0]), sig4(acc[ai][bj][m][1])); })
    }
};
template <int WHICH> struct EpiY {
    static constexpr bool PERM = true, AFTER_DRAIN = false; const bf16_t* SG; bf16_t* MG;
    __device__ __forceinline__ void operator()(const f32x4 (&acc)[2][2][4][2], const pg8::Unit& u, int wr, int wc, int fr, int fq) const {
        EPI_ROWS(_Pragma("unroll") for (int bj = 0; bj < 2; ++bj) { const int col = u.pn * 256 + bj * 128 + wc * 32 + 8 * fq;
            const u32x4 g = *(const u32x4*)(SG + (size_t)r * 2048 + WHICH * 1024 + col); f32x4 lo = unpk4lo(g) * acc[ai][bj][m][0], hi = unpk4hi(g) * acc[ai][bj][m][1];
            if (WHICH == 1) { const u32x4 p = *(const u32x4*)(MG + (size_t)r * 1024 + col); lo += unpk4lo(p); hi += unpk4hi(p); }
            *(u32x4*)(MG + (size_t)r * 1024 + col) = pk8(lo, hi); })
    }
};
struct EpiResid {
    static constexpr bool PERM = true, AFTER_DRAIN = false; const float* base; float* out;
    __device__ __forceinline__ void operator()(const f32x4 (&acc)[2][2][4][2], const pg8::Unit& u, int wr, int wc, int fr, int fq) const {
        EPI_ROWS(_Pragma("unroll") for (int bj = 0; bj < 2; ++bj) { const size_t off = (size_t)r * 1024 + u.pn * 256 + bj * 128 + wc * 32 + 8 * fq;
            const f32x4 b0 = *(const f32x4*)(base + off), b1 = *(const f32x4*)(base + off + 4); *(f32x4*)(out + off) = b0 + acc[ai][bj][m][0]; *(f32x4*)(out + off + 4) = b1 + acc[ai][bj][m][1]; })
    }
};
struct EpiSwiglu {
    static constexpr bool PERM = true, AFTER_DRAIN = false; bf16_t* ACT;
    __device__ __forceinline__ void operator()(const f32x4 (&acc)[2][2][4][2], const pg8::Unit& u, int wr, int wc, int fr, int fq) const {
        EPI_ROWS(_Pragma("unroll") for (int bj = 0; bj < 2; ++bj) { const int f0 = u.pn * 128 + bj * 64 + wc * 16 + 4 * fq; *(u32x2*)(ACT + (size_t)r * FF + f0) = pk4(silu4(acc[ai][bj][m][0]) * acc[ai][bj][m][1]); })
    }
};

#define STAGE_OPT_GDN 1
typedef short bf16x8 __attribute__((ext_vector_type(8)));
typedef float f32x16 __attribute__((ext_vector_type(16)));
typedef float f32x2_t __attribute__((ext_vector_type(2)));
typedef __bf16 bf16x2_t __attribute__((ext_vector_type(2)));
__device__ __forceinline__ unsigned cvtpk_s(float lo, float hi) { f32x2_t v = {lo, hi}; bf16x2_t b = __builtin_convertvector(v, bf16x2_t); return __builtin_bit_cast(unsigned, b); }
__device__ __forceinline__ int crow(int r, int hi) { return (r & 3) + 8 * (r >> 2) + 4 * hi; }
#define MFMA32(a, b, c) __builtin_amdgcn_mfma_f32_32x32x16_bf16((a), (b), (c), 0, 0, 0)
__device__ __forceinline__ bf16x8 pack_step(const f32x16& x, int s) {
    u32x4 p; p.x = cvtpk_s(x[8 * s], x[8 * s + 1]); p.y = cvtpk_s(x[8 * s + 2], x[8 * s + 3]); p.z = cvtpk_s(x[8 * s + 4], x[8 * s + 5]); p.w = cvtpk_s(x[8 * s + 6], x[8 * s + 7]);
    return __builtin_bit_cast(bf16x8, p);
}
constexpr int BLOB_WF = 0, BLOB_QDF = 16384, BLOB_KDF = 32768, BLOB_A_BYTES = 49152, BLOB_QKF = 0, BLOB_UF = 8192, BLOB_B_BYTES = 24576;
constexpr size_t P2_BLOBB = 0, P2_GLAST = 24 * MiB, P2_MASK = 25 * MiB;
__device__ __forceinline__ unsigned char* vaddrA(unsigned char* qkva, int ck, int h, int v) { const int i = (v >> 8) & 63, part = v >> 14; return qkva + ((size_t)(ck * 64 + i) * 3072 + part * 1024 + h * 128) * 2 + (v & 255); }
__device__ __forceinline__ u32x4 frag_from_rows(const bf16_t* T, int ld, int it, int ks, int lane) {
    const int r = lane & 31, hh = lane >> 5; const bf16_t* p = T + (size_t)(32 * it + r) * ld + 32 * (ks >> 1) + 16 * (ks & 1) + 4 * hh;
    const u32x2 a = *(const u32x2*)p, b = *(const u32x2*)(p + 8); return (u32x4){a.x, a.y, b.x, b.y};
}

__device__ __forceinline__ void gdn_prep_unit(const Ctx& c, int layer, int unit, unsigned char* smem) {
    const int tid = otid(), lane = tid & 63, wv = tid >> 6;
    const int h = unit & 7, ck = unit >> 3;
    bf16_t* Q = (bf16_t*)(c.R + R_QKVA); const bf16_t* HL = (const bf16_t*)(c.R + R_HALO);
    const float* cw = c.conv_w + (size_t)layer * 4 * 3072;
    float* X = (float*)smem;
    float* rq = X + 64 * 388; float* rk = rq + 64; float* gam = rk + 64; float* eg = gam + 64; float* egl = eg + 64; float* bet = egl + 64; float* gg = bet + 64;
    bf16_t* KNb = (bf16_t*)(gg + 64); bf16_t* QNb = KNb + 64 * 136;
    float* AM = (float*)(QNb + 64 * 136);
    const int row0 = ck * 64;
    __syncthreads();
    bf16_t* RAW = KNb;
    { const bool first = (row0 % SEQ) == 0;
      for (int p = tid; p < 67 * 48; p += 512) { const int rr = p / 48, cq = p - rr * 48, part = cq >> 4, col = part * 1024 + h * 128 + (cq & 15) * 8;
          u32x4 v = {0u, 0u, 0u, 0u};
          if (rr >= 3) v = *(const u32x4*)(Q + (size_t)(row0 + rr - 3) * 3072 + col);
          else if (!first) v = *(const u32x4*)(HL + ((size_t)(ck - 1) * 3 + rr) * 3072 + col);
          *(u32x4*)(RAW + rr * 384 + cq * 8) = v; } }
    __syncthreads();
    for (int q = tid; q < 4 * 384; q += 512) {
        const int g = q / 384, ch = q - g * 384, part = ch >> 7, col = part * 1024 + h * 128 + (ch & 127);
        const float w0 = cw[col], w1 = cw[3072 + col], w2 = cw[2 * 3072 + col], w3 = cw[3 * 3072 + col];
        const bf16_t* p = RAW + (16 * g) * 384 + ch;
        float x3 = bf2f(p[0]), x2 = bf2f(p[384]), x1 = bf2f(p[2 * 384]);
#pragma unroll
        for (int r = 0; r < 16; ++r) { const float xv = bf2f(p[(r + 3) * 384]); X[(16 * g + r) * 388 + ch] = siluf_(w0 * x3 + w1 * x2 + w2 * x1 + w3 * xv); x3 = x2; x2 = x1; x1 = xv; }
    }
    if (tid < 64) { gg[tid] = ((const float*)(c.R + R_GG))[(row0 + tid) * 8 + h]; bet[tid] = ((const float*)(c.R + R_BETA))[(row0 + tid) * 8 + h]; }
    __syncthreads();
    for (int p = wv * 16; p < wv * 16 + 16; ++p) { const int which = p & 1, i = p >> 1; const f32x2_t v = *(const f32x2_t*)(X + i * 388 + which * 128 + lane * 2);
        const float rs = rsqrtf(wave_sum(v.x * v.x + v.y * v.y) + EPS); if (lane == 0) { if (which) rk[i] = rs; else rq[i] = rs; } }
    if (wv == 7) { float v = gg[lane];
#pragma unroll
        for (int o = 1; o < 64; o <<= 1) { const float t = __shfl_up(v, o); if (lane >= o) v += t; }
        const float gl = __shfl(v, 63); gam[lane] = v; eg[lane] = __expf(v); egl[lane] = __expf(gl - v);
        if (lane == 0) ((float*)(c.R + R_P2 + P2_GLAST))[ck * 8 + h] = __expf(gl); }
    __syncthreads();
    for (int q = tid; q < 64 * 64; q += 512) { const int i = q >> 6, d = (q & 63) * 2; const f32x2_t a = *(const f32x2_t*)(X + i * 388 + d), b = *(const f32x2_t*)(X + i * 388 + 128 + d);
        const float sq = rq[i] * 0.08838834764831845f, sk = rk[i];
        *(unsigned*)(QNb + i * 136 + d) = cvtpk_s(a.x * sq, a.y * sq); *(unsigned*)(KNb + i * 136 + d) = cvtpk_s(b.x * sk, b.y * sk); }
    __syncthreads();
    { const int prod = wv >> 2, ti = (wv >> 1) & 1, tj = wv & 1, r = lane & 31, hh = lane >> 5;
      const bf16_t* Ab = (prod ? QNb : KNb) + (32 * ti + r) * 136 + 8 * hh; const bf16_t* Bb = KNb + (32 * tj + r) * 136 + 8 * hh;
      f32x16 acc = {};
#pragma unroll
      for (int ks = 0; ks < 8; ++ks) acc = MFMA32(*(const bf16x8*)(Ab + 16 * ks), *(const bf16x8*)(Bb + 16 * ks), acc);
      const int jj = 32 * tj + r; const float gj = gam[jj];
#pragma unroll
      for (int rr = 0; rr < 16; ++rr) { const int i = 32 * ti + crow(rr, hh); const float dec = __expf(gam[i] - gj);
          if (prod == 0) AM[i * 68 + jj] = (jj < i) ? bet[i] * acc[rr] * dec : 0.f;
          else ((bf16_t*)((unsigned char*)(X + i * 388) + 528))[jj] = f2bf((jj <= i) ? acc[rr] * dec : 0.f); } }
    __syncthreads();
    unsigned char* Qb = (unsigned char*)Q; unsigned char* PB = c.R + R_P2 + P2_BLOBB + (size_t)(ck * 8 + h) * BLOB_B_BYTES;
#define TMAT(i, j) (*(float*)((unsigned char*)(X + (i) * 388) + 704 + (j) * 4))
    int zl = 0; asm volatile("" : "+v"(zl));
    if (wv == 0) {
        const int kb = (lane >> 4) * 16, cI = lane & 15; float x[16];
#pragma unroll
        for (int i = 0; i < 16; ++i) x[i] = (i == cI) ? 1.f : 0.f;
#pragma unroll
        for (int i = 1; i < 16; ++i) { float a = x[i];
#pragma unroll
            for (int j4 = 0; j4 < i; j4 += 4) { const f32x4 am = *(const f32x4*)(AM + (kb + i) * 68 + kb + j4 + zl);
                a -= am[0] * x[j4]; if (j4 + 1 < i) a -= am[1] * x[j4 + 1]; if (j4 + 2 < i) a -= am[2] * x[j4 + 2]; if (j4 + 3 < i) a -= am[3] * x[j4 + 3]; }
            x[i] = (i > cI) ? a : x[i]; }
#pragma unroll
        for (int i = 0; i < 16; ++i) TMAT(kb + i, kb + cI) = x[i];
    } else if (wv < 4) {
        for (int q = tid - 64; q < 64 * 64; q += 192) { const int i = q >> 6, j = q & 63; if ((i >> 4) != (j >> 4)) TMAT(i, j) = 0.f; }
    } else {
        const int t4 = tid - 256;
        for (int f = t4; f < 1024; f += 256) {
            const int ln = f & 63, ks = (f >> 6) & 7, it = f >> 9; const u32x4 w = frag_from_rows(QNb, 136, it, ks, ln); const float sc = eg[32 * it + (ln & 31)];
            const f32x4 lo = unpk4lo(w) * sc, hi = unpk4hi(w) * sc; *(u32x4*)vaddrA(Qb, ck, h, BLOB_QDF + f * 16) = pk8(lo, hi); }
        for (int f = t4; f < 1024; f += 256) {
            const int ln = f & 63, ks = (f >> 6) & 3, dt = f >> 8, r = ln & 31, hh = ln >> 5, d = 32 * dt + r, ib = 32 * (ks >> 1) + 16 * (ks & 1) + 4 * hh; float v[8];
#pragma unroll
            for (int j = 0; j < 8; ++j) { const int i = ib + 8 * (j >> 2) + (j & 3); v[j] = bf2f(KNb[i * 136 + d]) * egl[i]; }
            *(u32x4*)vaddrA(Qb, ck, h, BLOB_KDF + f * 16) = pk8((f32x4){v[0], v[1], v[2], v[3]}, (f32x4){v[4], v[5], v[6], v[7]}); }
        for (int f = t4; f < 512; f += 256) {
            const int ln = f & 63, ks = (f >> 6) & 3, it = f >> 8; *(u32x4*)(PB + BLOB_QKF + f * 16) = frag_from_rows((const bf16_t*)((const unsigned char*)X + 528), 776, it, ks, ln); }
    }
    __syncthreads();
    float* MS_ = (float*)QNb;
    if (wv < 2) { const int b0 = 32 * wv, i = lane >> 2, c4 = (lane & 3) * 4; f32x4 m = {0.f, 0.f, 0.f, 0.f};
#pragma unroll
        for (int j = 0; j < 16; ++j) { const float a = AM[(b0 + 16 + i) * 68 + b0 + j]; const f32x4 t = *(const f32x4*)&TMAT(b0 + j, b0 + c4); m += a * t; }
        *(f32x4*)(MS_ + (wv * 16 + i) * 36 + c4) = m; }
    __syncthreads();
    if (wv < 2) { const int b0 = 32 * wv, i = lane >> 2, c4 = (lane & 3) * 4; f32x4 t = {0.f, 0.f, 0.f, 0.f};
#pragma unroll
        for (int j = 0; j < 16; ++j) { const float a = TMAT(b0 + 16 + i, b0 + 16 + j); const f32x4 m = *(const f32x4*)(MS_ + (wv * 16 + j) * 36 + c4); t -= a * m; }
        *(f32x4*)&TMAT(b0 + 16 + i, b0 + c4) = t; }
    __syncthreads();
    { const int i = tid >> 4, c2 = (tid & 15) * 2; f32x2_t m = {0.f, 0.f};
#pragma unroll 8
      for (int j = 0; j < 32; ++j) { const float a = AM[(32 + i) * 68 + j]; const f32x2_t t = *(const f32x2_t*)&TMAT(j, c2); m += a * t; }
      __syncthreads();
      *(f32x2_t*)(MS_ + i * 36 + c2) = m; }
    __syncthreads();
    { const int i = tid >> 4, c2 = (tid & 15) * 2; f32x2_t t = {0.f, 0.f};
#pragma unroll 8
      for (int j = 0; j < 32; ++j) { const float a = TMAT(32 + i, 32 + j); const f32x2_t m = *(const f32x2_t*)(MS_ + j * 36 + c2); t -= a * m; }
      *(f32x2_t*)&TMAT(32 + i, c2) = t; }
    __syncthreads();
    { const int r = lane & 31, hh = lane >> 5, col = 32 * wv + r; f32x16 acc0 = {}, acc1 = {};
#pragma unroll
      for (int ks = 0; ks < 4; ++ks) { float bv[8];
#pragma unroll
          for (int j = 0; j < 8; ++j) { const int i = 16 * ks + 8 * hh + j; bv[j] = (wv < 4) ? X[i * 388 + 256 + col] * bet[i] : bf2f(KNb[i * 136 + col - 128]) * (bet[i] * eg[i]); }
          const u32x4 bw = pk8((f32x4){bv[0], bv[1], bv[2], bv[3]}, (f32x4){bv[4], bv[5], bv[6], bv[7]});
          const f32x4 a0 = *(const f32x4*)&TMAT(r, 16 * ks + 8 * hh), a1 = *(const f32x4*)&TMAT(r, 16 * ks + 8 * hh + 4), a2 = *(const f32x4*)&TMAT(32 + r, 16 * ks + 8 * hh), a3 = *(const f32x4*)&TMAT(32 + r, 16 * ks + 8 * hh + 4);
          acc0 = MFMA32(__builtin_bit_cast(bf16x8, pk8(a0, a1)), __builtin_bit_cast(bf16x8, bw), acc0);
          acc1 = MFMA32(__builtin_bit_cast(bf16x8, pk8(a2, a3)), __builtin_bit_cast(bf16x8, bw), acc1); }
      __syncthreads();
#pragma unroll
      for (int rr = 0; rr < 16; ++rr) { ((bf16_t*)(X + crow(rr, hh) * 388))[col] = f2bf(acc0[rr]); ((bf16_t*)(X + (32 + crow(rr, hh)) * 388))[col] = f2bf(acc1[rr]); } }
#undef TMAT
    __syncthreads();
    for (int f = tid; f < 1024; f += 512) { const int ln = f & 63, ks = (f >> 6) & 7, it = f >> 9; *(u32x4*)vaddrA(Qb, ck, h, BLOB_WF + f * 16) = frag_from_rows((const bf16_t*)X + 128, 776, it, ks, ln); }
    { const int ln = tid & 63, it = (tid >> 6) & 1, eb = tid >> 7, cc = ln & 31, hi = ln >> 5; unsigned wds[8];
#pragma unroll
      for (int rp = 0; rp < 8; ++rp) { const int i0 = 32 * it + crow(2 * rp, hi), i1 = 32 * it + crow(2 * rp + 1, hi);
          wds[rp] = (unsigned)((const bf16_t*)(X + i0 * 388))[32 * eb + cc] | ((unsigned)((const bf16_t*)(X + i1 * 388))[32 * eb + cc] << 16); }
      u32x4* dst = (u32x4*)(PB + BLOB_UF + ((eb * 2 + it) * 64 + ln) * 32); dst[0] = (u32x4){wds[0], wds[1], wds[2], wds[3]}; dst[1] = (u32x4){wds[4], wds[5], wds[6], wds[7]}; }
}

constexpr int SC_BUF = 57344, SC_OBUF = 2 * SC_BUF, SC_OLD = 136;
__device__ __forceinline__ void gdn_scan_unit(const Ctx& c, int layer, int split, int su, unsigned char* smem) {
    const int tid = otid(), lane = tid & 63, wv = __builtin_amdgcn_readfirstlane(tid >> 6);
    const int bl = su >> 3, h = su & 7, ck0 = bl * (SEQ / 64);
    unsigned char* Qb = c.R + R_QKVA; const unsigned char* PB0 = c.R + R_P2 + P2_BLOBB; const float* GL = (const float*)(c.R + R_P2 + P2_GLAST);
    const bf16_t* ZS = (const bf16_t*)(c.R + R_ZS); const float* gn = c.gdn_norm + layer * 128;
    __syncthreads();
#pragma unroll
    for (int q = 0; q < 7; ++q) { const int v = (q * 512 + tid) * 16; const unsigned char* src = q < 6 ? vaddrA(Qb, ck0, h, v) : PB0 + (size_t)(ck0 * 8 + h) * BLOB_B_BYTES + BLOB_QKF + (v - BLOB_A_BYTES);
        *(u32x4*)(smem + v) = *(const u32x4*)src; }
    f32x16 S[4] = {};
    u32x4 zsn[4] = {};
    u32x4 un[4];
    if (wv < 4) { const u32x4* up = (const u32x4*)(PB0 + (size_t)(ck0 * 8 + h) * BLOB_B_BYTES + BLOB_UF + (wv * 2 * 64 + lane) * 32); un[0] = up[0]; un[1] = up[1]; un[2] = up[128]; un[3] = up[129]; }
    __syncthreads();
    constexpr int NCH = SEQ / 64;
#pragma unroll 1
    for (int n = 0; n <= NCH; ++n) {
        const int ck = ck0 + n; unsigned char* buf = smem + (n & 1) * SC_BUF; bf16_t* ob = (bf16_t*)(smem + SC_OBUF) + (n & 1) * 64 * SC_OLD;
        if (wv < 4) {
          if (n < NCH) {
            int lane = tid & 63; asm volatile("" : "+v"(lane));
            const float gl = GL[ck * 8 + h];
            bf16x8 Sb[8];
#pragma unroll
            for (int t = 0; t < 4; ++t) { Sb[2 * t] = pack_step(S[t], 0); Sb[2 * t + 1] = pack_step(S[t], 1); }
            f32x16 vn[2], o[2];
#pragma unroll
            for (int it = 0; it < 2; ++it) { f32x16 a = {};
#pragma unroll
                for (int ks = 0; ks < 8; ++ks) a = MFMA32(*(const bf16x8*)(buf + BLOB_WF + ((it * 8 + ks) * 64 + lane) * 16), Sb[ks], a);
                const u32x4 u0 = un[2 * it], u1 = un[2 * it + 1];
                const unsigned uw[8] = {u0.x, u0.y, u0.z, u0.w, u1.x, u1.y, u1.z, u1.w};
#pragma unroll
                for (int r = 0; r < 16; ++r) vn[it][r] = bf2f((r & 1) ? (uw[r >> 1] >> 16) : (uw[r >> 1] & 0xffffu)) - a[r];
                __builtin_amdgcn_sched_barrier(0); }
            if (n + 1 < NCH) { const u32x4* up = (const u32x4*)(PB0 + (size_t)((ck + 1) * 8 + h) * BLOB_B_BYTES + BLOB_UF + (wv * 2 * 64 + lane) * 32); un[0] = up[0]; un[1] = up[1]; un[2] = up[128]; un[3] = up[129]; }
#pragma unroll
            for (int it = 0; it < 2; ++it) { f32x16 b = {};
#pragma unroll
                for (int ks = 0; ks < 8; ++ks) b = MFMA32(*(const bf16x8*)(buf + BLOB_QDF + ((it * 8 + ks) * 64 + lane) * 16), Sb[ks], b);
                o[it] = b; __builtin_amdgcn_sched_barrier(0); }
            bf16x8 vb[4];
#pragma unroll
            for (int it = 0; it < 2; ++it) { vb[2 * it] = pack_step(vn[it], 0); vb[2 * it + 1] = pack_step(vn[it], 1); }
#pragma unroll
            for (int it = 0; it < 2; ++it)
#pragma unroll
                for (int ks = 0; ks < 4; ++ks) o[it] = MFMA32(*(const bf16x8*)(buf + BLOB_A_BYTES + BLOB_QKF + ((it * 4 + ks) * 64 + lane) * 16), vb[ks], o[it]);
            __builtin_amdgcn_sched_barrier(0);
#pragma unroll
            for (int t = 0; t < 4; ++t) { S[t] = S[t] * gl;
#pragma unroll
                for (int ks = 0; ks < 4; ++ks) S[t] = MFMA32(*(const bf16x8*)(buf + BLOB_KDF + ((t * 4 + ks) * 64 + lane) * 16), vb[ks], S[t]);
                __builtin_amdgcn_sched_barrier(0); }
            { const int cc = lane & 31, hi = lane >> 5;
#pragma unroll
              for (int it = 0; it < 2; ++it)
#pragma unroll
                  for (int r = 0; r < 16; ++r) ob[(32 * it + crow(r, hi)) * SC_OLD + 32 * wv + cc] = f2bf(o[it][r]); }
          }
        } else {
            int t4 = tid - 256; asm volatile("" : "+v"(t4));
            if (n + 1 < NCH) {
                const unsigned char* pa = Qb + ((size_t)((ck + 1) * 64 + (t4 >> 4)) * 3072 + h * 128) * 2 + (t4 & 15) * 16;
                const unsigned char* pb = PB0 + (size_t)((ck + 1) * 8 + h) * BLOB_B_BYTES + BLOB_QKF + t4 * 16;
                PG8_LAS unsigned char* nb = (PG8_LAS unsigned char*)smem + ((n + 1) & 1) * SC_BUF + (wv - 4) * 1024;
#pragma unroll
                for (int q = 0; q < 12; ++q) __builtin_amdgcn_global_load_lds((const unsigned*)(pa + (size_t)(q & 3) * 16 * 6144 + (q >> 2) * 2048), (PG8_LAS unsigned*)(nb + q * 4096), 16, 0, 0);
                __builtin_amdgcn_global_load_lds((const unsigned*)pb, (PG8_LAS unsigned*)(nb + 12 * 4096), 16, 0, 0);
                __builtin_amdgcn_global_load_lds((const unsigned*)(pb + 4096), (PG8_LAS unsigned*)(nb + 13 * 4096), 16, 0, 0); }
            u32x4 zc[4] = {zsn[0], zsn[1], zsn[2], zsn[3]};
            if (n < NCH) { const bf16_t* zp = ZS + ((size_t)ck * 64 + (t4 >> 2)) * 1024 + h * 128 + (t4 & 3) * 32;
#pragma unroll
                for (int q = 0; q < 4; ++q) zsn[q] = *(const u32x4*)(zp + 8 * q); }
            if (n > 0) {
                const bf16_t* po = (const bf16_t*)(smem + SC_OBUF) + ((n - 1) & 1) * 64 * SC_OLD; const int i = t4 >> 2, qc = (t4 & 3) * 32;
                const size_t rowl = (size_t)(ck - 1) * 64 + i; float ss = 0.f;
#pragma unroll
                for (int q = 0; q < 4; ++q) { const u32x4 w = *(const u32x4*)(po + i * SC_OLD + qc + 8 * q); const f32x4 a = unpk4lo(w), b = unpk4hi(w);
#pragma unroll
                    for (int j = 0; j < 4; ++j) ss += a[j] * a[j] + b[j] * b[j]; }
                ss += __shfl_xor(ss, 1); ss += __shfl_xor(ss, 2); const float rs = rsqrtf(ss * (1.f / 128.f) + EPS);
#pragma unroll
                for (int q = 0; q < 4; ++q) { const u32x4 w = *(const u32x4*)(po + i * SC_OLD + qc + 8 * q); const u32x4 z = zc[q];
                    const f32x4 ga = *(const f32x4*)(gn + qc + 8 * q), gb = *(const f32x4*)(gn + qc + 8 * q + 4);
                    const f32x4 oa = unpk4lo(w) * rs * ga * unpk4lo(z), obv = unpk4hi(w) * rs * gb * unpk4hi(z);
                    *(u32x4*)(c.OA + ((size_t)split * MS + rowl) * 1024 + h * 128 + qc + 8 * q) = pk8(oa, obv); } }
            asm volatile("s_waitcnt vmcnt(0)" ::: "memory");
        }
        __syncthreads();
    }
}
__device__ __forceinline__ void phase_gdn_prep(const Ctx& c, int layer, unsigned char* smem) { for (int u = blockIdx.x; u < (MS / 64) * 8; u += gridDim.x) gdn_prep_unit(c, layer, u, smem); }
__device__ __forceinline__ void phase_gdn_scan(const Ctx& c, int layer, int split, unsigned char* smem) { for (int u = blockIdx.x; u < BPS * 8; u += gridDim.x) gdn_scan_unit(c, layer, split, u, smem); }

#define STAGE_OPT_DSA 1
#ifndef PROBE_DUP_MASK
#define PROBE_DUP_MASK 0
#endif
#ifndef PROBE_C_MODE
#define PROBE_C_MODE 0
#endif
__device__ __forceinline__ unsigned fkey(float x) { const unsigned u = __float_as_uint(x); return (u & 0x80000000u) ? ~u : (u | 0x80000000u); }
__device__ __forceinline__ float fkey_inv(unsigned k) { return __uint_as_float((k & 0x80000000u) ? (k & 0x7fffffffu) : ~k); }
constexpr int SL_QIF = 0, SL_WIL = 16384, SL_ST = 16896, SL_HIST = 18432, SL_MWG = 34816, SL_MWE = 43008, SL_CAND = 51200;
__device__ __forceinline__ void dsa_select_unit(const Ctx& c, int unit, unsigned char* smem) {
    const int tid = otid(), lane = tid & 63, wv = __builtin_amdgcn_readfirstlane(tid >> 6), cc = lane & 31, hi = lane >> 5;
    const int bl = unit & (BPS - 1), qg = (SEQ / 16 - 1) - unit / BPS, t0 = 16 * qg, rb = bl * SEQ, row0 = rb + t0, nkt = (t0 + 47) >> 5;
    const bf16_t* QI = (const bf16_t*)(c.R + R_QI); const bf16_t* KI = (const bf16_t*)(c.R + R_KI); const float* WI = (const float*)(c.R + R_WI);
    float* WIL = (float*)(smem + SL_WIL); unsigned* ST = (unsigned*)(smem + SL_ST); float* STf = (float*)ST; unsigned* HIST = (unsigned*)(smem + SL_HIST);
    unsigned* MWG = (unsigned*)(smem + SL_MWG); unsigned* MWE = (unsigned*)(smem + SL_MWE); float* CAND = (float*)(smem + SL_CAND);
    const float NINF = -__builtin_inff();
    __syncthreads();
    for (int p = tid; p < 1024; p += 512) { const int f = p >> 6, ln = p & 63, rt = f >> 2, s = f & 3, r = ln & 31, hh = ln >> 5;
        *(u32x4*)(smem + SL_QIF + p * 16) = *(const u32x4*)(QI + (size_t)(row0 + 4 * rt + (r >> 3)) * 512 + (r & 7) * 64 + 16 * s + 8 * hh); }
    if (tid < 128) WIL[tid] = WI[(row0 + (tid >> 3)) * 8 + (tid & 7)];
    for (int p = tid; p < 4096; p += 512) MWG[p] = 0u;
    if (tid < 192) ST[tid] = (tid < 16) ? 0xffffffffu : 0u;
    __syncthreads();
    float sc[16][4][2];
    bf16x8 bq[3][4];
#define SEL_LOADB(slot, ktl_) do { if (wv + 8 * (ktl_) < nkt) { const bf16_t* kp_ = KI + (size_t)(rb + 32 * (wv + 8 * (ktl_)) + cc) * 64 + 8 * hi; \
        _Pragma("unroll") for (int s_ = 0; s_ < 4; ++s_) bq[slot][s_] = *(const bf16x8*)(kp_ + 16 * s_); } } while (0)
    SEL_LOADB(0, 0); SEL_LOADB(1, 1);
#pragma unroll
    for (int ktl = 0; ktl < 16; ++ktl) {
        const int kt = wv + 8 * ktl;
        if (ktl + 2 < 16) SEL_LOADB((ktl + 2) % 3, ktl + 2);
        if (kt < nkt) {
            const int key = 32 * kt + cc;
#pragma unroll
            for (int rt = 0; rt < 4; ++rt) {
                f32x16 acc = {};
#pragma unroll
                for (int s = 0; s < 4; ++s) acc = MFMA32(*(const bf16x8*)(smem + SL_QIF + ((rt * 4 + s) * 64 + lane) * 16), bq[ktl % 3][s], acc);
                float p[4];
#pragma unroll
                for (int qq = 0; qq < 4; ++qq) { const f32x4 w4 = *(const f32x4*)(WIL + (4 * rt + qq) * 8 + 4 * hi);
                    p[qq] = w4[0] * fmaxf(acc[4 * qq], 0.f) + w4[1] * fmaxf(acc[4 * qq + 1], 0.f) + w4[2] * fmaxf(acc[4 * qq + 2], 0.f) + w4[3] * fmaxf(acc[4 * qq + 3], 0.f); }
                const auto r01 = __builtin_amdgcn_permlane32_swap(__float_as_uint(p[0]), __float_as_uint(p[1]), false, false);
                const auto r23 = __builtin_amdgcn_permlane32_swap(__float_as_uint(p[2]), __float_as_uint(p[3]), false, false);
                float s0 = __uint_as_float(r01[0]) + __uint_as_float(r01[1]) + 0.f, s1 = __uint_as_float(r23[0]) + __uint_as_float(r23[1]) + 0.f;
                if (key > t0 + 4 * rt + hi) s0 = NINF;
                if (key > t0 + 4 * rt + 2 + hi) s1 = NINF;
                sc[ktl][rt][0] = s0; sc[ktl][rt][1] = s1;
            }
        } else {
#pragma unroll
            for (int rt = 0; rt < 4; ++rt) { sc[ktl][rt][0] = NINF; sc[ktl][rt][1] = NINF; }
        }
    }
#undef SEL_LOADB
    if (t0 >= TOPK) {
        {
#pragma unroll
          for (int rt = 0; rt < 4; ++rt)
#pragma unroll
              for (int i = 0; i < 2; ++i) { float mn = __builtin_inff(), mx = NINF;
#pragma unroll
                  for (int ktl = 0; ktl < 16; ++ktl) { const float x = sc[ktl][rt][i]; mx = fmaxf(mx, x); mn = (x > NINF) ? fminf(mn, x) : mn; }
#pragma unroll
                  for (int o = 1; o < 32; o <<= 1) { mn = fminf(mn, __shfl_xor(mn, o)); mx = fmaxf(mx, __shfl_xor(mx, o)); }
                  if (cc == 0 && mx > NINF) { const int q = 4 * rt + 2 * i + hi; atomicMin(&ST[q], fkey(mn)); atomicMax(&ST[16 + q], fkey(mx)); } } }
        __syncthreads();
        if (tid < 16) { STf[32 + tid] = fkey_inv(ST[tid]); STf[48 + tid] = fkey_inv(ST[16 + tid]); ST[64 + tid] = TOPK; ST[96 + tid] = 0u; }
        __syncthreads();
#pragma unroll 1
        for (int level = 0; level < 12; ++level) {
            if (tid < 16 && ST[96 + tid] == 0u && STf[32 + tid] == STf[48 + tid]) { STf[80 + tid] = STf[32 + tid]; ST[96 + tid] = 1u; }
            for (int p = tid; p < 4096; p += 512) HIST[p] = 0u;
            if (tid == 0) ST[176] = 0u;
            if (tid < 16) { ST[144 + tid] = 0u; ST[tid] = 0xffffffffu; ST[16 + tid] = 0u; }
            __syncthreads();
#pragma unroll
            for (int rt = 0; rt < 4; ++rt)
#pragma unroll
                for (int i = 0; i < 2; ++i) { const int q = 4 * rt + 2 * i + hi;
                    if (ST[96 + q] == 0u) { const float lo = STf[32 + q], hv = STf[48 + q], scale = 256.f / (hv - lo);
#pragma unroll
                        for (int ktl = 0; ktl < 16; ++ktl) { float x = sc[ktl][rt][i]; asm volatile("" : "+v"(x));
                            if (x >= lo && x <= hv) { const int b = min(255, (int)((x - lo) * scale)); atomicAdd(&HIST[q * 256 + b], 1u); } } } }
            __syncthreads();
            { const int q = 2 * wv + hi;
              if (ST[96 + q] == 0u) { const unsigned krem = ST[64 + q]; unsigned loc[8]; unsigned lsum = 0;
#pragma unroll
                  for (int j = 0; j < 8; ++j) { loc[j] = HIST[q * 256 + 255 - 8 * cc - j]; lsum += loc[j]; }
                  unsigned incl = lsum;
#pragma unroll
                  for (int o = 1; o < 32; o <<= 1) { const unsigned t = __shfl_up(incl, o, 32); if (cc >= o) incl += t; }
                  const unsigned excl = incl - lsum;
                  if (excl < krem && krem <= incl) { unsigned cum = excl; int bs = 0; unsigned cn = 0; bool found = false;
#pragma unroll
                      for (int j = 0; j < 8; ++j) { if (!found) { if (cum + loc[j] >= krem) { bs = 255 - 8 * cc - j; cn = loc[j]; found = true; } else cum += loc[j]; } }
                      ST[112 + q] = (unsigned)bs; ST[64 + q] = krem - cum; ST[128 + q] = cn; } } }
            __syncthreads();
#pragma unroll
            for (int rt = 0; rt < 4; ++rt)
#pragma unroll
                for (int i = 0; i < 2; ++i) { const int q = 4 * rt + 2 * i + hi;
                    if (ST[96 + q] == 0u) { const float lo = STf[32 + q], hv = STf[48 + q], scale = 256.f / (hv - lo); const int bs = (int)ST[112 + q]; const bool small = ST[128 + q] <= 256u;
#pragma unroll
                        for (int ktl = 0; ktl < 16; ++ktl) { float x = sc[ktl][rt][i]; asm volatile("" : "+v"(x));
                            if (x >= lo && x <= hv && min(255, (int)((x - lo) * scale)) == bs) {
                                if (small) { const unsigned pos = atomicAdd(&ST[144 + q], 1u); CAND[q * 256 + pos] = x; }
                                else { atomicMin(&ST[q], fkey(x)); atomicMax(&ST[16 + q], fkey(x)); } } } } }
            __syncthreads();
            { const int q = 2 * wv + hi;
              if (ST[96 + q] == 0u) {
                  if (ST[128 + q] <= 256u) { const int cn = (int)ST[128 + q]; const unsigned want = ST[64 + q] - 1u;
                      for (int e = cc; e < cn; e += 32) { const float v = CAND[q * 256 + e]; unsigned rank = 0;
                          for (int j = 0; j < cn; ++j) { const float o = CAND[q * 256 + j]; rank += (o > v || (o == v && j < e)) ? 1u : 0u; }
                          if (rank == want) { STf[80 + q] = v; ST[96 + q] = 1u; } } }
                  else if (cc == 0) { STf[32 + q] = fkey_inv(ST[q]); STf[48 + q] = fkey_inv(ST[16 + q]); ST[176] = 1u; } } }
            __syncthreads();
            const unsigned act = ST[176];
            __syncthreads();
            if (act == 0u) break;
        }
    } else { if (tid < 16) STf[80 + tid] = NINF; }
    __syncthreads();
#pragma unroll
    for (int rt = 0; rt < 4; ++rt)
#pragma unroll
        for (int i = 0; i < 2; ++i) { const int q = 4 * rt + 2 * i + hi; const float T = STf[80 + q]; unsigned cg = 0;
#pragma unroll
            for (int ktl = 0; ktl < 16; ++ktl) { const float x = sc[ktl][rt][i]; const int kt = wv + 8 * ktl;
                const unsigned long long bg = __ballot(x > T), be = __ballot(x == T && T > NINF);
                if (kt < nkt && cc == 0) { const unsigned g = hi ? (unsigned)(bg >> 32) : (unsigned)bg, e = hi ? (unsigned)(be >> 32) : (unsigned)be; MWG[q * 128 + kt] = g; MWE[q * 128 + kt] = e; cg += __popc(g); } }
            if (cc == 0) atomicAdd(&ST[160 + q], cg); }
    __syncthreads();
    { const int q = 2 * wv + hi; const int need = TOPK - (int)ST[160 + q];
      u32x4 g = *(const u32x4*)(MWG + q * 128 + 4 * cc), e = *(const u32x4*)(MWE + q * 128 + 4 * cc);
      unsigned ew[4] = {e.x, e.y, e.z, e.w}; unsigned lsum = __popc(ew[0]) + __popc(ew[1]) + __popc(ew[2]) + __popc(ew[3]); unsigned incl = lsum;
#pragma unroll
      for (int o = 1; o < 32; o <<= 1) { const unsigned t = __shfl_up(incl, o, 32); if (cc >= o) incl += t; }
      int before = (int)(incl - lsum);
#pragma unroll
      for (int j = 0; j < 4; ++j) { const int pc = __popc(ew[j]); int allowed = need - before; allowed = allowed < 0 ? 0 : (allowed > pc ? pc : allowed);
          unsigned w = ew[j]; while (__popc(w) > allowed) w &= ~(0x80000000u >> __clz(w));
          ew[j] = w; before += pc; }
      *(u32x4*)((unsigned*)(c.R + R_P2 + P2_MASK) + (size_t)(row0 + q) * 128 + 4 * cc) = (u32x4){g.x | ew[0], g.y | ew[1], g.z | ew[2], g.w | ew[3]}; }
}
__device__ __forceinline__ void phase_dsa_select(const Ctx& c, unsigned char* smem) { for (int u = blockIdx.x; u < MS / 16; u += gridDim.x) dsa_select_unit(c, u, smem); }

typedef short s16x4 __attribute__((ext_vector_type(4)));
constexpr int AT_TILE = 16384, AT_K = 0, AT_V = 4 * AT_TILE, AT_WS = 8 * AT_TILE, AT_LDS = AT_WS + 8 * 64 * 4 * 2;
#define KSWZ(row, colB) ((row) * 256 + ((colB) ^ (((row) & 7) << 4)))
__device__ __forceinline__ int v_st(int k, int cidx) { const int kk = (k & ~0xC) | ((k & 4) << 1) | ((k & 8) >> 1); return ((kk >> 3) * 4 + (cidx >> 5)) * 512 + ((kk & 7) * 32 + (cidx & 31)) * 2; }
__device__ __forceinline__ int v_rd_base(int lane) { return ((lane & 3) << 3) | (((lane >> 2) & 3) << 6) | (((lane >> 4) & 1) << 5) | (((lane >> 5) & 1) << 8); }
constexpr int v_rd_off(int d0, int ks, int half) { return d0 * 512 + ks * 4096 + half * 2048; }
constexpr float AT_SCALE = 0.08838834764831845f, AT_THR = 8.f;
__device__ __forceinline__ unsigned cvtpk_a(float lo, float hi) { unsigned r; asm volatile("v_cvt_pk_bf16_f32 %0, %1, %2" : "=v"(r) : "v"(lo), "v"(hi)); return r; }
__device__ __forceinline__ void at_partialSM(f32x16& p0, f32x16& p1, float& m_reg, float& alpha) {
    float pmax = p0[0];
#pragma unroll
    for (int r = 1; r < 16; ++r) pmax = fmaxf(pmax, p0[r]);
#pragma unroll
    for (int r = 0; r < 16; ++r) pmax = fmaxf(pmax, p1[r]);
    { auto rr = __builtin_amdgcn_permlane32_swap(__float_as_uint(pmax), __float_as_uint(pmax), false, false); pmax = fmaxf(__uint_as_float(rr[0]), __uint_as_float(rr[1])); }
    constexpr float C2 = 1.4426950408889634f * AT_SCALE; float mn;
    if (__builtin_expect(__all((pmax - m_reg) * AT_SCALE <= AT_THR), 1)) { mn = m_reg; alpha = 1.f; }
    else { mn = fmaxf(m_reg, pmax); alpha = __builtin_amdgcn_exp2f((m_reg - mn) * C2); m_reg = mn; }
    const float mnL = -mn * C2;
#pragma unroll
    for (int r = 0; r < 16; ++r) { p0[r] = __builtin_amdgcn_exp2f(fmaf(p0[r], C2, mnL)); p1[r] = __builtin_amdgcn_exp2f(fmaf(p1[r], C2, mnL)); }
}
__device__ __forceinline__ void at_finishSM(const f32x16& p0, const f32x16& p1, float alpha, float& l_reg, bf16x8& pa0, bf16x8& pa1, bf16x8& pa2, bf16x8& pa3) {
    float ps = 0;
#pragma unroll
    for (int r = 0; r < 16; ++r) ps += p0[r];
#pragma unroll
    for (int r = 0; r < 16; ++r) ps += p1[r];
    { auto rr = __builtin_amdgcn_permlane32_swap(__float_as_uint(ps), __float_as_uint(ps), false, false); ps = __uint_as_float(rr[0]) + __uint_as_float(rr[1]); }
    l_reg = l_reg * alpha + ps;
#define AT_PK4(P, B_, OUT) do { unsigned a0 = cvtpk_a(P[B_+0], P[B_+1]), a1 = cvtpk_a(P[B_+2], P[B_+3]); unsigned b0 = cvtpk_a(P[B_+4], P[B_+5]), b1 = cvtpk_a(P[B_+6], P[B_+7]); \
        auto r0 = __builtin_amdgcn_permlane32_swap(a0, b0, false, false); auto r1 = __builtin_amdgcn_permlane32_swap(a1, b1, false, false); \
        u32x4 w = {r0[0], r1[0], r0[1], r1[1]}; OUT = __builtin_bit_cast(bf16x8, w); } while (0)
    AT_PK4(p0, 0, pa0); AT_PK4(p0, 8, pa1); AT_PK4(p1, 0, pa2); AT_PK4(p1, 8, pa3);
#undef AT_PK4
}
__device__ __forceinline__ void at_qkt(f32x16& p0, f32x16& p1, const unsigned char* Kt, int r32, int hi, const bf16x8* qr) {
    p0 = f32x16{}; p1 = f32x16{};
    const unsigned char* kb[4];
#pragma unroll
    for (int dd = 0; dd < 4; ++dd) kb[dd] = Kt + KSWZ(r32, (dd * 16 + hi * 8) * 2);
#pragma unroll
    for (int d0 = 0; d0 < 8; ++d0) { const unsigned char* a = kb[d0 & 3] + (d0 >> 2) * 128;
        const bf16x8 b0 = *reinterpret_cast<const bf16x8*>(a), b1 = *reinterpret_cast<const bf16x8*>(a + 32 * 256);
        p0 = MFMA32(b0, qr[d0], p0); p1 = MFMA32(b1, qr[d0], p1); }
}
template <int VOFF> __device__ __forceinline__ void at_pv(f32x16* o, int vb0, bf16x8 pa0, bf16x8 pa1, bf16x8 pa2, bf16x8 pa3) {
#define TRRD(dst, off) asm volatile("ds_read_b64_tr_b16 %0, %1 offset:%2" : "=&v"(dst) : "v"(vb0), "i"(off) : "memory")
#define PV_D0(d0) do { s16x4 l0, l1, l2, l3, h0, h1, h2, h3; constexpr int b_ = VOFF + v_rd_off(d0, 0, 0); \
        TRRD(l0, b_); TRRD(h0, b_ + 2048); TRRD(l1, b_ + 4096); TRRD(h1, b_ + 6144); TRRD(l2, b_ + 8192); TRRD(h2, b_ + 10240); TRRD(l3, b_ + 12288); TRRD(h3, b_ + 14336); \
        asm volatile("s_waitcnt lgkmcnt(0)" ::: "memory"); __builtin_amdgcn_sched_barrier(0); \
        o[d0] = MFMA32(pa0, ((bf16x8){l0[0], l0[1], l0[2], l0[3], h0[0], h0[1], h0[2], h0[3]}), o[d0]); \
        o[d0] = MFMA32(pa1, ((bf16x8){l1[0], l1[1], l1[2], l1[3], h1[0], h1[1], h1[2], h1[3]}), o[d0]); \
        o[d0] = MFMA32(pa2, ((bf16x8){l2[0], l2[1], l2[2], l2[3], h2[0], h2[1], h2[2], h2[3]}), o[d0]); \
        o[d0] = MFMA32(pa3, ((bf16x8){l3[0], l3[1], l3[2], l3[3], h3[0], h3[1], h3[2], h3[3]}), o[d0]); } while (0)
    PV_D0(0); PV_D0(1); PV_D0(2); PV_D0(3);
#undef PV_D0
#undef TRRD
}
__device__ __forceinline__ void dsa_attn_unit(const Ctx& c, int split, int unit, unsigned char* smem) {
    const int tid = otid(), lane = tid & 63, wv = __builtin_amdgcn_readfirstlane(tid >> 6), r32 = lane & 31, hi = lane >> 5, rg = wv & 3, kp = wv >> 2;
    const int bh = unit & (BPS * 8 - 1), qb = (SEQ / 128 - 1) - unit / (BPS * 8), bl = bh >> 3, h = bh & 7, rb = bl * SEQ, q0 = 128 * qb, nstep = qb + 1;
    const bf16_t* QB = (const bf16_t*)(c.R + R_QB); const bf16_t* KB = (const bf16_t*)(c.R + R_KB) + (size_t)rb * 1024 + h * 128; const bf16_t* VB = (const bf16_t*)(c.R + R_VB) + (size_t)rb * 1024 + h * 128;
    const unsigned* MK = (const unsigned*)(c.R + R_P2 + P2_MASK) + (size_t)(rb + q0 + 32 * rg + r32) * 128;
    float* ws = (float*)(smem + AT_WS) + wv * 128; float* li_l = ws; float* al_l = ws + 32;
    const int sr = tid >> 4, scol = (tid & 15) * 8, vst0 = v_st(sr, scol), vst1 = v_st(32 + sr, scol), kws = KSWZ(sr, scol * 2);
    const int vb0 = (int)(uintptr_t)(smem + AT_V) + kp * AT_TILE + v_rd_base(lane);
    bf16x8 qr[8];
    { const bf16_t* qp = QB + (size_t)(rb + q0 + 32 * rg + r32) * 1024 + h * 128 + hi * 8;
#pragma unroll
      for (int d0 = 0; d0 < 8; ++d0) qr[d0] = *(const bf16x8*)(qp + d0 * 16); }
    bf16x8 sk[4], sv[4];
#define AT_LOAD(j) do { const size_t o0 = (size_t)(128 * (j) + sr) * 1024 + scol; sk[0] = *(const bf16x8*)(KB + o0); sk[1] = *(const bf16x8*)(KB + o0 + 32 * 1024); sk[2] = *(const bf16x8*)(KB + o0 + 64 * 1024); sk[3] = *(const bf16x8*)(KB + o0 + 96 * 1024); \
        sv[0] = *(const bf16x8*)(VB + o0); sv[1] = *(const bf16x8*)(VB + o0 + 32 * 1024); sv[2] = *(const bf16x8*)(VB + o0 + 64 * 1024); sv[3] = *(const bf16x8*)(VB + o0 + 96 * 1024); } while (0)
#define AT_WRITE(bf) do { unsigned char* Kd = smem + AT_K + (bf) * 2 * AT_TILE; unsigned char* Vd = smem + AT_V + (bf) * 2 * AT_TILE; \
        *(bf16x8*)(Kd + kws) = sk[0]; *(bf16x8*)(Kd + kws + 32 * 256) = sk[1]; *(bf16x8*)(Kd + AT_TILE + kws) = sk[2]; *(bf16x8*)(Kd + AT_TILE + kws + 32 * 256) = sk[3]; \
        *(bf16x8*)(Vd + vst0) = sv[0]; *(bf16x8*)(Vd + vst1) = sv[1]; *(bf16x8*)(Vd + AT_TILE + vst0) = sv[2]; *(bf16x8*)(Vd + AT_TILE + vst1) = sv[3]; } while (0)
    __syncthreads();
    AT_LOAD(0); AT_WRITE(0);
    float m_reg = -1e30f, l_reg = 0.f; f32x16 o[4] = {};
    __syncthreads();
    const int lastrow = q0 + 32 * rg + 31; const float NINF = -__builtin_inff();
#define AT_STEP(j, BUF) do { \
        const int tt = 2 * (j) + kp; const bool act = 64 * tt <= lastrow; \
        uint2 mw = make_uint2(0u, 0u); if (act) mw = *(const uint2*)(MK + 2 * tt); \
        if ((j) + 1 < nstep) AT_LOAD((j) + 1); \
        if (act) { \
            const unsigned m0 = mw.x >> (4 * hi), m1 = mw.y >> (4 * hi); \
            f32x16 p0, p1; at_qkt(p0, p1, smem + AT_K + ((BUF) * 2 + kp) * AT_TILE, r32, hi, qr); \
            _Pragma("unroll") for (int r = 0; r < 16; ++r) { const unsigned bit = 1u << ((r & 3) + 8 * (r >> 2)); if (!(m0 & bit)) p0[r] = NINF; if (!(m1 & bit)) p1[r] = NINF; } \
            float alpha; at_partialSM(p0, p1, m_reg, alpha); \
            bf16x8 pa0, pa1, pa2, pa3; at_finishSM(p0, p1, alpha, l_reg, pa0, pa1, pa2, pa3); \
            if (__any(alpha < 1.f)) { if (hi == 0) al_l[r32] = alpha; asm volatile("s_waitcnt lgkmcnt(0)" ::: "memory"); \
                _Pragma("unroll") for (int d_ = 0; d_ < 4; ++d_) _Pragma("unroll") for (int r = 0; r < 16; ++r) o[d_][r] *= al_l[crow(r, hi)]; } \
            __builtin_amdgcn_sched_barrier(0); \
            at_pv<(BUF) * 2 * AT_TILE>(o, vb0, pa0, pa1, pa2, pa3); } \
        if ((j) + 1 < nstep) { asm volatile("s_waitcnt vmcnt(0)" ::: "memory"); AT_WRITE(1 - (BUF)); } \
        __syncthreads(); } while (0)
#pragma unroll 1
    for (int j = 0; j < nstep; j += 2) { AT_STEP(j, 0); if (j + 1 < nstep) AT_STEP(j + 1, 1); }
#undef AT_STEP
#undef AT_LOAD
#undef AT_WRITE
    float* mg = (float*)smem + (size_t)rg * (66 * 64);
    if (kp == 1) {
#pragma unroll
        for (int d0 = 0; d0 < 4; ++d0)
#pragma unroll
            for (int r = 0; r < 16; ++r) mg[(d0 * 16 + r) * 64 + lane] = o[d0][r];
        mg[64 * 64 + lane] = m_reg; mg[65 * 64 + lane] = l_reg; }
    __syncthreads();
    if (kp == 0) {
        constexpr float C2 = 1.4426950408889634f * AT_SCALE;
        const float m2 = mg[64 * 64 + lane], l2 = mg[65 * 64 + lane], mm = fmaxf(m_reg, m2);
        const float a1 = __builtin_amdgcn_exp2f((m_reg - mm) * C2), a2 = __builtin_amdgcn_exp2f((m2 - mm) * C2), lt = l_reg * a1 + l2 * a2;
        if (hi == 0) { li_l[r32] = __builtin_amdgcn_rcpf(lt); al_l[r32] = a1; al_l[32 + r32] = a2; }
        asm volatile("s_waitcnt lgkmcnt(0)" ::: "memory");
        bf16_t* Ow = c.AT + ((size_t)split * MS + rb + q0 + 32 * rg) * 1024 + h * 128;
#pragma unroll
        for (int r = 0; r < 16; ++r) { const int orow = crow(r, hi); const float f1 = al_l[orow] * li_l[orow], f2 = al_l[32 + orow] * li_l[orow];
#pragma unroll
            for (int d0 = 0; d0 < 4; ++d0) { const float v = o[d0][r] * f1 + mg[(d0 * 16 + r) * 64 + lane] * f2; const float vn = __shfl_xor(v, 1);
                if ((r32 & 1) == 0) *(unsigned*)(Ow + (size_t)orow * 1024 + d0 * 32 + r32) = cvtpk_s(v, vn); } } }
}

constexpr int LDS_QSLOT = LDS_BYTES - 16;
__device__ __forceinline__ int queue_next(unsigned* ctr, unsigned char* smem) {
    __syncthreads(); if (otid() == 0) *(volatile int*)(smem + LDS_QSLOT) = (int)atomicAdd(ctr, 1u); __syncthreads(); return *(volatile int*)(smem + LDS_QSLOT);
}
__device__ __forceinline__ void phase_prep_select(const Ctx& c, int layer, int split, int rep, unsigned char* smem) {
    unsigned* ctr = (unsigned*)(c.ws + WS_CTL) + 1024 + (((layer * NSPLIT + split) * 2 + 0) * 2 + rep) * 64;
    constexpr int NSEL = MS / 16, NPREP = (MS / 64) * 8;
    for (;;) { const int u = queue_next(ctr, smem); if (u >= (rep ? NSEL : NSEL + NPREP)) break; if (u < NSEL) dsa_select_unit(c, u, smem); else gdn_prep_unit(c, layer, u - NSEL, smem); }
}
__device__ __forceinline__ void phase_scan_attn(const Ctx& c, int layer, int split, int rep, unsigned char* smem) {
    unsigned* ctr = (unsigned*)(c.ws + WS_CTL) + 1024 + (((layer * NSPLIT + split) * 2 + 1) * 2 + rep) * 64;
    constexpr int NSCAN = BPS * 8, NATT = BPS * 8 * (SEQ / 128);
    for (;;) { int u = queue_next(ctr, smem);
        if (rep && PROBE_C_MODE == 1) { if (u >= NSCAN) break; }
        else if (rep && PROBE_C_MODE == 2) { u += NSCAN; }
        if (u >= NSCAN + NATT) break; if (u < NSCAN) gdn_scan_unit(c, layer, split, u, smem); else dsa_attn_unit(c, split, u - NSCAN, smem); }
}
#define LAS __attribute__((address_space(3)))
#define XB_TMO      128
#define XB_XCNT(j)  (256  + 64 * (j))
#define XB_XSUB(j)  (1280 + 64 * (j))
#define XB_XGEN(j)  (2304 + 64 * (j))
#define XB_TOP      3328
#define XB_TOPGEN   3392
#define XCD_BAR_WORDS 3456
#define XB_SPIN_CAP (1u << 18)

__device__ __forceinline__ unsigned xb_ld(unsigned* p)              { return __hip_atomic_load(p, __ATOMIC_RELAXED, __HIP_MEMORY_SCOPE_AGENT); }
__device__ __forceinline__ unsigned xb_add(unsigned* p, unsigned v) { return __hip_atomic_fetch_add(p, v, __ATOMIC_RELAXED, __HIP_MEMORY_SCOPE_AGENT); }
__device__ __forceinline__ unsigned xb_xcc_id() { return (unsigned)__builtin_amdgcn_s_getreg((3 << 11) | 20) & 0xFu; }
#define XB_SPIN(cond, bar) do { unsigned _sp = 0; while (cond) { __builtin_amdgcn_s_sleep(1); \
    if ((++_sp & 255u) == 0u) { if (xb_ld(&(bar)[XB_TMO])) break; if (_sp > XB_SPIN_CAP) { atomicAdd(&(bar)[XB_TMO], 1u); break; } } } } while (0)

struct XcdBarrier {
    unsigned* bar; unsigned x;
    volatile LAS unsigned* st;
};

__device__ __forceinline__ XcdBarrier xcd_barrier_post(unsigned* bar, volatile LAS unsigned* st) {
    XcdBarrier b; b.bar = bar; b.x = xb_xcc_id(); b.st = st;
    if (threadIdx.x == 0) (void)xb_add(&bar[XB_XCNT(b.x)], 1u);
    return b;
}
__device__ __forceinline__ void xcd_barrier_complete(unsigned* bar, unsigned x, unsigned& nloc, unsigned& nx) {
    const unsigned G = gridDim.x * gridDim.y * gridDim.z;
    unsigned sum, cnt, mine, sp = 0u;
    for (;;) {
        sum = 0u; cnt = 0u; mine = 0u;
#pragma unroll
        for (unsigned j = 0; j < 16; ++j) { const unsigned c = xb_ld(&bar[XB_XCNT(j)]); sum += c; cnt += (c > 0u) ? 1u : 0u; mine = (j == x) ? c : mine; }
        if (sum == G) break;
        __builtin_amdgcn_s_sleep(1);
        if ((++sp & 255u) == 0u) { if (xb_ld(&bar[XB_TMO])) break; if (sp > XB_SPIN_CAP) { atomicAdd(&bar[XB_TMO], 1u); break; } }
    }
    nloc = mine > 0u ? mine : 1u; nx = cnt > 0u ? cnt : 1u;
}

__device__ __forceinline__ void xcd_barrier(const XcdBarrier& b) {
    asm volatile("s_waitcnt vmcnt(0)" ::: "memory");
    __syncthreads();
    if (threadIdx.x == 0) {
        unsigned* bar = b.bar;
        __builtin_amdgcn_s_waitcnt(0);
        unsigned nloc = b.st[0], nx = b.st[1];
        if (nloc == 0u) { xcd_barrier_complete(bar, b.x, nloc, nx); b.st[0] = nloc; b.st[1] = nx; }
        const unsigned old = xb_add(&bar[XB_XSUB(b.x)], 1u);
        const unsigned gen = old / nloc;
        if (old + 1u == (gen + 1u) * nloc) {
            __builtin_amdgcn_fence(__ATOMIC_RELEASE, "agent");
            asm volatile("s_waitcnt vmcnt(0)" ::: "memory");
            const unsigned og = xb_add(&bar[XB_TOP], 1u);
            const unsigned tg = og / nx;
            if (og + 1u == (tg + 1u) * nx) xb_add(&bar[XB_TOPGEN], 1u);
            else XB_SPIN(xb_ld(&bar[XB_TOPGEN]) == tg, bar);
            __builtin_amdgcn_fence(__ATOMIC_ACQUIRE, "agent");
            xb_add(&bar[XB_XGEN(b.x)], 1u);
            asm volatile("s_waitcnt vmcnt(0)" ::: "memory");
        } else {
            XB_SPIN(xb_ld(&bar[XB_XGEN(b.x)]) == gen, bar);
            __builtin_amdgcn_fence(__ATOMIC_ACQUIRE, "agent");
            asm volatile("s_waitcnt vmcnt(0)" ::: "memory");
        }
    }
    __syncthreads();
}
typedef const __attribute__((address_space(4))) Args* KArgsP;
__device__ __forceinline__ Ctx make_ctx() {
    KArgsP a = (KArgsP)__builtin_amdgcn_kernarg_segment_ptr(); asm volatile("" : "+s"(a));
    Ctx c;
    c.x = a->in[0]; c.norm_mix = a->in[1]; c.w_in = a->in[2]; c.conv_w = a->in[3]; c.a_log = a->in[4]; c.dt_bias = a->in[5]; c.gdn_norm = a->in[6];
    c.w_out_gdn = a->in[7]; c.w_out_dsa = a->in[8]; c.w_o = a->in[9]; c.norm_ffn = a->in[10]; c.w_gate_up = a->in[11]; c.w_down = a->in[12]; c.norm_final = a->in[13];
    c.out = a->out; c.ws = a->ws; c.R = c.ws + WS_R;
    c.cosA = (float*)(c.ws + WS_TAB); c.sinA = c.cosA + SEQ * 64; c.cosI = c.sinA + SEQ * 64; c.sinI = c.cosI + SEQ * 32;
    c.XN = (bf16_t*)(c.ws + WS_XN); c.OA = (bf16_t*)(c.ws + WS_OA); c.AT = (bf16_t*)(c.ws + WS_AT);
    return c;
}
__global__ void __launch_bounds__(512, 2) fwd_kernel(Args a) {
    extern __shared__ __attribute__((aligned(16))) unsigned char smem[];
    cg::grid_group grid = cg::this_grid();
    PG8_LAS unsigned char* lds = (PG8_LAS unsigned char*)smem;
    volatile LAS unsigned* bst = (volatile LAS unsigned*)((LAS unsigned char*)smem + (LDS_BYTES - 32));
    if (otid() < 2) bst[otid()] = 0u;
    __syncthreads();
    XcdBarrier xbar = xcd_barrier_post((unsigned*)(a.ws + WS_CTL) + 4096, bst);
#define SYNC() xcd_barrier(xbar)
    { const Ctx c = make_ctx(); phase_tables(c); }
    if (ANY_OPT_GEMM) { const Ctx c = make_ctx(); phase_convert_weights(c, 0, smem); }
    { const Ctx c = make_ctx(); phase_rmsnorm(c.x, c.norm_mix, c.XN, nullptr); }
    grid.sync();
#pragma unroll 1
    for (int layer = 0; layer < DEPTH; ++layer) {
#pragma unroll 1
        for (int pc = 0; pc < 19; ++pc) {
            int st, split = 0;
            if (pc < 12) { split = pc / 6; st = pc % 6; } else st = pc - 6;
            if (STAGE_OPT_GDN && STAGE_OPT_DSA && (st == 2 || st == 4 || st == 5)) continue;
            const int nrep = ((PROBE_DUP_MASK >> st) & 1) ? 2 : 1;
#pragma unroll 1
            for (int rep = 0; rep < nrep; ++rep) {
            int k0 = 0, k1 = 0;
            if (st == 0) { if (STAGE_OPT_INPROJ) { const Ctx c = make_ctx(); unsigned char* wt = c.ws + WS_WT; pg8::Gemm g{c.XN + (size_t)split * MS * DM, (const bf16_t*)(wt + WT_IN), MS, 31 * 256, DM}; pg8::StaticOrder S; S.init(MS, 31 * 256, gridDim.x, blockIdx.x);
                    EpiInProj E{c.R, c.cosA, c.sinA, c.cosI, c.sinI, c.a_log + layer * 8, c.dt_bias + layer * 8}; pg8::gemm_phase<EpiInProj, pg8::StaticOrder, true, true>(lds, g, S, E); }
                else { k0 = split * 10; k1 = k0 + 10; } }
            else if (st == 1) { const Ctx c = make_ctx(); if (STAGE_OPT_GDN && STAGE_OPT_DSA) phase_prep_select(c, layer, split, rep, smem); else if (STAGE_OPT_GDN) phase_gdn_prep(c, layer, smem); else naive_conv(c, layer); }
            else if (st == 2) { if (!STAGE_OPT_GDN) { const Ctx c = make_ctx(); naive_l2norm(c); } }
            else if (st == 3) { const Ctx c = make_ctx(); if (STAGE_OPT_GDN && STAGE_OPT_DSA) phase_scan_attn(c, layer, split, rep, smem); else if (STAGE_OPT_GDN) phase_gdn_scan(c, layer, split, smem); else naive_scan(c, smem); }
            else if (st == 4) { if (!STAGE_OPT_GDN) { const Ctx c = make_ctx(); naive_gate(c, layer, split); } }
            else if (st == 5) { if (!(STAGE_OPT_GDN && STAGE_OPT_DSA)) { const Ctx c = make_ctx(); naive_dsa(c, split, smem); } }
            else if (st == 6) { if (STAGE_OPT_GATES) { const Ctx c = make_ctx(); unsigned char* wt = c.ws + WS_WT; pg8::Gemm g{c.XN, (const bf16_t*)(wt + WT_IN) + (size_t)31 * 256 * DM, M, 2048, DM}; pg8::StaticOrder S; S.init(M, 2048, gridDim.x, blockIdx.x);
                    EpiGates E{(bf16_t*)(c.R + R_SG)}; pg8::gemm_phase<EpiGates, pg8::StaticOrder, true, true>(lds, g, S, E); }
                else { k0 = 20; k1 = 24; } }
            else if (st == 7) { if (STAGE_OPT_Y) { const Ctx c = make_ctx(); unsigned char* wt = c.ws + WS_WT; pg8::StaticOrder S; S.init(M, DM, gridDim.x, blockIdx.x);
                    { pg8::Gemm g{c.OA, (const bf16_t*)(wt + WT_OG), M, DM, DM}; EpiY<0> E{(const bf16_t*)(c.R + R_SG), (bf16_t*)(c.R + R_MG)}; pg8::gemm_phase<EpiY<0>, pg8::StaticOrder, false, true>(lds, g, S, E); }
                    { pg8::Gemm g{c.AT, (const bf16_t*)(wt + WT_OD), M, DM, DM}; EpiY<1> E{(const bf16_t*)(c.R + R_SG), (bf16_t*)(c.R + R_MG)}; pg8::gemm_phase<EpiY<1>, pg8::StaticOrder, false, true>(lds, g, S, E); } }
                else { k0 = 24; k1 = 28; } }
            else if (st == 8) { if (STAGE_OPT_WO) { const Ctx c = make_ctx(); unsigned char* wt = c.ws + WS_WT; pg8::Gemm g{(const bf16_t*)(c.R + R_MG), (const bf16_t*)(wt + WT_O), M, DM, DM}; pg8::StaticOrder S; S.init(M, DM, gridDim.x, blockIdx.x);
                    EpiResid E{layer == 0 ? c.x : c.out, c.out}; pg8::gemm_phase<EpiResid, pg8::StaticOrder, false, true>(lds, g, S, E); }
                else { k0 = 28; k1 = 30; } }
            else if (st == 9) { const Ctx c = make_ctx(); phase_rmsnorm(c.out, c.norm_ffn + layer * DM, c.XN, nullptr); }
            else if (st == 10) { if (STAGE_OPT_GU) { const Ctx c = make_ctx(); unsigned char* wt = c.ws + WS_WT; pg8::Gemm g{c.XN, (const bf16_t*)(wt + WT_GU), M, 2 * FF, DM}; pg8::StaticOrder S; S.init(M, 2 * FF, gridDim.x, blockIdx.x);
                    EpiSwiglu E{(bf16_t*)(c.R + R_ACT)}; pg8::gemm_phase<EpiSwiglu, pg8::StaticOrder, true, true>(lds, g, S, E); }
                else { k0 = 30; k1 = 52; } }
            else if (st == 11) { if (STAGE_OPT_DN) { const Ctx c = make_ctx(); unsigned char* wt = c.ws + WS_WT; pg8::Gemm g{(const bf16_t*)(c.R + R_ACT), (const bf16_t*)(wt + WT_DN), M, DM, FF}; pg8::StaticOrder S; S.init(M, DM, gridDim.x, blockIdx.x);
                    EpiResid E{c.out, c.out}; pg8::gemm_phase<EpiResid, pg8::StaticOrder, false, true>(lds, g, S, E); }
                else { k0 = 52; k1 = 54; } }
            else { const Ctx c = make_ctx(); if (layer + 1 < DEPTH) { phase_rmsnorm(c.out, c.norm_mix + (layer + 1) * DM, c.XN, nullptr); if (ANY_OPT_GEMM) phase_convert_weights(c, layer + 1, smem); }
                   else phase_rmsnorm(c.out, c.norm_final, nullptr, c.out); }
#pragma unroll 1
            for (int k = k0; k < k1; ++k) {
                const Ctx c = make_ctx(); const float* w_in = c.w_in + (size_t)layer * DM * INC; float* TMP = (float*)(c.R + R_TMP);
                NG g; EP e; int ng = 1;
                g.A = c.XN; g.lda = DM; g.W = w_in; g.ldw = INC; g.col0 = 0; g.ncols = 1024; g.row0 = 0; g.nrows = MS; g.K = DM; g.T = TMP; g.ldt = 1024; g.tcol0 = 0;
                e.kind = E_V; e.nrows = MS; e.rowg0 = 0; e.p0 = 0; e.layer = layer; e.dst = nullptr; e.base = nullptr;
                if (k < 20) { const int sp = k / 10, j = k % 10; g.row0 = sp * MS; e.rowg0 = sp * MS;
                    if (j < 3) { g.col0 = C_QKVA + j * 1024; e.kind = E_QKVA; e.p0 = j; }
                    else if (j == 3) { g.col0 = C_Z; e.kind = E_Z; }
                    else if (j == 4) { g.col0 = C_A; g.ncols = 16; e.kind = E_AB; }
                    else if (j == 5) { g.col0 = C_QB; e.kind = E_ROPE; e.dst = (bf16_t*)(c.R + R_QB); }
                    else if (j == 6) { g.col0 = C_KB; e.kind = E_ROPE; e.dst = (bf16_t*)(c.R + R_KB); }
                    else if (j == 7) { g.col0 = C_VB; e.kind = E_V; e.dst = (bf16_t*)(c.R + R_VB); }
                    else if (j == 8) { g.col0 = C_QI; g.ncols = 512; e.kind = E_QI; }
                    else { g.col0 = C_KI; g.ncols = 72; e.kind = E_KIWI; } }
                else if (k < 24) { const int hf = (k - 20) >> 1, gg = (k - 20) & 1; g.row0 = hf * MS; e.rowg0 = hf * MS; g.col0 = C_GA + gg * 1024; e.kind = E_SG; e.p0 = gg; }
                else if (k < 28) { const int hf = (k - 24) >> 1, wh = (k - 24) & 1; g.row0 = hf * MS; e.rowg0 = hf * MS; g.A = wh ? c.AT : c.OA;
                    g.W = (wh ? c.w_out_dsa : c.w_out_gdn) + (size_t)layer * DM * DM; g.ldw = DM; e.kind = wh ? E_YB : E_YA; }
                else if (k < 30) { const int hf = k - 28; g.row0 = hf * MS; e.rowg0 = hf * MS; g.A = (const bf16_t*)(c.R + R_MG); g.W = c.w_o + (size_t)layer * DM * DM; g.ldw = DM; e.kind = E_WO; e.base = layer == 0 ? c.x : c.out; }
                else if (k < 52) { const int hf = (k - 30) / 11, fg = (k - 30) % 11; g.row0 = hf * MS; e.rowg0 = hf * MS; g.W = c.w_gate_up + (size_t)layer * DM * 2 * FF; g.ldw = 2 * FF; g.col0 = fg * 256; g.ncols = 256;
                    ng = 2; e.kind = E_SWIGLU; e.p0 = fg; }
                else { const int hf = k - 52; g.row0 = hf * MS; e.rowg0 = hf * MS; g.A = (const bf16_t*)(c.R + R_ACT); g.lda = FF; g.K = FF; g.W = c.w_down + (size_t)layer * FF * DM; g.ldw = DM; e.kind = E_DOWN; }
#pragma unroll 1
                for (int q = 0; q < ng; ++q) { if (q == 1) { g.col0 += FF; g.tcol0 = 256; } naive_gemm(g, smem); }
                SYNC();
                epi_phase(c, e);
                if (k + 1 < k1) SYNC();
            }
            SYNC();
            }
        }
    }
}

extern "C" void kernel_launch(void* const* d_in, const int* in_sizes, int n_in, void* d_out, int out_size, void* d_ws, size_t ws_size, hipStream_t stream) {
    static int grid = 0;
    if (grid == 0) {
        if (n_in != 14 || out_size != M * DM || ws_size < WS_END) { fprintf(stderr, "kernel_launch: unexpected problem (n_in %d out %d ws %zu need %zu)\n", n_in, out_size, ws_size, (size_t)WS_END); grid = -1; return; }
        int dev = 0, cus = 0, per_cu = 0;
        hipGetDevice(&dev); hipDeviceGetAttribute(&cus, hipDeviceAttributeMultiprocessorCount, dev);
        hipFuncSetAttribute((const void*)fwd_kernel, hipFuncAttributeMaxDynamicSharedMemorySize, LDS_BYTES);
        hipOccupancyMaxActiveBlocksPerMultiprocessor(&per_cu, (const void*)fwd_kernel, 512, LDS_BYTES);
        if (per_cu < 1) { fprintf(stderr, "kernel_launch: occupancy query says %d blocks/CU\n", per_cu); grid = -1; return; }
        grid = cus;
        (void)hipGetLastError();
    }
    if (grid < 0) return;
    hipMemsetAsync((char*)d_ws + WS_CTL, 0, 65536, stream);
    Args a{};
    for (int i = 0; i < 14; ++i) a.in[i] = (const float*)d_in[i];
    a.out = (float*)d_out; a.ws = (unsigned char*)d_ws;
    void* args[] = {&a};
    hipError_t e = hipLaunchCooperativeKernel((const void*)fwd_kernel, dim3(grid), dim3(512), args, LDS_BYTES, stream);
    if (e != hipSuccess) fprintf(stderr, "cooperative launch failed: %s (grid %d)\n", hipGetErrorString(e), grid);
}
```
